# Optimizing an MI355X kernel written in HIP

```python
import jax, jax.numpy as jnp
from jax import lax
import numpy as np

D_MODEL = 2048
BATCH = 2
SEQ = 4096
DEPTH = 2
DEC_BATCH = 32
DEC_SEQ = 64
PAST_LEN = 2048

CHUNK = 64
N_MIXERS = 2
N_CONV_LAYERS = (DEPTH + 1) // 2
N_ATTN_LAYERS = DEPTH // 2
CONV_WIDTH = 3
N_HEADS = 16
N_KV_HEADS = 4
HEAD_DIM = 128
N_IDX_HEADS = 16
IDX_DIM = 128
INDEX_TOPK = 256
QUERY_BLOCK = 128
D_FF = 5632
ROPE_THETA = 10000.0
LN_EPS = 1e-5
DEEPNORM_ALPHA = (2 * DEPTH) ** 0.25
DEEPNORM_BETA = (8 * DEPTH) ** -0.25
ATTN_SCALE = HEAD_DIM ** -0.5
IDX_W_SCALE = (N_IDX_HEADS ** -0.5) * (IDX_DIM ** -0.5)
Q_WIDTH = N_HEADS * HEAD_DIM
KV_WIDTH = N_KV_HEADS * HEAD_DIM
IQ_WIDTH = N_IDX_HEADS * IDX_DIM
ATTN_SPLITS = (Q_WIDTH, Q_WIDTH + KV_WIDTH, Q_WIDTH + 2 * KV_WIDTH, Q_WIDTH + 2 * KV_WIDTH + IQ_WIDTH, Q_WIDTH + 2 * KV_WIDTH + IQ_WIDTH + IDX_DIM)
ATTN_IN_WIDTH = ATTN_SPLITS[-1] + N_IDX_HEADS

kernel_name = 'hybrid_shortconv_dsa_stream_step'


def _layer_norm(x, g, b):
    xf = x.astype(jnp.float32)
    mu = jnp.mean(xf, axis=-1, keepdims=True)
    xc = xf - mu
    var = jnp.mean(xc * xc, axis=-1, keepdims=True)
    return (xc * lax.rsqrt(var + LN_EPS) * g.astype(jnp.float32) + b.astype(jnp.float32)).astype(x.dtype)


def _rope(x, pos):
    half = x.shape[-1] // 2
    inv_freq = ROPE_THETA ** (-jnp.arange(half, dtype=jnp.float32) / half)
    ang = pos.astype(jnp.float32)[:, None] * inv_freq[None, :]
    cos = jnp.cos(ang)[:, None, :].astype(x.dtype)
    sin = jnp.sin(ang)[:, None, :].astype(x.dtype)
    x1, x2 = x[..., :half], x[..., half:]
    return jnp.concatenate([x1 * cos - x2 * sin, x1 * sin + x2 * cos], axis=-1)


def _causal_dwconv3(xp, w):
    t = xp.shape[1] - (CONV_WIDTH - 1)
    return w[0] * xp[:, 0:t] + w[1] * xp[:, 1:t + 1] + w[2] * xp[:, 2:t + 2]


def _short_conv_mixer(x, prev, w_in, conv_w, w_out):
    gate_b, gate_c, val = jnp.split(x @ w_in, 3, axis=-1)
    u = jnp.concatenate([prev, gate_c * val], axis=1)
    y = (gate_b * _causal_dwconv3(u, conv_w)) @ w_out
    return y, u[:, -(CONV_WIDTH - 1):]


def _conv_glu(x, prev, w_in, conv_w, conv_b, w_down):
    g, up = jnp.split(x @ w_in, 2, axis=-1)
    gp = jnp.concatenate([prev, g], axis=1)
    h = jax.nn.silu(_causal_dwconv3(gp, conv_w) + conv_b) * up
    return h @ w_down, gp[:, -(CONV_WIDTH - 1):]


def _attn_project(x, pos, w_in, kn_g, kn_b):
    b, t = x.shape[:2]
    q, k, v, iq, ik, iw = jnp.split(x @ w_in, list(ATTN_SPLITS), axis=-1)
    q = _rope(q.reshape(b, t, N_HEADS, HEAD_DIM), pos)
    k = _rope(k.reshape(b, t, N_KV_HEADS, HEAD_DIM), pos)
    v = v.reshape(b, t, N_KV_HEADS, HEAD_DIM)
    iq = _rope(iq.reshape(b, t, N_IDX_HEADS, IDX_DIM), pos)
    ik = _rope(_layer_norm(ik, kn_g, kn_b)[:, :, None, :], pos)[:, :, 0]
    return q, k, v, iq, ik, iw * IDX_W_SCALE


def _dsa_attend(q, iq, iw, k_all, v_all, ik_all, q_pos, k_pos, topk):
    tq = q.shape[0]
    qk_idx = jnp.einsum('qhd,sd->qhs', iq, ik_all).astype(jnp.float32)
    index = jnp.einsum('qhs,qh->qs', jax.nn.relu(qk_idx), iw.astype(jnp.float32))
    admissible = (k_pos[None, :] // CHUNK) <= (q_pos[:, None] // CHUNK)
    index = jnp.where(admissible, index, -jnp.inf)
    _, sel = lax.top_k(index, topk)
    valid = jnp.take_along_axis(admissible, sel, axis=1)
    k_sel = k_all[sel]
    v_sel = v_all[sel]
    qg = q.reshape(tq, N_KV_HEADS, N_HEADS // N_KV_HEADS, HEAD_DIM)
    s = jnp.einsum('qgrd,qkgd->qgrk', qg, k_sel).astype(jnp.float32) * ATTN_SCALE
    s = jnp.where(valid[:, None, None, :], s, -jnp.inf)
    p = jax.nn.softmax(s, axis=-1).astype(v_all.dtype)
    o = jnp.einsum('qgrk,qkgd->qgrd', p, v_sel)
    return o.reshape(tq, N_HEADS * HEAD_DIM)


def _dsa_prompt(q, iq, iw, k, v, ik, topk):
    t = q.shape[1]
    nb = t // QUERY_BLOCK
    pos = jnp.arange(t, dtype=jnp.int32)

    def per_seq(q1, iq1, iw1, k1, v1, ik1):
        def blk(a):
            qb, iqb, iwb, pb = a
            return _dsa_attend(qb, iqb, iwb, k1, v1, ik1, pb, pos, topk)
        out = lax.map(blk, (q1.reshape(nb, QUERY_BLOCK, N_HEADS, HEAD_DIM),
                            iq1.reshape(nb, QUERY_BLOCK, N_IDX_HEADS, IDX_DIM),
                            iw1.reshape(nb, QUERY_BLOCK, N_IDX_HEADS),
                            pos.reshape(nb, QUERY_BLOCK)))
        return out.reshape(t, N_HEADS * HEAD_DIM)

    return jax.vmap(per_seq)(q, iq, iw, k, v, ik)


def _dsa_sample(q, iq, iw, k_all, v_all, ik_all, q_pos, topk):
    k_pos = jnp.arange(k_all.shape[1], dtype=jnp.int32)
    return lax.map(lambda a: _dsa_attend(a[0], a[1], a[2], a[3], a[4], a[5], q_pos, k_pos, topk),
                   (q, iq, iw, k_all, v_all, ik_all))


def setup_inputs(seed: int = 0) -> dict:
    key = jax.random.key(seed)
    ks = jax.random.split(key, 24)
    f32 = jnp.float32

    def nrm(k, shape, scale):
        return jax.random.normal(k, shape, f32) * scale

    d_scale = D_MODEL ** -0.5
    mix_col = jnp.concatenate([jnp.ones((2 * D_MODEL,), f32), jnp.full((D_MODEL,), DEEPNORM_BETA, f32)])
    attn_col = jnp.ones((ATTN_IN_WIDTH,), f32).at[ATTN_SPLITS[1]:ATTN_SPLITS[2]].set(DEEPNORM_BETA)
    return {
        'x_prompt': nrm(ks[0], (BATCH, SEQ, D_MODEL), 1.0),
        'x_sample': nrm(ks[1], (DEC_BATCH, DEC_SEQ, D_MODEL), 1.0),
        'state_conv_mix': nrm(ks[2], (N_CONV_LAYERS, DEC_BATCH, CONV_WIDTH - 1, D_MODEL), 0.5),
        'cache_k': nrm(ks[3], (N_ATTN_LAYERS, DEC_BATCH, PAST_LEN, N_KV_HEADS, HEAD_DIM), 1.0),
        'cache_v': nrm(ks[4], (N_ATTN_LAYERS, DEC_BATCH, PAST_LEN, N_KV_HEADS, HEAD_DIM), 0.5),
        'cache_idx_k': nrm(ks[5], (N_ATTN_LAYERS, DEC_BATCH, PAST_LEN, IDX_DIM), 1.0),
        'state_ffn_conv': nrm(ks[6], (DEPTH, DEC_BATCH, CONV_WIDTH - 1, D_FF), 0.5),
        'mix_w_in': nrm(ks[7], (N_CONV_LAYERS, D_MODEL, 3 * D_MODEL), d_scale) * mix_col,
        'mix_conv_w': nrm(ks[8], (N_CONV_LAYERS, CONV_WIDTH, D_MODEL), CONV_WIDTH ** -0.5),
        'mix_w_out': nrm(ks[9], (N_CONV_LAYERS, D_MODEL, D_MODEL), d_scale * DEEPNORM_BETA),
        'attn_w_in': nrm(ks[10], (N_ATTN_LAYERS, D_MODEL, ATTN_IN_WIDTH), d_scale) * attn_col,
        'idx_k_norm_g': 1.0 + nrm(ks[11], (N_ATTN_LAYERS, IDX_DIM), 0.01),
        'idx_k_norm_b': nrm(ks[12], (N_ATTN_LAYERS, IDX_DIM), 0.01),
        'attn_w_out': nrm(ks[13], (N_ATTN_LAYERS, Q_WIDTH, D_MODEL), (Q_WIDTH ** -0.5) * DEEPNORM_BETA),
        'ffn_w_in': nrm(ks[14], (DEPTH, D_MODEL, 2 * D_FF), d_scale * DEEPNORM_BETA),
        'ffn_conv_w': nrm(ks[15], (DEPTH, CONV_WIDTH, D_FF), CONV_WIDTH ** -0.5),
        'ffn_conv_b': nrm(ks[16], (DEPTH, D_FF), 0.01),
        'ffn_w_down': nrm(ks[17], (DEPTH, D_FF, D_MODEL), (D_FF ** -0.5) * DEEPNORM_BETA),
        'ln1_g': 1.0 + nrm(ks[18], (DEPTH, D_MODEL), 0.01),
        'ln1_b': nrm(ks[19], (DEPTH, D_MODEL), 0.01),
        'ln2_g': 1.0 + nrm(ks[20], (DEPTH, D_MODEL), 0.01),
        'ln2_b': nrm(ks[21], (DEPTH, D_MODEL), 0.01),
    }


def reference(x_prompt, x_sample, state_conv_mix, cache_k, cache_v, cache_idx_k, state_ffn_conv,
              mix_w_in, mix_conv_w, mix_w_out, attn_w_in, idx_k_norm_g, idx_k_norm_b, attn_w_out,
              ffn_w_in, ffn_conv_w, ffn_conv_b, ffn_w_down, ln1_g, ln1_b, ln2_g, ln2_b):
    bp, tp = x_prompt.shape[:2]
    ts = x_sample.shape[1]
    past = cache_k.shape[2]
    pos_p = jnp.arange(tp, dtype=jnp.int32)
    pos_s = past + jnp.arange(ts, dtype=jnp.int32)
    topk_p = min(INDEX_TOPK, tp // 4)
    topk_s = min(INDEX_TOPK, (past + ts) // 4)

    xp, xs = x_prompt, x_sample
    conv_p, conv_s = [], []
    kp, vp, ikp, ks_, vs_, iks = [], [], [], [], [], []
    ffn_p, ffn_s = [], []
    for i in range(DEPTH):
        j = i // N_MIXERS
        if i % N_MIXERS == 0:
            zero = jnp.zeros((bp, CONV_WIDTH - 1, D_MODEL), xp.dtype)
            mp, st_p = _short_conv_mixer(xp, zero, mix_w_in[j], mix_conv_w[j], mix_w_out[j])
            ms, st_s = _short_conv_mixer(xs, state_conv_mix[j], mix_w_in[j], mix_conv_w[j], mix_w_out[j])
            conv_p.append(st_p)
            conv_s.append(st_s)
        else:
            q, k, v, iq, ik, iw = _attn_project(xp, pos_p, attn_w_in[j], idx_k_norm_g[j], idx_k_norm_b[j])
            mp = _dsa_prompt(q, iq, iw, k, v, ik, topk_p) @ attn_w_out[j]
            kp.append(k)
            vp.append(v)
            ikp.append(ik)
            q, k, v, iq, ik, iw = _attn_project(xs, pos_s, attn_w_in[j], idx_k_norm_g[j], idx_k_norm_b[j])
            k_all = jnp.concatenate([cache_k[j], k], axis=1)
            v_all = jnp.concatenate([cache_v[j], v], axis=1)
            ik_all = jnp.concatenate([cache_idx_k[j], ik], axis=1)
            ms = _dsa_sample(q, iq, iw, k_all, v_all, ik_all, pos_s, topk_s) @ attn_w_out[j]
            ks_.append(k)
            vs_.append(v)
            iks.append(ik)
        xp = _layer_norm(DEEPNORM_ALPHA * xp + mp, ln1_g[i], ln1_b[i])
        xs = _layer_norm(DEEPNORM_ALPHA * xs + ms, ln1_g[i], ln1_b[i])
        zero_f = jnp.zeros((bp, CONV_WIDTH - 1, D_FF), xp.dtype)
        fp, fst_p = _conv_glu(xp, zero_f, ffn_w_in[i], ffn_conv_w[i], ffn_conv_b[i], ffn_w_down[i])
        fs, fst_s = _conv_glu(xs, state_ffn_conv[i], ffn_w_in[i], ffn_conv_w[i], ffn_conv_b[i], ffn_w_down[i])
        ffn_p.append(fst_p)
        ffn_s.append(fst_s)
        xp = _layer_norm(DEEPNORM_ALPHA * xp + fp, ln2_g[i], ln2_b[i])
        xs = _layer_norm(DEEPNORM_ALPHA * xs + fs, ln2_g[i], ln2_b[i])

    new_conv_mix_p = jnp.stack(conv_p)
    new_k_p = jnp.stack(kp)
    new_v_p = jnp.stack(vp)
    new_idx_k_p = jnp.stack(ikp)
    new_ffn_conv_p = jnp.stack(ffn_p)
    new_conv_mix_s = jnp.stack(conv_s)
    new_k_s = jnp.stack(ks_)
    new_v_s = jnp.stack(vs_)
    new_idx_k_s = jnp.stack(iks)
    new_ffn_conv_s = jnp.stack(ffn_s)
    return (xp, xs, new_conv_mix_p, new_k_p, new_v_p, new_idx_k_p, new_ffn_conv_p,
            new_conv_mix_s, new_k_s, new_v_s, new_idx_k_s, new_ffn_conv_s)
```

```cpp
#include <hip/hip_runtime.h>
#include <cstdio>
#include <cstdint>
#include <cmath>
namespace pg8 {
#define PG8_LAS __attribute__((address_space(3)))
typedef unsigned short bf16_t;
typedef short bf16x8 __attribute__((ext_vector_type(8)));
typedef float f32x4 __attribute__((ext_vector_type(4)));
typedef unsigned u32x4 __attribute__((ext_vector_type(4)));
constexpr int BM = 256, BK = 64, HALF = 128, HTB = HALF * BK * 2  , STAGE_BYTES = 8 * HTB, NXCD = 8, WGM = 8;

__host__ __device__ __forceinline__ int lds_byte(int r, int c) { const int st = (r >> 4) * 2 + (c >> 5), rr = r & 15, cc = c & 31, ob = rr * 64 + cc * 2; return st * 1024 + (ob ^ (((ob >> 9) & 1) << 5)); }
__host__ __device__ __forceinline__ void stage_rc(int b, int& R, int& C) { const int st = b / 1024, sb = b % 1024, swz = sb ^ (((sb >> 9) & 1) << 5); R = (st >> 1) * 16 + swz / 64; C = (st & 1) * 32 + (swz % 64) / 2; }
__host__ __device__ __forceinline__ int perm32(int rho) { const int n = rho >> 4, i = rho & 15; return 8 * (i >> 2) + 4 * n + (i & 3); }

struct Unit { int pm, pn; };
struct Gemm { const __attribute__((address_space(1))) bf16_t* A; const __attribute__((address_space(1))) bf16_t* Bt; int M, N, K; };

struct StaticOrder {
    int nM, nN, nwg, G, c;
    __host__ __device__ void init(int M, int N, int G_, int c_) { nM = M / BM; nN = N / BM; nwg = nM * nN; G = G_; c = c_; }
    __host__ __device__ bool next(int i, Unit& u) const {
        const long L = (long)i * G + c; if (L >= nwg) return false;
        int wgid = (int)L; { const int q = nwg / NXCD, r = nwg % NXCD, xcd = wgid % NXCD, off = wgid / NXCD; wgid = (xcd < r ? xcd * (q + 1) : r * (q + 1) + (xcd - r) * q) + off; }
        const int nig = WGM * nN, gid = wgid / nig, fm = gid * WGM, gsz = (nM - fm) < WGM ? (nM - fm) : WGM;
        u.pm = fm + ((wgid % nig) % gsz); u.pn = (wgid % nig) / gsz; return true;
    }
    __device__ __forceinline__ void a_ready(const Unit&) const {}
    __device__ __forceinline__ void done(const Unit&) const {}
};

}
namespace pg8 {
#define PG8_GAS __attribute__((address_space(1)))
__device__ __forceinline__ unsigned cvt_pk_bf16(float lo, float hi) { unsigned r; asm volatile("v_cvt_pk_bf16_f32 %0, %1, %2" : "=v"(r) : "v"(lo), "v"(hi)); return r; }
struct EpiBf16P {
    static constexpr bool AFTER_DRAIN = false; __device__ __forceinline__ bool perm() const { return true; }
    PG8_GAS bf16_t* O; int ldc;
    __device__ __forceinline__ void operator()(const f32x4 (&acc)[2][2][4][2], const Unit& u, int wr, int wc, int fr, int fq) const {
        const int row0 = u.pm * BM + wr * 64 + fr, col0 = u.pn * BM + wc * 32 + 8 * fq;
#pragma unroll
        for (int ai = 0; ai < 2; ++ai)
#pragma unroll
            for (int m = 0; m < 4; ++m) { PG8_GAS bf16_t* rowp = O + (size_t)(row0 + ai * HALF + m * 16) * ldc + col0;
#pragma unroll
                for (int bj = 0; bj < 2; ++bj) { const f32x4 v0 = acc[ai][bj][m][0], v1 = acc[ai][bj][m][1];
                    u32x4 w; w.x = cvt_pk_bf16(v0[0], v0[1]); w.y = cvt_pk_bf16(v0[2], v0[3]); w.z = cvt_pk_bf16(v1[0], v1[1]); w.w = cvt_pk_bf16(v1[2], v1[3]);
                    *(PG8_GAS u32x4*)(rowp + bj * HALF) = w; } }
    }
};
struct EpiF32R {
    static constexpr bool AFTER_DRAIN = false; __device__ __forceinline__ bool perm() const { return false; }
    PG8_GAS float* Y; const PG8_GAS float* X0; const PG8_GAS float* X1; int split; int ldc; float alpha;
    __device__ __forceinline__ void operator()(const f32x4 (&acc)[2][2][4][2], const Unit& u, int wr, int wc, int fr, int fq) const {
        const int row0 = u.pm * BM + wr * 64 + fr, col0 = u.pn * BM + wc * 32 + 4 * fq;
#pragma unroll
        for (int ai = 0; ai < 2; ++ai)
#pragma unroll
            for (int m = 0; m < 4; ++m) { const int row = row0 + ai * HALF + m * 16;
                const PG8_GAS float* xr = (row < split ? X0 + (size_t)row * ldc : X1 + (size_t)(row - split) * ldc) + col0; PG8_GAS float* yr = Y + (size_t)row * ldc + col0;
#pragma unroll
                for (int bj = 0; bj < 2; ++bj)
#pragma unroll
                    for (int n = 0; n < 2; ++n) { const f32x4 x = *(const PG8_GAS f32x4*)(xr + bj * HALF + n * 16); *(PG8_GAS f32x4*)(yr + bj * HALF + n * 16) = x * alpha + acc[ai][bj][m][n]; }
                asm volatile("" ::: "memory"); }
    }
};

struct EpiDual {
    static constexpr bool AFTER_DRAIN = false;
    int mode; PG8_GAS bf16_t* O; int ldo; PG8_GAS float* Y; const PG8_GAS float* X0; const PG8_GAS float* X1; int split; int ldc; float alpha;
    __device__ __forceinline__ bool perm() const { return mode == 0; }
    __device__ __forceinline__ void operator()(const f32x4 (&acc)[2][2][4][2], const Unit& u, int wr, int wc, int fr, int fq) const {
        if (mode == 0) { EpiBf16P e{O, ldo}; e(acc, u, wr, wc, fr, fq); } else { EpiF32R e{Y, X0, X1, split, ldc, alpha}; e(acc, u, wr, wc, fr, fq); }
    }
};
}
namespace pg8 {
template <class Epi, class Sched, bool ALIGN_EPI = false, bool SP2 = false>
__device__ __forceinline__ void gemm_phase(PG8_LAS unsigned char* lds, const Gemm g, const Sched& S, const Epi& E, const int tid) {
    const int wid = __builtin_amdgcn_readfirstlane(tid >> 6), lane = tid & 63, wr = wid >> 2, wc = wid & 3, fr = lane & 15, fq = lane >> 4;
    const int K = g.K, nt = K / BK;
    unsigned voffA[2], voffB[2];
#pragma unroll
    for (int i = 0; i < 2; ++i) { int R, C; stage_rc(tid * 16 + i * 8192, R, C); const int Rb = E.perm() ? ((R & ~31) + perm32(R & 31)) : R;
        voffA[i] = (unsigned)(R * K + C) * 2u; voffB[i] = (unsigned)(Rb * K + C) * 2u; }
    const size_t kstep = (size_t)(BK * 2);
    const size_t hstep = (size_t)HALF * K * 2;
    const size_t tstep = 2 * hstep;
    const unsigned ldsw = (unsigned)wid * 1024u;
    const int aoff = lds_byte(wr * 64 + fr, fq * 8), boff = lds_byte(wc * 32 + fr, fq * 8);
#define PG8_SA(b, h) (((b) * 2 + (h)) * HTB)
#define PG8_SB(b, h) ((4 + (b) * 2 + (h)) * HTB)
#define PG8_STAGE(bufoff, gbase, voff) do { _Pragma("unroll") for (int _i = 0; _i < 2; ++_i) \
        __builtin_amdgcn_global_load_lds((const unsigned*)((const char*)(gbase) + (voff)[_i]), (PG8_LAS unsigned*)(lds + (bufoff) + ldsw + _i * 8192), 16, 0, 0); } while (0)
#define PG8_LDA(dst, b, h) do { _Pragma("unroll") for (int m = 0; m < 4; ++m) _Pragma("unroll") for (int k = 0; k < 2; ++k) dst[m][k] = *(const PG8_LAS bf16x8*)(lds + PG8_SA(b, h) + aoff + m * 2048 + k * 1024); } while (0)
#define PG8_LDB(dst, b, h) do { _Pragma("unroll") for (int n = 0; n < 2; ++n) _Pragma("unroll") for (int k = 0; k < 2; ++k) dst[n][k] = *(const PG8_LAS bf16x8*)(lds + PG8_SB(b, h) + boff + n * 2048 + k * 1024); } while (0)
#define PG8_MMA(ai, bj, At, Bt) do { __builtin_amdgcn_s_setprio(1); _Pragma("unroll") for (int m = 0; m < 4; ++m) _Pragma("unroll") for (int n = 0; n < 2; ++n) _Pragma("unroll") for (int k = 0; k < 2; ++k) \
        acc[ai][bj][m][n] = __builtin_amdgcn_mfma_f32_16x16x32_bf16(Bt[n][k], At[m][k], acc[ai][bj][m][n], 0, 0, 0); __builtin_amdgcn_s_setprio(0); } while (0)
#define PG8_WAIT_V(n) asm volatile("s_waitcnt vmcnt(" #n ")" ::: "memory")
#define PG8_WAIT_L(n) asm volatile("s_waitcnt lgkmcnt(" #n ")" ::: "memory")
#define PG8_BAR __builtin_amdgcn_s_barrier()
#define PG8_SCHED __builtin_amdgcn_sched_barrier(0)
    Unit cur, nxt; int ui = 0;
    if (!S.next(0, cur)) return;
    f32x4 acc[2][2][4][2];
#pragma unroll
    for (int a = 0; a < 2; ++a)
#pragma unroll
        for (int b = 0; b < 2; ++b)
#pragma unroll
            for (int m = 0; m < 4; ++m)
#pragma unroll
                for (int n = 0; n < 2; ++n) acc[a][b][m][n] = (f32x4){0.f, 0.f, 0.f, 0.f};
    bf16x8 At[4][2], B0[2][2], B1[2][2];
    const char* cA = (const char*)g.A + (size_t)cur.pm * tstep; const char* cB = (const char*)g.Bt + (size_t)cur.pn * tstep;
    S.a_ready(cur);
    if constexpr (SP2) {
        PG8_STAGE(PG8_SB(0, 0), cB, voffB); PG8_STAGE(PG8_SB(0, 1), cB + hstep, voffB); PG8_STAGE(PG8_SA(0, 0), cA, voffA); PG8_STAGE(PG8_SA(0, 1), cA + hstep, voffA);
        if (wr == 1) PG8_BAR;
        PG8_WAIT_V(2); PG8_BAR;
        PG8_STAGE(PG8_SB(1, 0), cB + kstep, voffB); PG8_STAGE(PG8_SA(1, 0), cA + kstep, voffA); PG8_STAGE(PG8_SB(1, 1), cB + hstep + kstep, voffB);
        PG8_WAIT_V(6); PG8_BAR;
    } else {
        PG8_STAGE(PG8_SB(0, 0), cB, voffB); PG8_STAGE(PG8_SA(0, 0), cA, voffA); PG8_STAGE(PG8_SB(0, 1), cB + hstep, voffB); PG8_STAGE(PG8_SA(0, 1), cA + hstep, voffA);
        if (wr == 1) PG8_BAR;
        PG8_WAIT_V(4); PG8_BAR;
        PG8_STAGE(PG8_SB(1, 0), cB + kstep, voffB); PG8_STAGE(PG8_SA(1, 0), cA + kstep, voffA); PG8_STAGE(PG8_SB(1, 1), cB + hstep + kstep, voffB);
        PG8_WAIT_V(6); PG8_BAR;
    }
    for (;;) {
        const bool has_next = S.next(ui + 1, nxt);
        const char* nA = has_next ? (const char*)g.A + (size_t)nxt.pm * tstep : cA; const char* nB = has_next ? (const char*)g.Bt + (size_t)nxt.pn * tstep : cB;
        for (int t = 0; t < nt; t += 2) {
            const bool last = (t == nt - 2);
            const char* a1 = cA + (size_t)(t + 1) * kstep;
            const char* a2 = last ? nA : cA + (size_t)(t + 2) * kstep; const char* b2 = last ? nB : cB + (size_t)(t + 2) * kstep;
            const char* a3 = a2 + kstep; const char* b3 = b2 + kstep;
            if (last && has_next) S.a_ready(nxt);
            if constexpr (SP2) {
            PG8_LDB(B0, 0, 0); PG8_LDB(B1, 0, 1); PG8_SCHED; PG8_LDA(At, 0, 0); PG8_STAGE(PG8_SA(1, 1), a1 + hstep, voffA);
            PG8_WAIT_V(8); PG8_WAIT_L(0); PG8_BAR; PG8_MMA(0, 0, At, B0); PG8_MMA(0, 1, At, B1); PG8_BAR; PG8_SCHED;
            PG8_LDA(At, 0, 1); PG8_STAGE(PG8_SB(0, 0), b2, voffB); PG8_STAGE(PG8_SB(0, 1), b2 + hstep, voffB); PG8_STAGE(PG8_SA(0, 0), a2, voffA);
            PG8_WAIT_V(8); PG8_WAIT_L(0); PG8_BAR; PG8_MMA(1, 0, At, B0); PG8_MMA(1, 1, At, B1); PG8_BAR; PG8_SCHED;
            PG8_LDB(B0, 1, 0); PG8_LDB(B1, 1, 1); PG8_SCHED; PG8_LDA(At, 1, 0); PG8_STAGE(PG8_SA(0, 1), a2 + hstep, voffA);
            PG8_WAIT_V(8); PG8_WAIT_L(0); PG8_BAR; PG8_MMA(0, 0, At, B0); PG8_MMA(0, 1, At, B1); PG8_BAR; PG8_SCHED;
            PG8_LDA(At, 1, 1); PG8_STAGE(PG8_SB(1, 0), b3, voffB); PG8_STAGE(PG8_SB(1, 1), b3 + hstep, voffB); PG8_STAGE(PG8_SA(1, 0), a3, voffA);
            PG8_WAIT_V(8); PG8_WAIT_L(0); PG8_BAR; PG8_MMA(1, 0, At, B0); PG8_MMA(1, 1, At, B1); PG8_BAR; PG8_SCHED;
            } else {
            PG8_LDB(B0, 0, 0); PG8_SCHED; PG8_LDA(At, 0, 0); PG8_STAGE(PG8_SA(1, 1), a1 + hstep, voffA);
            PG8_WAIT_L(8); PG8_BAR; PG8_WAIT_L(0); PG8_MMA(0, 0, At, B0); PG8_BAR; PG8_SCHED;
            PG8_LDB(B1, 0, 1); PG8_STAGE(PG8_SB(0, 0), b2, voffB);
            PG8_BAR; PG8_WAIT_L(0); PG8_MMA(0, 1, At, B1); PG8_BAR;
            PG8_LDA(At, 0, 1); PG8_STAGE(PG8_SA(0, 0), a2, voffA);
            PG8_BAR; PG8_WAIT_L(0); PG8_MMA(1, 0, At, B0); PG8_BAR; PG8_SCHED;
            PG8_STAGE(PG8_SB(0, 1), b2 + hstep, voffB);
            PG8_WAIT_V(6); PG8_BAR; PG8_MMA(1, 1, At, B1); PG8_BAR;
            PG8_LDB(B0, 1, 0); PG8_SCHED; PG8_LDA(At, 1, 0); PG8_STAGE(PG8_SA(0, 1), a2 + hstep, voffA);
            PG8_WAIT_L(8); PG8_BAR; PG8_WAIT_L(0); PG8_MMA(0, 0, At, B0); PG8_BAR; PG8_SCHED;
            PG8_LDB(B1, 1, 1); PG8_STAGE(PG8_SB(1, 0), b3, voffB);
            PG8_BAR; PG8_WAIT_L(0); PG8_MMA(0, 1, At, B1); PG8_BAR;
            PG8_LDA(At, 1, 1); PG8_STAGE(PG8_SA(1, 0), a3, voffA);
            PG8_BAR; PG8_WAIT_L(0); PG8_MMA(1, 0, At, B0); PG8_BAR; PG8_SCHED;
            PG8_STAGE(PG8_SB(1, 1), b3 + hstep, voffB);
            PG8_WAIT_V(6); PG8_BAR; PG8_MMA(1, 1, At, B1); PG8_BAR;
            }
        }
        if constexpr (ALIGN_EPI) { if (wr == 0) PG8_BAR; }
        if constexpr (!Epi::AFTER_DRAIN) { E(acc, cur, wr, wc, fr, fq); S.done(cur); }
        if (!has_next) break;
#pragma unroll
        for (int a = 0; a < 2; ++a)
#pragma unroll
            for (int b = 0; b < 2; ++b)
#pragma unroll
                for (int m = 0; m < 4; ++m)
#pragma unroll
                    for (int n = 0; n < 2; ++n) acc[a][b][m][n] = (f32x4){0.f, 0.f, 0.f, 0.f};
        cur = nxt; cA = nA; cB = nB; ++ui;
        if constexpr (ALIGN_EPI) { if (wr == 1) PG8_BAR; }
    }
    PG8_WAIT_V(0);
    if constexpr (!ALIGN_EPI) { if (wr == 0) PG8_BAR; }
    PG8_BAR;
    if constexpr (Epi::AFTER_DRAIN) { E.fused(acc, cur, wr, wc, fr, fq, lds, wid, lane); S.done(cur); }
#undef PG8_SA
#undef PG8_SB
#undef PG8_STAGE
#undef PG8_LDA
#undef PG8_LDB
#undef PG8_MMA
#undef PG8_WAIT_V
#undef PG8_WAIT_L
#undef PG8_BAR
#undef PG8_SCHED
}
}
#define GAS __attribute__((address_space(1)))
#define LAS __attribute__((address_space(3)))
typedef unsigned short bf16;
typedef unsigned v4u __attribute__((ext_vector_type(4)));
typedef float f32x4 __attribute__((ext_vector_type(4)));
typedef short bf16x8 __attribute__((ext_vector_type(8)));
typedef GAS unsigned gu32;
typedef GAS unsigned long long gu64;
#define RLX_AGENT __ATOMIC_RELAXED, __HIP_MEMORY_SCOPE_AGENT
#define LDS_WAIT() asm volatile("s_waitcnt lgkmcnt(0)" ::: "memory")
#define VM_WAIT() asm volatile("s_waitcnt vmcnt(0)" ::: "memory")
__device__ __forceinline__ unsigned long long rt() { return __builtin_amdgcn_s_memrealtime(); }
__device__ __forceinline__ unsigned f2bf(float f) { unsigned u = __builtin_bit_cast(unsigned, f); return (u + 0x7fffu + ((u >> 16) & 1u)) >> 16; }
__device__ __forceinline__ unsigned pk2(float lo, float hi) { return f2bf(lo) | (f2bf(hi) << 16); }
#define XB_TMO      128
#define XB_XCNT(j)  (256  + 64 * (j))
#define XB_XSUB(j)  (1280 + 64 * (j))
#define XB_XGEN(j)  (2304 + 64 * (j))
#define XB_TOP      3328
#define XB_TOPGEN   3392
#define XCD_BAR_WORDS 3456
#define XB_SPIN_CAP (1u << 18)

__device__ __forceinline__ unsigned xb_ld(unsigned* p)              { return __hip_atomic_load(p, __ATOMIC_RELAXED, __HIP_MEMORY_SCOPE_AGENT); }
__device__ __forceinline__ unsigned xb_add(unsigned* p, unsigned v) { return __hip_atomic_fetch_add(p, v, __ATOMIC_RELAXED, __HIP_MEMORY_SCOPE_AGENT); }
__device__ __forceinline__ unsigned xb_xcc_id() { return (unsigned)__builtin_amdgcn_s_getreg((3 << 11) | 20) & 0xFu; }
#define XB_SPIN(cond, bar) do { unsigned _sp = 0; while (cond) { __builtin_amdgcn_s_sleep(1); \
    if ((++_sp & 255u) == 0u) { if (xb_ld(&(bar)[XB_TMO])) break; if (_sp > XB_SPIN_CAP) { atomicAdd(&(bar)[XB_TMO], 1u); break; } } } } while (0)

struct XcdBarrier {
    unsigned* bar; unsigned x;
    volatile LAS unsigned* st;
};

__device__ __forceinline__ XcdBarrier xcd_barrier_post(unsigned* bar, volatile LAS unsigned* st) {
    XcdBarrier b; b.bar = bar; b.x = xb_xcc_id(); b.st = st;
    if (threadIdx.x == 0) (void)xb_add(&bar[XB_XCNT(b.x)], 1u);
    return b;
}
__device__ __forceinline__ void xcd_barrier_complete(unsigned* bar, unsigned x, unsigned& nloc, unsigned& nx) {
    const unsigned G = gridDim.x * gridDim.y * gridDim.z;
    unsigned sum, cnt, mine, sp = 0u;
    for (;;) {
        sum = 0u; cnt = 0u; mine = 0u;
#pragma unroll
        for (unsigned j = 0; j < 16; ++j) { const unsigned c = xb_ld(&bar[XB_XCNT(j)]); sum += c; cnt += (c > 0u) ? 1u : 0u; mine = (j == x) ? c : mine; }
        if (sum == G) break;
        __builtin_amdgcn_s_sleep(1);
        if ((++sp & 255u) == 0u) { if (xb_ld(&bar[XB_TMO])) break; if (sp > XB_SPIN_CAP) { atomicAdd(&bar[XB_TMO], 1u); break; } }
    }
    nloc = mine > 0u ? mine : 1u; nx = cnt > 0u ? cnt : 1u;
}

__device__ __forceinline__ void xcd_barrier(const XcdBarrier& b, const int tid_) {
    asm volatile("s_waitcnt vmcnt(0)" ::: "memory");
    __syncthreads();
    if (tid_ == 0) {
        unsigned* bar = b.bar;
        __builtin_amdgcn_s_waitcnt(0);
        unsigned nloc = b.st[0], nx = b.st[1];
        if (nloc == 0u) { xcd_barrier_complete(bar, b.x, nloc, nx); b.st[0] = nloc; b.st[1] = nx; }
        const unsigned old = xb_add(&bar[XB_XSUB(b.x)], 1u);
        const unsigned gen = old / nloc;
        if (old + 1u == (gen + 1u) * nloc) {
            __builtin_amdgcn_fence(__ATOMIC_RELEASE, "agent");
            asm volatile("s_waitcnt vmcnt(0)" ::: "memory");
            const unsigned og = xb_add(&bar[XB_TOP], 1u);
            const unsigned tg = og / nx;
            if (og + 1u == (tg + 1u) * nx) xb_add(&bar[XB_TOPGEN], 1u);
            else XB_SPIN(xb_ld(&bar[XB_TOPGEN]) == tg, bar);
            __builtin_amdgcn_fence(__ATOMIC_ACQUIRE, "agent");
            xb_add(&bar[XB_XGEN(b.x)], 1u);
            asm volatile("s_waitcnt vmcnt(0)" ::: "memory");
        } else {
            XB_SPIN(xb_ld(&bar[XB_XGEN(b.x)]) == gen, bar);
            __builtin_amdgcn_fence(__ATOMIC_ACQUIRE, "agent");
            asm volatile("s_waitcnt vmcnt(0)" ::: "memory");
        }
    }
    __syncthreads();
}

constexpr int NWAVES = 8, NTHR = 512;
constexpr int DM = 2048, NPROW = 8192, MROWS = 10240, SEQ = 4096, DSEQ = 64, PAST = 2048, LSK = 2112, DFF = 5632;
constexpr int NBCV = 6144, NGU = 11264, NPROJ = 5376, NATT = 5264, KVW = 512, IDXD = 128;
constexpr int SCS_LD = 2304;
constexpr float LN_EPS = 1e-5f, DN_ALPHA = 1.4142135623730951f, ATTN_SC2 = 0.08838834764831845f * 1.4426950408889634f, IDX_W_SCALE = 0.022097086912079608f;
constexpr size_t O_YP = 0, O_YS = 16777216, O_CMP = 20971520, O_KP = 20979712, O_VP = 25174016, O_IKP = 29368320, O_FCP = 30416896,
                 O_CMS = 30461952, O_KS = 30593024, O_VS = 31641600, O_IKS = 32690176, O_FCS = 32952320, O_END = 33673216;
constexpr size_t MiB = 1u << 20;
constexpr size_t WS_CTL = 0, CTL_ZERO_BYTES = 1 * MiB;
constexpr size_t WS_WMI = 1 * MiB, WS_WMO = 25 * MiB, WS_WAI = 33 * MiB, WS_WAO = 54 * MiB, WS_WF1 = 62 * MiB, WS_WF2 = 150 * MiB;
constexpr size_t WF1_STRIDE = 44 * MiB, WF2_STRIDE = 22 * MiB;
constexpr size_t WS_XB = 194 * MiB, WS_XF = 234 * MiB, WS_Y = 314 * MiB, WS_BIG = 394 * MiB, WS_H = 614 * MiB, WS_END = 724 * MiB;
constexpr size_t WS_KP = 1 * MiB, WS_VP = 9 * MiB, WS_IKP = 17 * MiB, WS_IW = 19 * MiB, WS_SEL = 20 * MiB;
constexpr size_t WS_IKS = 62 * MiB;
constexpr size_t WS_KS = 314 * MiB;
constexpr size_t WS_PROJ = 394 * MiB, WS_SCP = 394 * MiB, WS_SCS = 522 * MiB, WS_VS = 548 * MiB;
constexpr size_t WS_QR = 614 * MiB, WS_IQ = 654 * MiB;
constexpr int CW_BAR = 4096;

typedef const GAS float* gcf; typedef GAS float* gf; typedef const GAS bf16* gcb; typedef GAS bf16* gb; typedef const GAS int* gci; typedef GAS int* gi;
typedef float f32x16 __attribute__((ext_vector_type(16)));
typedef float f32x2 __attribute__((ext_vector_type(2)));
__device__ __forceinline__ float bflo(unsigned w) { return __uint_as_float(w << 16); }
__device__ __forceinline__ float bfhi(unsigned w) { return __uint_as_float(w & 0xffff0000u); }
__device__ __forceinline__ float bf1(bf16 h) { return __uint_as_float((unsigned)h << 16); }
__device__ __forceinline__ void unpack8(const v4u w, float (&f)[8]) { f[0] = bflo(w.x); f[1] = bfhi(w.x); f[2] = bflo(w.y); f[3] = bfhi(w.y); f[4] = bflo(w.z); f[5] = bfhi(w.z); f[6] = bflo(w.w); f[7] = bfhi(w.w); }
__device__ __forceinline__ v4u pack8(const float (&f)[8]) { v4u o; o.x = pk2(f[0], f[1]); o.y = pk2(f[2], f[3]); o.z = pk2(f[4], f[5]); o.w = pk2(f[6], f[7]); return o; }
__device__ __forceinline__ void ldf8(gcf p, float (&f)[8]) { const f32x4 a = *(const GAS f32x4*)p, b = *(const GAS f32x4*)(p + 4); f[0] = a.x; f[1] = a.y; f[2] = a.z; f[3] = a.w; f[4] = b.x; f[5] = b.y; f[6] = b.z; f[7] = b.w; }
__device__ __forceinline__ void stf8(gf p, const float (&f)[8]) { *(GAS f32x4*)p = (f32x4){f[0], f[1], f[2], f[3]}; *(GAS f32x4*)(p + 4) = (f32x4){f[4], f[5], f[6], f[7]}; }
__device__ __forceinline__ float shfl_f(float v, int src) { return __int_as_float(__builtin_amdgcn_ds_bpermute(src << 2, __float_as_int(v))); }
__device__ __forceinline__ float wave_sum(float v, int lane) {
#pragma unroll
    for (int o = 1; o < 64; o <<= 1) v += shfl_f(v, lane ^ o);
    return v;
}
__device__ __forceinline__ int wave_sum_i(int v, int lane) {
#pragma unroll
    for (int o = 1; o < 64; o <<= 1) v += __builtin_amdgcn_ds_bpermute((lane ^ o) << 2, v);
    return v;
}

__device__ __forceinline__ void transpose_item(gcf W, int K, int N, int Npad, gb WT, LAS float* scr, int item, int lane) {
    const int nblk = Npad / 32, kb = item / nblk, nb = item - kb * nblk, k0 = 64 * kb, n0 = 32 * nb;
    const int ncol = n0 + (lane & 31); const bool okc = ncol < N; const int nc = okc ? ncol : N - 1;
#pragma unroll 8
    for (int i = 0; i < 32; ++i) { const int kk = 2 * i + (lane >> 5); const float v = W[(size_t)(k0 + kk) * N + nc]; scr[kk * 33 + (lane & 31)] = okc ? v : 0.f; }
    LDS_WAIT(); asm volatile("" ::: "memory");
    const int c = lane & 7;
#pragma unroll
    for (int j = 0; j < 4; ++j) { const int n = (lane >> 3) + 8 * j; const LAS float* s = scr + (8 * c) * 33 + n;
        v4u o; o.x = pk2(s[0 * 33], s[1 * 33]); o.y = pk2(s[2 * 33], s[3 * 33]); o.z = pk2(s[4 * 33], s[5 * 33]); o.w = pk2(s[6 * 33], s[7 * 33]);
        *(GAS v4u*)(WT + (size_t)(n0 + n) * K + k0 + 8 * c) = o; }
    LDS_WAIT(); asm volatile("" ::: "memory");
}
__device__ __forceinline__ void cvt_rows(gcf src, gb dst, int cps, size_t dstride, int total, int gt, int GT) {
    for (int e = gt; e < total; e += GT) { const int sb = e / cps, rem = e - sb * cps; float f[8]; ldf8(src + (size_t)e * 8, f); *(GAS v4u*)(dst + (size_t)sb * dstride + (size_t)rem * 8) = pack8(f); }
}

__device__ __forceinline__ void conv_mix_phase(gcb BCV, gb Z, gcf cw, gcf state, gf out, int gt, int GT) {
    for (int task = gt; task < (MROWS / 16) * 256; task += GT) {
        const int cg = task & 255, seg = task >> 8, row0 = seg * 16, c0 = cg * 8;
        const bool is_s = row0 >= NPROW; const int tl = is_s ? ((row0 - NPROW) & 63) : (row0 & 4095); const int sb = is_s ? ((row0 - NPROW) >> 6) : (row0 >> 12); const int T = is_s ? DSEQ : SEQ;
        float w0[8], w1[8], w2[8]; ldf8(cw + c0, w0); ldf8(cw + DM + c0, w1); ldf8(cw + 2 * DM + c0, w2);
        float um2[8], um1[8];
        if (tl == 0) {
            if (is_s) { ldf8(state + (size_t)(sb * 2 + 0) * DM + c0, um2); ldf8(state + (size_t)(sb * 2 + 1) * DM + c0, um1); }
            else {
#pragma unroll
                for (int e = 0; e < 8; ++e) { um2[e] = 0.f; um1[e] = 0.f; } }
        } else {
            float c8[8], v8[8];
            gcb p2 = BCV + (size_t)(row0 - 2) * NBCV + c0; unpack8(*(const GAS v4u*)(p2 + DM), c8); unpack8(*(const GAS v4u*)(p2 + 2 * DM), v8);
#pragma unroll
            for (int e = 0; e < 8; ++e) um2[e] = c8[e] * v8[e];
            gcb p1 = p2 + NBCV; unpack8(*(const GAS v4u*)(p1 + DM), c8); unpack8(*(const GAS v4u*)(p1 + 2 * DM), v8);
#pragma unroll
            for (int e = 0; e < 8; ++e) um1[e] = c8[e] * v8[e];
        }
#pragma unroll 4
        for (int r = 0; r < 16; ++r) {
            const int row = row0 + r; gcb p = BCV + (size_t)row * NBCV + c0;
            float b8[8], c8[8], v8[8], u[8], z[8];
            unpack8(*(const GAS v4u*)p, b8); unpack8(*(const GAS v4u*)(p + DM), c8); unpack8(*(const GAS v4u*)(p + 2 * DM), v8);
#pragma unroll
            for (int e = 0; e < 8; ++e) { u[e] = c8[e] * v8[e]; z[e] = b8[e] * (w0[e] * um2[e] + w1[e] * um1[e] + w2[e] * u[e]); }
            *(GAS v4u*)(Z + (size_t)row * DM + c0) = pack8(z);
            const int j = tl + r - (T - 2);
            if (j >= 0) stf8(out + (is_s ? O_CMS : O_CMP) + (size_t)(sb * 2 + j) * DM + c0, u);
#pragma unroll
            for (int e = 0; e < 8; ++e) { um2[e] = um1[e]; um1[e] = u[e]; }
        }
    }
}
__device__ __forceinline__ void conv_glu_phase(gcb GU, gb H, gcf cw, gcf cb, gcf state, gf out, int layer, int gt, int GT) {
    constexpr int NCG = DFF / 8;
    for (int task = gt; task < (MROWS / 16) * NCG; task += GT) {
        const int seg = task / NCG, cg = task - seg * NCG, row0 = seg * 16, c0 = cg * 8;
        const bool is_s = row0 >= NPROW; const int tl = is_s ? ((row0 - NPROW) & 63) : (row0 & 4095); const int sb = is_s ? ((row0 - NPROW) >> 6) : (row0 >> 12); const int T = is_s ? DSEQ : SEQ;
        float w0[8], w1[8], w2[8], bb[8]; ldf8(cw + c0, w0); ldf8(cw + DFF + c0, w1); ldf8(cw + 2 * DFF + c0, w2); ldf8(cb + c0, bb);
        float gm2[8], gm1[8];
        if (tl == 0) {
            if (is_s) { ldf8(state + (size_t)(sb * 2 + 0) * DFF + c0, gm2); ldf8(state + (size_t)(sb * 2 + 1) * DFF + c0, gm1); }
            else {
#pragma unroll
                for (int e = 0; e < 8; ++e) { gm2[e] = 0.f; gm1[e] = 0.f; } }
        } else { unpack8(*(const GAS v4u*)(GU + (size_t)(row0 - 2) * NGU + c0), gm2); unpack8(*(const GAS v4u*)(GU + (size_t)(row0 - 1) * NGU + c0), gm1); }
#pragma unroll 4
        for (int r = 0; r < 16; ++r) {
            const int row = row0 + r; gcb p = GU + (size_t)row * NGU + c0;
            float g8[8], u8[8], h[8];
            unpack8(*(const GAS v4u*)p, g8); unpack8(*(const GAS v4u*)(p + DFF), u8);
#pragma unroll
            for (int e = 0; e < 8; ++e) { const float a = w0[e] * gm2[e] + w1[e] * gm1[e] + w2[e] * g8[e] + bb[e];
                const float sg = __builtin_amdgcn_rcpf(1.f + __builtin_amdgcn_exp2f(-a * 1.4426950408889634f)); h[e] = a * sg * u8[e]; }
            *(GAS v4u*)(H + (size_t)row * DFF + c0) = pack8(h);
            const int j = tl + r - (T - 2);
            if (j >= 0) stf8(out + (is_s ? O_FCS + (size_t)((layer * 32 + sb) * 2 + j) * DFF : O_FCP + (size_t)((layer * 2 + sb) * 2 + j) * DFF) + c0, g8);
#pragma unroll
            for (int e = 0; e < 8; ++e) { gm2[e] = gm1[e]; gm1[e] = g8[e]; }
        }
    }
}
__device__ __forceinline__ void ln_phase(gcf Y, gcf g, gcf b, gf XF, gb XB, int gw, int NGW, int lane) {
    for (int row = gw; row < MROWS; row += NGW) {
        const GAS f32x4* yr = (const GAS f32x4*)(Y + (size_t)row * DM) + lane;
        f32x4 v[8]; float s = 0.f;
#pragma unroll
        for (int j = 0; j < 8; ++j) { v[j] = yr[64 * j]; s += (v[j].x + v[j].y) + (v[j].z + v[j].w); }
        const float mean = wave_sum(s, lane) * (1.f / DM); float s2 = 0.f;
#pragma unroll
        for (int j = 0; j < 8; ++j) { v[j] = v[j] - mean; s2 += (v[j].x * v[j].x + v[j].y * v[j].y) + (v[j].z * v[j].z + v[j].w * v[j].w); }
        const float rstd = 1.f / sqrtf(wave_sum(s2, lane) * (1.f / DM) + LN_EPS);
        GAS f32x4* xo = (GAS f32x4*)(XF + (size_t)row * DM) + lane;
#pragma unroll
        for (int j = 0; j < 8; ++j) { const f32x4 g4 = ((const GAS f32x4*)g)[lane + 64 * j], b4 = ((const GAS f32x4*)b)[lane + 64 * j]; const f32x4 o = v[j] * rstd * g4 + b4; xo[64 * j] = o;
            if (XB) { GAS unsigned long long* o8 = (GAS unsigned long long*)(XB + (size_t)row * DM) + lane; o8[64 * j] = (unsigned long long)pk2(o.x, o.y) | ((unsigned long long)pk2(o.z, o.w) << 32); } }
    }
}

__device__ __forceinline__ void postproj_phase(gcb PROJ, const __attribute__((address_space(4))) float* inv_freq, gcf kng, gcf knb, gf out,
                                               gb QR, gb IQ, gb KP, gb VP, gb IKP, gb KS, gb VS, gb IKS, gf IW, int gw, int NGW, int lane) {
    const float invf = inv_freq[lane]; const float g1 = kng[lane], g2 = kng[64 + lane], bb1 = knb[lane], bb2 = knb[64 + lane];
    for (int row = gw; row < MROWS; row += NGW) {
        const bool is_s = row >= NPROW; const int sb = is_s ? ((row - NPROW) >> 6) : (row >> 12); const int t = is_s ? ((row - NPROW) & 63) : (row & 4095);
        const int pos = is_s ? PAST + t : t;
        const float ang = (float)pos * invf;
        const double rev = (double)ang * 0.15915494309189535; const float fr = (float)(rev - __builtin_rint(rev));
        const float cs = __builtin_amdgcn_cosf(fr), sn = __builtin_amdgcn_sinf(fr);
        gcb P = PROJ + (size_t)row * NPROJ;
        gb qo = QR + (size_t)row * DM; gb iqo = IQ + (size_t)row * DM;
#pragma unroll 4
        for (int h = 0; h < 16; ++h) {
            const float x1 = bf1(P[h * 128 + lane]), x2 = bf1(P[h * 128 + 64 + lane]);
            qo[h * 128 + lane] = (bf16)f2bf(x1 * cs - x2 * sn); qo[h * 128 + 64 + lane] = (bf16)f2bf(x1 * sn + x2 * cs);
            const float y1 = bf1(P[3072 + h * 128 + lane]), y2 = bf1(P[3072 + h * 128 + 64 + lane]);
            iqo[h * 128 + lane] = (bf16)f2bf(y1 * cs - y2 * sn); iqo[h * 128 + 64 + lane] = (bf16)f2bf(y1 * sn + y2 * cs);
        }
        gf kof = out + (is_s ? O_KS + (size_t)(row - NPROW) * KVW : O_KP + (size_t)row * KVW);
        gf vof = out + (is_s ? O_VS + (size_t)(row - NPROW) * KVW : O_VP + (size_t)row * KVW);
        gb kob = is_s ? KS + ((size_t)sb * LSK + PAST + t) * KVW : KP + (size_t)row * KVW;
        gb vob = is_s ? VS + ((size_t)sb * LSK + PAST + t) * KVW : VP + (size_t)row * KVW;
#pragma unroll
        for (int g = 0; g < 4; ++g) {
            const float x1 = bf1(P[2048 + g * 128 + lane]), x2 = bf1(P[2048 + g * 128 + 64 + lane]);
            const float o1 = x1 * cs - x2 * sn, o2 = x1 * sn + x2 * cs;
            kof[g * 128 + lane] = o1; kof[g * 128 + 64 + lane] = o2; kob[g * 128 + lane] = (bf16)f2bf(o1); kob[g * 128 + 64 + lane] = (bf16)f2bf(o2);
        }
#pragma unroll
        for (int j = 0; j < 8; ++j) { const bf16 hv = P[2560 + j * 64 + lane]; vof[j * 64 + lane] = bf1(hv); vob[j * 64 + lane] = hv; }
        {
            const float x1 = bf1(P[5120 + lane]), x2 = bf1(P[5120 + 64 + lane]);
            const float mean = wave_sum(x1 + x2, lane) * (1.f / 128.f); const float d1 = x1 - mean, d2 = x2 - mean;
            const float rstd = 1.f / sqrtf(wave_sum(d1 * d1 + d2 * d2, lane) * (1.f / 128.f) + LN_EPS);
            const float n1 = d1 * rstd * g1 + bb1, n2 = d2 * rstd * g2 + bb2;
            const float o1 = n1 * cs - n2 * sn, o2 = n1 * sn + n2 * cs;
            gf iof = out + (is_s ? O_IKS + (size_t)(row - NPROW) * IDXD : O_IKP + (size_t)row * IDXD);
            gb iob = is_s ? IKS + ((size_t)sb * LSK + PAST + t) * IDXD : IKP + (size_t)row * IDXD;
            iof[lane] = o1; iof[64 + lane] = o2; iob[lane] = (bf16)f2bf(o1); iob[64 + lane] = (bf16)f2bf(o2);
        }
        if (lane < 16) IW[(size_t)row * 16 + lane] = bf1(P[5248 + lane]) * IDX_W_SCALE;
    }
}

__device__ __forceinline__ void indexer_phase(LAS unsigned char* L, gcb IQ, gcf IW, gcb IKP, gcb IKS, gf SCP, gf SCS,
                                              int vcu, int G, int tid, int lane, int wave) {
    const int r32 = lane & 31, hi = lane >> 5;
    for (int u = vcu; u < 1376; u += G) {
        int qrow0, kt, scld; gcb IKb; gf scb;
        if (u < 1088) { const int b = u / 544; int r = u - b * 544; int gq = 0; while (r >= 4 * (gq + 1)) { r -= 4 * (gq + 1); ++gq; }
            const int c = 4 * gq + r / (gq + 1); kt = r % (gq + 1); qrow0 = b * SEQ + 64 * c; IKb = IKP + (size_t)b * SEQ * IDXD; scb = SCP + (size_t)qrow0 * SEQ; scld = SEQ; }
        else { const int us = u - 1088; const int sb = us / 9; kt = us - sb * 9; qrow0 = NPROW + 64 * sb; IKb = IKS + (size_t)sb * LSK * IDXD; scb = SCS + (size_t)(64 * sb) * SCS_LD; scld = SCS_LD; }
        const int key0 = kt * 256 + 32 * wave;
        pg8::bf16x8 a[8];
#pragma unroll
        for (int ks = 0; ks < 8; ++ks) a[ks] = *(const GAS pg8::bf16x8*)(IKb + (size_t)(key0 + r32) * IDXD + 16 * ks + 8 * hi);
        f32x16 I0, I1;
#pragma unroll
        for (int r = 0; r < 16; ++r) { I0[r] = 0.f; I1[r] = 0.f; }
        const int sq = tid >> 3, sc0 = tid & 7;
        gcb iqsrc = IQ + (size_t)(qrow0 + sq) * DM + sc0 * 8;
        const unsigned wofs0 = (unsigned)(sq * 256 + ((sc0 ^ (sq & 15)) * 16)), wofs1 = (unsigned)(sq * 256 + (((sc0 + 8) ^ (sq & 15)) * 16));
        gcf iw0 = IW + (size_t)(qrow0 + r32) * 16; gcf iw1 = iw0 + 32 * 16;
        v4u st0 = *(const GAS v4u*)iqsrc, st1 = *(const GAS v4u*)(iqsrc + 64);
        float wn0 = iw0[0], wn1 = iw1[0];
        *(LAS v4u*)(L + wofs0) = st0; *(LAS v4u*)(L + wofs1) = st1;
        const unsigned rofs = (unsigned)(r32 * 256), rx = (unsigned)(r32 & 15);
#pragma unroll 1
        for (int h = 0; h < 16; ++h) {
            __syncthreads();
            const float wc0 = wn0, wc1 = wn1;
            if (h < 15) { st0 = *(const GAS v4u*)(iqsrc + (h + 1) * 128); st1 = *(const GAS v4u*)(iqsrc + (h + 1) * 128 + 64); wn0 = iw0[h + 1]; wn1 = iw1[h + 1]; }
            LAS unsigned char* buf = L + (h & 1) * 16384;
            f32x16 S0, S1;
#pragma unroll
            for (int r = 0; r < 16; ++r) { S0[r] = 0.f; S1[r] = 0.f; }
#pragma unroll
            for (int ks = 0; ks < 8; ++ks) {
                const unsigned co = (((unsigned)(2 * ks + hi)) ^ rx) * 16u;
                const pg8::bf16x8 b0 = *(const LAS pg8::bf16x8*)(buf + rofs + co), b1 = *(const LAS pg8::bf16x8*)(buf + 8192 + rofs + co);
                S0 = __builtin_amdgcn_mfma_f32_32x32x16_bf16(a[ks], b0, S0, 0, 0, 0); S1 = __builtin_amdgcn_mfma_f32_32x32x16_bf16(a[ks], b1, S1, 0, 0, 0);
            }
#pragma unroll
            for (int r = 0; r < 16; ++r) { I0[r] += wc0 * fmaxf(S0[r], 0.f); I1[r] += wc1 * fmaxf(S1[r], 0.f); }
            if (h < 15) { LAS unsigned char* nb = L + ((h + 1) & 1) * 16384; *(LAS v4u*)(nb + wofs0) = st0; *(LAS v4u*)(nb + wofs1) = st1; }
        }
#pragma unroll
        for (int j = 0; j < 4; ++j) {
            *(GAS f32x4*)(scb + (size_t)r32 * scld + key0 + 8 * j + 4 * hi) = (f32x4){I0[4 * j], I0[4 * j + 1], I0[4 * j + 2], I0[4 * j + 3]};
            *(GAS f32x4*)(scb + (size_t)(32 + r32) * scld + key0 + 8 * j + 4 * hi) = (f32x4){I1[4 * j], I1[4 * j + 1], I1[4 * j + 2], I1[4 * j + 3]};
        }
        __syncthreads();
    }
}

__device__ __forceinline__ void topk_phase(gcf SCP, gcf SCS, gi SEL, int gw, int NGW, int lane) {
    for (int q = gw; q < MROWS; q += NGW) {
        const bool is_s = q >= NPROW; int Lk; gcf src;
        if (!is_s) { const int t = q & 4095; Lk = ((t >> 6) + 1) * 64; src = SCP + (size_t)q * SEQ; } else { Lk = LSK; src = SCS + (size_t)(q - NPROW) * SCS_LD; }
        gi selq = SEL + (size_t)q * 256;
        if (Lk <= 256) { for (int i = lane; i < Lk; i += 64) selq[i] = i; continue; }
        const int nv = Lk >> 6;
        unsigned key[64];
#pragma unroll
        for (int gI = 0; gI < 8; ++gI) {
            if (nv > gI * 8) {
#pragma unroll
                for (int i = gI * 8; i < gI * 8 + 8; ++i) { const int idx = i * 64 + lane; const bool ok = idx < Lk; const unsigned ub = __float_as_uint(src[ok ? idx : 0]);
                    key[i] = ok ? ((ub & 0x80000000u) ? ~ub : (ub | 0x80000000u)) : 0u; }
            } else {
#pragma unroll
                for (int i = gI * 8; i < gI * 8 + 8; ++i) key[i] = 0u;
            }
        }
        unsigned prefix = 0u; int need = 256;
#pragma unroll 1
        for (int b = 31; b >= 0; --b) {
            const unsigned target = (prefix >> b) | 1u; int c = 0;
#pragma unroll
            for (int gI = 0; gI < 8; ++gI) if (nv > gI * 8) {
#pragma unroll
                for (int i = gI * 8; i < gI * 8 + 8; ++i) c += ((key[i] >> b) == target) ? 1 : 0;
            }
            c = wave_sum_i(c, lane);
            if (c >= need) prefix |= (1u << b); else need -= c;
        }
        int base = 0, eqtaken = 0;
#pragma unroll
        for (int gI = 0; gI < 8; ++gI) if (nv > gI * 8) {
#pragma unroll
            for (int i = gI * 8; i < gI * 8 + 8; ++i) {
                const bool gtb = key[i] > prefix, eqb = key[i] == prefix;
                const unsigned long long be = __ballot(eqb);
                const int eqrank = eqtaken + (int)__builtin_amdgcn_mbcnt_hi((unsigned)(be >> 32), __builtin_amdgcn_mbcnt_lo((unsigned)be, 0u));
                const bool take = gtb || (eqb && eqrank < need);
                const unsigned long long bt = __ballot(take);
                const int pos = base + (int)__builtin_amdgcn_mbcnt_hi((unsigned)(bt >> 32), __builtin_amdgcn_mbcnt_lo((unsigned)bt, 0u));
                if (take && pos < 256) selq[pos] = i * 64 + lane;
                base += __popcll(bt); eqtaken += __popcll(be);
            }
        }
    }
}

__device__ __forceinline__ void attn_phase(gcb QR, gb O, gci SEL, gcb KP, gcb VP, gcb KS, gcb VS, int gw, int NGW, int lane) {
    const int kq = lane & 15, lg = lane >> 4, myg = kq >> 2;
    for (int q = gw; q < MROWS; q += NGW) {
        const bool is_s = q >= NPROW; int nsel; gcb Kb, Vb;
        if (!is_s) { const int b = q >> 12, t = q & 4095; const int Lk = ((t >> 6) + 1) * 64; nsel = Lk < 256 ? Lk : 256; Kb = KP + (size_t)b * SEQ * KVW; Vb = VP + (size_t)b * SEQ * KVW; }
        else { const int sb = (q - NPROW) >> 6; nsel = 256; Kb = KS + (size_t)sb * LSK * KVW; Vb = VS + (size_t)sb * LSK * KVW; }
        const int nkg = nsel >> 4;
        gci selq = SEL + (size_t)q * 256;
        pg8::bf16x8 qf[4];
#pragma unroll
        for (int ks = 0; ks < 4; ++ks) qf[ks] = *(const GAS pg8::bf16x8*)(QR + (size_t)q * DM + kq * 128 + 32 * ks + 8 * lg);
        const pg8::bf16x8 zf = {0, 0, 0, 0, 0, 0, 0, 0};
        f32x4 sc[16];
#pragma unroll
        for (int kg = 0; kg < 16; ++kg) {
            sc[kg] = (f32x4){-INFINITY, -INFINITY, -INFINITY, -INFINITY};
            if (kg < nkg) {
                const int sidx = selq[kg * 16 + kq];
                gcb krow = Kb + (size_t)sidx * KVW + 8 * lg;
                f32x4 acc = {0.f, 0.f, 0.f, 0.f};
#pragma unroll
                for (int g = 0; g < 4; ++g)
#pragma unroll
                    for (int ks = 0; ks < 4; ++ks) {
                        const pg8::bf16x8 kf = *(const GAS pg8::bf16x8*)(krow + g * 128 + 32 * ks);
                        acc = __builtin_amdgcn_mfma_f32_16x16x32_bf16(myg == g ? qf[ks] : zf, kf, acc, 0, 0, 0);
                    }
                sc[kg] = acc;
            }
        }
        float mx[4], sm[4];
#pragma unroll
        for (int r = 0; r < 4; ++r) { float m = sc[0][r];
#pragma unroll
            for (int kg = 1; kg < 16; ++kg) m = fmaxf(m, sc[kg][r]);
            m = fmaxf(m, shfl_f(m, lane ^ 1)); m = fmaxf(m, shfl_f(m, lane ^ 2)); m = fmaxf(m, shfl_f(m, lane ^ 4)); m = fmaxf(m, shfl_f(m, lane ^ 8)); mx[r] = m; sm[r] = 0.f; }
#pragma unroll
        for (int kg = 0; kg < 16; ++kg)
#pragma unroll
            for (int r = 0; r < 4; ++r) { const float p = __builtin_amdgcn_exp2f((sc[kg][r] - mx[r]) * ATTN_SC2); sc[kg][r] = p; sm[r] += p; }
#pragma unroll
        for (int r = 0; r < 4; ++r) { float s = sm[r]; s += shfl_f(s, lane ^ 1); s += shfl_f(s, lane ^ 2); s += shfl_f(s, lane ^ 4); s += shfl_f(s, lane ^ 8); sm[r] = s; }
        int selreg[4];
#pragma unroll
        for (int i = 0; i < 4; ++i) selreg[i] = (i * 64 < nsel) ? selq[i * 64 + lane] : 0;
        float o[4][8];
#pragma unroll
        for (int r = 0; r < 4; ++r)
#pragma unroll
            for (int e = 0; e < 8; ++e) o[r][e] = 0.f;
        gcb vcol = Vb + lane * 8;
#pragma unroll
        for (int kg = 0; kg < 16; ++kg) {
            if (kg < nkg) {
#pragma unroll 4
                for (int kk = 0; kk < 16; ++kk) {
                    const int sidx = __builtin_amdgcn_readlane(selreg[kg >> 2], (kg & 3) * 16 + kk);
                    float v8[8]; unpack8(*(const GAS v4u*)(vcol + (size_t)sidx * KVW), v8);
                    const int srcl = (lane & 48) | kk;
#pragma unroll
                    for (int r = 0; r < 4; ++r) { const float p = shfl_f(sc[kg][r], srcl);
#pragma unroll
                        for (int e = 0; e < 8; ++e) o[r][e] += p * v8[e]; }
                }
            }
        }
#pragma unroll
        for (int r = 0; r < 4; ++r) { const float inv = 1.f / sm[r]; float w8[8];
#pragma unroll
            for (int e = 0; e < 8; ++e) w8[e] = o[r][e] * inv;
            *(GAS v4u*)(O + (size_t)q * DM + (4 * lg + r) * 128 + 8 * kq) = pack8(w8); }
    }
}

constexpr int RING_BYTES = 131072, LDSCTL_OFF = RING_BYTES, MISC_OFF = LDSCTL_OFF + 320, LDS_BYTES = 147456;
struct Args { const float* in[22]; float* out; unsigned char* ws; float inv_freq[64]; };
constexpr int NSTEP = 20;
#ifndef PH_MASK
#define PH_MASK 0x3ff
#endif
#define PHM(k) (((PH_MASK) >> (k)) & 1)

#define PH_ENV \
        int tid; asm volatile("v_mbcnt_lo_u32_b32 %0, -1, 0\n\tv_mbcnt_hi_u32_b32 %0, -1, %0" : "=v"(tid)); tid += wave_s * 64; \
        const __attribute__((address_space(4))) Args* ap = (const __attribute__((address_space(4))) Args*)__builtin_amdgcn_kernarg_segment_ptr(); asm volatile("" : "+s"(ap)); \
        const int lane = tid & 63, wave = wave_s; \
        const int G = gridDim.x, bx = blockIdx.x; const int vcu = (G % 8 == 0) ? (bx % 8) * (G / 8) + bx / 8 : bx; \
        const int gt = vcu * NTHR + tid, GT = G * NTHR, gw = vcu * NWAVES + wave, NGW = G * NWAVES; \
        GAS unsigned char* ws = (GAS unsigned char*)ap->ws; gf out = (gf)ap->out; \
        gcf xp = (gcf)ap->in[0]; gcf xs = (gcf)ap->in[1]; \
        gb WMI = (gb)(ws + WS_WMI); gb WMO = (gb)(ws + WS_WMO); gb WAI = (gb)(ws + WS_WAI); gb WAO = (gb)(ws + WS_WAO); \
        gb WF1 = (gb)(ws + WS_WF1); gb WF2 = (gb)(ws + WS_WF2); \
        gb XB = (gb)(ws + WS_XB); gf XF = (gf)(ws + WS_XF); gf Y = (gf)(ws + WS_Y); gb BIG = (gb)(ws + WS_BIG); gb HB = (gb)(ws + WS_H); \
        gb KP = (gb)(ws + WS_KP); gb VP = (gb)(ws + WS_VP); gb IKP = (gb)(ws + WS_IKP); gf IW = (gf)(ws + WS_IW); gi SEL = (gi)(ws + WS_SEL); \
        gb IKS = (gb)(ws + WS_IKS); gb KS = (gb)(ws + WS_KS); gb VS = (gb)(ws + WS_VS); \
        gf SCP = (gf)(ws + WS_SCP); gf SCS = (gf)(ws + WS_SCS); gb QR = (gb)(ws + WS_QR); gb IQ = (gb)(ws + WS_IQ);
__global__ void __launch_bounds__(NTHR, 2) mega_fwd(Args args) {
    extern __shared__ __attribute__((aligned(16))) unsigned char lds[];
    LAS unsigned char* L = (LAS unsigned char*)lds;
    volatile LAS unsigned* MISC = (volatile LAS unsigned*)(L + MISC_OFF);
    for (int u = threadIdx.x; u < (LDS_BYTES - LDSCTL_OFF) / 4; u += NTHR) ((LAS unsigned*)(L + LDSCTL_OFF))[u] = 0u;
    __syncthreads();
    const int wave_s = __builtin_amdgcn_readfirstlane(threadIdx.x >> 6);
    XcdBarrier bar = xcd_barrier_post((unsigned*)((gu32*)(args.ws + WS_CTL) + CW_BAR), MISC + 8);

#pragma unroll 1
    for (int step = 0; step < NSTEP; ++step) {
        if (PHM(0) && step == 0) {
            PH_ENV
            LAS float* scr = (LAS float*)(L + wave * 16384);
            constexpr int I_MI = 32 * 192, I_MO = 32 * 64, I_AI = 32 * 168, I_AO = 32 * 64, I_F1 = 32 * 352, I_F2 = 88 * 64;
            constexpr int NITEMS = I_MI + I_MO + I_AI + I_AO + 2 * I_F1 + 2 * I_F2;
            for (int it = gw; it < NITEMS; it += NGW) {
                int r = it;
                if (r < I_MI) { transpose_item((gcf)ap->in[7], DM, NBCV, NBCV, WMI, scr, r, lane); continue; } r -= I_MI;
                if (r < I_MO) { transpose_item((gcf)ap->in[9], DM, DM, DM, WMO, scr, r, lane); continue; } r -= I_MO;
                if (r < I_AI) { transpose_item((gcf)ap->in[10], DM, NATT, NPROJ, WAI, scr, r, lane); continue; } r -= I_AI;
                if (r < I_AO) { transpose_item((gcf)ap->in[13], DM, DM, DM, WAO, scr, r, lane); continue; } r -= I_AO;
                if (r < 2 * I_F1) { const int l = r / I_F1; transpose_item((gcf)ap->in[14] + (size_t)l * DM * NGU, DM, NGU, NGU, WF1 + (size_t)l * NGU * DM, scr, r - l * I_F1, lane); continue; } r -= 2 * I_F1;
                { const int l = r / I_F2; transpose_item((gcf)ap->in[17] + (size_t)l * DFF * DM, DFF, DM, DM, WF2 + (size_t)l * DM * DFF, scr, r - l * I_F2, lane); }
            }
            for (int e = gt; e < MROWS * DM / 8; e += GT) { const size_t o = (size_t)e * 8; float f[8]; ldf8(o < (size_t)NPROW * DM ? xp + o : xs + (o - (size_t)NPROW * DM), f); *(GAS v4u*)(XB + o) = pack8(f); }
        } else if (PHM(1) && (step == 1 || step == 5 || step == 9 || step == 16 || step == 3 || step == 7 || step == 14 || step == 18)) {
            PH_ENV
            gcb A = XB; gcb Bt; int N = DM, K = DM, mode = 1; gcf X0 = XF; gcf X1 = XF + (size_t)NPROW * DM;
            if (step == 1) { Bt = WMI; N = NBCV; mode = 0; } else if (step == 5) { Bt = WF1; N = NGU; mode = 0; } else if (step == 9) { Bt = WAI; N = NPROJ; mode = 0; } else if (step == 16) { Bt = WF1 + (size_t)NGU * DM; N = NGU; mode = 0; }
            else if (step == 3) { A = HB; Bt = WMO; X0 = xp; X1 = xs; } else if (step == 7) { A = HB; Bt = WF2; K = DFF; }
            else if (step == 14) { A = QR; Bt = WAO; } else { A = HB; Bt = WF2 + (size_t)DM * DFF; K = DFF; }
            pg8::Gemm g{A, Bt, MROWS, N, K}; pg8::StaticOrder S; S.init(MROWS, N, G, bx);
            pg8::EpiDual E{mode, BIG, N, Y, X0, X1, NPROW, DM, DN_ALPHA};
            pg8::gemm_phase<pg8::EpiDual, pg8::StaticOrder, true, true>(L, g, S, E, tid);
        } else if (PHM(3) && step == 2) {
            PH_ENV
            conv_mix_phase(BIG, HB, (gcf)ap->in[8], (gcf)ap->in[2], out, gt, GT);
        } else if (PHM(4) && (step == 6 || step == 17)) {
            PH_ENV
            const int l = step == 6 ? 0 : 1;
            conv_glu_phase(BIG, HB, (gcf)ap->in[15] + (size_t)l * 3 * DFF, (gcf)ap->in[16] + (size_t)l * DFF, (gcf)ap->in[6] + (size_t)l * 32 * 2 * DFF, out, l, gt, GT);
        } else if (PHM(5) && (step == 4 || step == 8 || step == 15 || step == 19)) {
            PH_ENV
            gcf g_; gcf b_; gf xo = XF; gb xb = XB;
            if (step == 4) { g_ = (gcf)ap->in[18]; b_ = (gcf)ap->in[19]; } else if (step == 8) { g_ = (gcf)ap->in[20]; b_ = (gcf)ap->in[21]; } else if (step == 15) { g_ = (gcf)ap->in[18] + DM; b_ = (gcf)ap->in[19] + DM; }
            else { g_ = (gcf)ap->in[20] + DM; b_ = (gcf)ap->in[21] + DM; xo = out; xb = nullptr; }
            ln_phase(Y, g_, b_, xo, xb, gw, NGW, lane);
        } else if (PHM(6) && step == 10) {
            PH_ENV
            postproj_phase(BIG, ap->inv_freq, (gcf)ap->in[11], (gcf)ap->in[12], out, QR, IQ, KP, VP, IKP, KS, VS, IKS, IW, gw, NGW, lane);
            cvt_rows((gcf)ap->in[5], IKS, PAST * IDXD / 8, (size_t)LSK * IDXD, 32 * PAST * IDXD / 8, gt, GT);
            cvt_rows((gcf)ap->in[3], KS, PAST * KVW / 8, (size_t)LSK * KVW, 32 * PAST * KVW / 8, gt, GT);
            cvt_rows((gcf)ap->in[4], VS, PAST * KVW / 8, (size_t)LSK * KVW, 32 * PAST * KVW / 8, gt, GT);
        } else if (PHM(7) && step == 11) {
            PH_ENV
            indexer_phase(L, IQ, IW, IKP, IKS, SCP, SCS, vcu, G, tid, lane, wave);
        } else if (PHM(8) && step == 12) {
            PH_ENV
            topk_phase(SCP, SCS, SEL, gw, NGW, lane);
        } else if (PHM(9) && step == 13) {
            PH_ENV
            attn_phase(QR, QR, SEL, KP, VP, KS, VS, gw, NGW, lane);
        }
        if (step + 1 < NSTEP) { int tb; asm volatile("v_mbcnt_lo_u32_b32 %0, -1, 0\n\tv_mbcnt_hi_u32_b32 %0, -1, %0" : "=v"(tb)); xcd_barrier(bar, tb + wave_s * 64); }
    }
}

extern "C" void kernel_launch(void* const* d_in, const int* in_sizes, int n_in, void* d_out, int out_size, void* d_ws, size_t ws_size, hipStream_t stream) {
    static int grid = 0;
    if (grid == 0) {
        if (n_in != 22 || out_size != (int)O_END || ws_size < WS_END) { fprintf(stderr, "kernel_launch: built for 22 inputs, %zu outputs, >= %zu bytes of workspace; got n_in %d, out %d, ws %zu; nothing launched\n", (size_t)O_END, (size_t)WS_END, n_in, out_size, ws_size); grid = -1; return; }
        int dev = 0, cus = 0;
        if (hipGetDevice(&dev) != hipSuccess || hipDeviceGetAttribute(&cus, hipDeviceAttributeMultiprocessorCount, dev) != hipSuccess) { fprintf(stderr, "kernel_launch: device query failed\n"); grid = -1; return; }
        if (hipFuncSetAttribute((const void*)mega_fwd, hipFuncAttributeMaxDynamicSharedMemorySize, LDS_BYTES) != hipSuccess) { fprintf(stderr, "kernel_launch: hipFuncSetAttribute failed\n"); grid = -1; return; }
        (void)hipGetLastError();
        grid = cus;
    }
    if (grid < 0) return;
    if (hipMemsetAsync((char*)d_ws + WS_CTL, 0, CTL_ZERO_BYTES, stream) != hipSuccess) { fprintf(stderr, "kernel_launch: hipMemsetAsync failed\n"); return; }
    Args a{};
    for (int i = 0; i < 22; ++i) a.in[i] = (const float*)d_in[i];
    a.out = (float*)d_out; a.ws = (unsigned char*)d_ws;
    for (int d = 0; d < 64; ++d) a.inv_freq[d] = (float)pow(10000.0, -(double)d / 64.0);
    hipLaunchKernelGGL(mega_fwd, dim3(grid), dim3(NTHR), LDS_BYTES, stream, a);
    const hipError_t le = hipPeekAtLastError();
    if (le != hipSuccess) fprintf(stderr, "kernel_launch: launch failed: %s\n", hipGetErrorName(le));
}
```

```cpp
#include <hip/hip_runtime.h>
#include <cstdio>
#include <cstdint>
#include <cmath>
namespace pg8 {
#define PG8_LAS __attribute__((address_space(3)))
typedef unsigned short bf16_t;
typedef short bf16x8 __attribute__((ext_vector_type(8)));
typedef float f32x4 __attribute__((ext_vector_type(4)));
typedef unsigned u32x4 __attribute__((ext_vector_type(4)));
constexpr int BM = 256, BK = 64, HALF = 128, HTB = HALF * BK * 2  , STAGE_BYTES = 8 * HTB, NXCD = 8, WGM = 8;

__host__ __device__ __forceinline__ int lds_byte(int r, int c) { const int st = (r >> 4) * 2 + (c >> 5), rr = r & 15, cc = c & 31, ob = rr * 64 + cc * 2; return st * 1024 + (ob ^ (((ob >> 9) & 1) << 5)); }
__host__ __device__ __forceinline__ void stage_rc(int b, int& R, int& C) { const int st = b / 1024, sb = b % 1024, swz = sb ^ (((sb >> 9) & 1) << 5); R = (st >> 1) * 16 + swz / 64; C = (st & 1) * 32 + (swz % 64) / 2; }
__host__ __device__ __forceinline__ int perm32(int rho) { const int n = rho >> 4, i = rho & 15; return 8 * (i >> 2) + 4 * n + (i & 3); }

struct Unit { int pm, pn, k0, ntk, kq; };
struct Gemm { const __attribute__((address_space(1))) bf16_t* A; const __attribute__((address_space(1))) bf16_t* Bt; int M, N, K; int sw, sa; int i8; int kfix; };

struct StaticOrder {
    int nM, nN, nwg, G, c;
    __host__ __device__ void init(int M, int N, int G_, int c_) { nM = M / BM; nN = N / BM; nwg = nM * nN; G = G_; c = c_; }
    __host__ __device__ bool next(int i, Unit& u) const {
        const long L = (long)i * G + c; if (L >= nwg) return false;
        int wgid = (int)L; { const int q = nwg / NXCD, r = nwg % NXCD, xcd = wgid % NXCD, off = wgid / NXCD; wgid = (xcd < r ? xcd * (q + 1) : r * (q + 1) + (xcd - r) * q) + off; }
        const int nig = WGM * nN, gid = wgid / nig, fm = gid * WGM, gsz = (nM - fm) < WGM ? (nM - fm) : WGM;
        u.pm = fm + ((wgid % nig) % gsz); u.pn = (wgid % nig) / gsz; u.k0 = 0; u.ntk = 0; u.kq = 0; return true;
    }
    __device__ __forceinline__ void a_ready(const Unit&) const {}
    __device__ __forceinline__ void done(const Unit&) const {}
};

struct DualOrder {
    int nM, nN, nwg, tail, G, c, qhi, qlo;
    __device__ __forceinline__ void init(int M, int N, int K, int G_, int c_, int tail_) { tail = tail_; G = G_; c = c_; { const int nt = K / BK; qhi = 2 * ((nt + 7) / 8); qlo = (nt - 2 * qhi) / 2; } nM = (tail_ == 1 ? 8192 : M) / BM; nN = N / BM; nwg = tail_ == 2 ? 0 : nM * nN; }
    __device__ __forceinline__ bool next(int i, Unit& u) const {
        const long L = (long)i * G + c; int pm = 0, pn = 0, k0 = 0, ntk = 0, kq = 0; bool ok = true;
        if (L < nwg) {
            int wgid = (int)L; { const int q = nwg / NXCD, r = nwg % NXCD, xcd = wgid % NXCD, off = wgid / NXCD; wgid = (xcd < r ? xcd * (q + 1) : r * (q + 1) + (xcd - r) * q) + off; }
            const int nig = WGM * nN, gid = wgid / nig, fm = gid * WGM, gsz = (nM - fm) < WGM ? (nM - fm) : WGM;
            pm = fm + ((wgid % nig) % gsz); pn = (wgid % nig) / gsz;
        } else if (tail == 2) {
            if (L < 2 * nN) { pn = (int)(L % nN); kq = (int)(L / nN); ntk = 16; k0 = kq * 16; } else ok = false;
        } else if (tail == 1 && L < nwg + 256) {
            const int t = (int)(L - nwg), x = t & 7, j = t >> 3; pm = 32 + (j & 7); pn = x; kq = j >> 3; ntk = kq < 2 ? qhi : qlo; k0 = kq < 2 ? kq * qhi : 2 * qhi + (kq - 2) * qlo;
        } else ok = false;
        u.pm = pm; u.pn = pn; u.k0 = k0; u.ntk = ntk; u.kq = kq; return ok;
    }
    __device__ __forceinline__ void a_ready(const Unit&) const {}
    __device__ __forceinline__ void done(const Unit&) const {}
};
}
namespace pg8 {
#define PG8_GAS __attribute__((address_space(1)))
__device__ __forceinline__ unsigned cvt_pk_bf16(float lo, float hi) { unsigned r; asm volatile("v_cvt_pk_bf16_f32 %0, %1, %2" : "=v"(r) : "v"(lo), "v"(hi)); return r; }
struct EpiBf16P {
    static constexpr bool AFTER_DRAIN = false; __device__ __forceinline__ bool perm() const { return true; }
    PG8_GAS bf16_t* O; int ldc; size_t kslab;
    const PG8_GAS float* SA; const PG8_GAS float* SWM;
    __device__ __forceinline__ void operator()(const f32x4 (&acc)[2][2][4][2], const Unit& u, int wr, int wc, int fr, int fq) const {
        const int row0 = u.pm * BM + wr * 64 + fr, col0 = u.pn * BM + wc * 32 + 8 * fq;
        f32x4 sw[2][2];
#pragma unroll
        for (int bj = 0; bj < 2; ++bj)
#pragma unroll
            for (int n = 0; n < 2; ++n) sw[bj][n] = SA ? *(const PG8_GAS f32x4*)(SWM + col0 + bj * HALF + 4 * n) * (1.f / 127.f) : (f32x4){0.f, 0.f, 0.f, 0.f};
#pragma unroll
        for (int ai = 0; ai < 2; ++ai)
#pragma unroll
            for (int m = 0; m < 4; ++m) { PG8_GAS bf16_t* rowp = O + (size_t)u.kq * kslab + (size_t)(row0 + ai * HALF + m * 16) * ldc + col0;
                const float sar = SA ? SA[row0 + ai * HALF + m * 16] : 0.f;
#pragma unroll
                for (int bj = 0; bj < 2; ++bj) { f32x4 v0 = acc[ai][bj][m][0], v1 = acc[ai][bj][m][1];
                    if (SA) {
#pragma unroll
                        for (int i = 0; i < 4; ++i) { v0[i] = (float)__float_as_int(v0[i]) * (sw[bj][0][i] * sar); v1[i] = (float)__float_as_int(v1[i]) * (sw[bj][1][i] * sar); } }
                    u32x4 w; w.x = cvt_pk_bf16(v0[0], v0[1]); w.y = cvt_pk_bf16(v0[2], v0[3]); w.z = cvt_pk_bf16(v1[0], v1[1]); w.w = cvt_pk_bf16(v1[2], v1[3]);
                    *(PG8_GAS u32x4*)(rowp + bj * HALF) = w; } }
    }
};
struct EpiF32R {
    static constexpr bool AFTER_DRAIN = false; __device__ __forceinline__ bool perm() const { return true; }
    PG8_GAS bf16_t* Y; const PG8_GAS bf16_t* X; int split; int ldc; float alpha; PG8_GAS float* P;
    __device__ __forceinline__ void operator()(const f32x4 (&acc)[2][2][4][2], const Unit& u, int wr, int wc, int fr, int fq) const {
        const int row0 = u.pm * BM + wr * 64 + fr, col0 = u.pn * BM + wc * 32 + 8 * fq;
        if (u.kq > 0) {
#pragma unroll
            for (int ai = 0; ai < 2; ++ai)
#pragma unroll
                for (int m = 0; m < 4; ++m) { PG8_GAS float* pr = P + ((size_t)(u.kq - 1) * 2048 + (size_t)(row0 + ai * HALF + m * 16 - split)) * ldc + col0;
#pragma unroll
                    for (int bj = 0; bj < 2; ++bj)
#pragma unroll
                        for (int n = 0; n < 2; ++n) *(PG8_GAS f32x4*)(pr + bj * HALF + n * 4) = acc[ai][bj][m][n]; }
            return;
        }
#pragma unroll
        for (int ai = 0; ai < 2; ++ai) {
            u32x4 xv[4][2];
#pragma unroll
            for (int m = 0; m < 4; ++m)
#pragma unroll
                for (int bj = 0; bj < 2; ++bj) xv[m][bj] = *(const PG8_GAS u32x4*)(X + (size_t)(row0 + ai * HALF + m * 16) * ldc + col0 + bj * HALF);
#pragma unroll
            for (int m = 0; m < 4; ++m)
#pragma unroll
                for (int bj = 0; bj < 2; ++bj) { const u32x4 w = xv[m][bj]; const f32x4 a0 = acc[ai][bj][m][0], a1 = acc[ai][bj][m][1];
                    u32x4 o; o.x = cvt_pk_bf16(__uint_as_float(w.x << 16) * alpha + a0[0], __uint_as_float(w.x & 0xffff0000u) * alpha + a0[1]); o.y = cvt_pk_bf16(__uint_as_float(w.y << 16) * alpha + a0[2], __uint_as_float(w.y & 0xffff0000u) * alpha + a0[3]);
                    o.z = cvt_pk_bf16(__uint_as_float(w.z << 16) * alpha + a1[0], __uint_as_float(w.z & 0xffff0000u) * alpha + a1[1]); o.w = cvt_pk_bf16(__uint_as_float(w.w << 16) * alpha + a1[2], __uint_as_float(w.w & 0xffff0000u) * alpha + a1[3]);
                    *(PG8_GAS u32x4*)(Y + (size_t)(row0 + ai * HALF + m * 16) * ldc + col0 + bj * HALF) = o; }
            asm volatile("" ::: "memory");
        }
    }
};

struct EpiConvGlu {
    static constexpr bool AFTER_DRAIN = false; __device__ __forceinline__ bool perm() const { return true; }
    PG8_GAS unsigned char* H; const PG8_GAS float* cw; const PG8_GAS float* cb; PG8_GAS float* FIXG; PG8_GAS float* FIXU; PG8_GAS float* HALO; int ldh;
    const PG8_GAS float* SA; const PG8_GAS float* SWM;
    __device__ __forceinline__ void operator()(const f32x4 (&acc)[2][2][4][2], const Unit& u, int wr, int wc, int fr, int fq) const {
        typedef unsigned u32x2 __attribute__((ext_vector_type(2)));
        const int ch0 = u.pn * 128 + wc * 32 + 8 * fq;
        float w0[8], w1[8], w2[8], bb[8];
#pragma unroll
        for (int h4 = 0; h4 < 2; ++h4) { const f32x4 a = *(const PG8_GAS f32x4*)(cw + ch0 + 4 * h4), b = *(const PG8_GAS f32x4*)(cw + ldh + ch0 + 4 * h4), c = *(const PG8_GAS f32x4*)(cw + 2 * ldh + ch0 + 4 * h4), d = *(const PG8_GAS f32x4*)(cb + ch0 + 4 * h4);
#pragma unroll
            for (int i = 0; i < 4; ++i) { w0[4 * h4 + i] = a[i]; w1[4 * h4 + i] = b[i]; w2[4 * h4 + i] = c[i]; bb[4 * h4 + i] = d[i]; } }
        float sg8[8], su8[8];
#pragma unroll
        for (int h4 = 0; h4 < 2; ++h4) { const f32x4 a = *(const PG8_GAS f32x4*)(SWM + u.pn * BM + wc * 32 + 8 * fq + 4 * h4), b = *(const PG8_GAS f32x4*)(SWM + u.pn * BM + HALF + wc * 32 + 8 * fq + 4 * h4);
#pragma unroll
            for (int i = 0; i < 4; ++i) { sg8[4 * h4 + i] = a[i] * (1.f / 127.f); su8[4 * h4 + i] = b[i] * (1.f / 127.f); } }
        const int src1 = ((fq << 4) | ((fr + 15) & 15)) << 2, src2 = ((fq << 4) | ((fr + 14) & 15)) << 2;
#pragma unroll
        for (int ai = 0; ai < 2; ++ai)
#pragma unroll
            for (int m = 0; m < 4; ++m) {
                const int row = u.pm * BM + ai * HALF + wr * 64 + m * 16 + fr; float hv[8], gvv[8], uvv[8];
                const float sar = SA[row], sam1 = m > 0 ? SA[row - 16] : 0.f;
#pragma unroll
                for (int e8 = 0; e8 < 8; ++e8) { const int n = e8 >> 2, i = e8 & 3;
                    const float gv = (float)__float_as_int(acc[ai][0][m][n][i]) * sar * sg8[e8], gp = m > 0 ? (float)__float_as_int(acc[ai][0][m > 0 ? m - 1 : 0][n][i]) * sam1 * sg8[e8] : 0.f, uv = (float)__float_as_int(acc[ai][1][m][n][i]) * sar * su8[e8];
                    const float g1 = __int_as_float(__builtin_amdgcn_update_dpp(0, __float_as_int(fr == 15 ? gp : gv), 0x121, 0xf, 0xf, false));
                    const float g2 = __int_as_float(__builtin_amdgcn_update_dpp(0, __float_as_int(fr >= 14 ? gp : gv), 0x122, 0xf, 0xf, false));
                    const float a = w0[e8] * g2 + w1[e8] * g1 + w2[e8] * gv + bb[e8];
                    const float sg = __builtin_amdgcn_rcpf(1.f + __builtin_amdgcn_exp2f(-a * 1.4426950408889634f));
                    hv[e8] = fminf(fmaxf(a * sg * uv * 16.f, -448.f), 448.f); gvv[e8] = gv; uvv[e8] = uv; }
                if (m == 0 && fr < 2) { const size_t fo = (size_t)((row >> 6) * 2 + fr) * ldh + ch0;
                    *(PG8_GAS f32x4*)(FIXG + fo) = (f32x4){gvv[0], gvv[1], gvv[2], gvv[3]}; *(PG8_GAS f32x4*)(FIXG + fo + 4) = (f32x4){gvv[4], gvv[5], gvv[6], gvv[7]};
                    *(PG8_GAS f32x4*)(FIXU + fo) = (f32x4){uvv[0], uvv[1], uvv[2], uvv[3]}; *(PG8_GAS f32x4*)(FIXU + fo + 4) = (f32x4){uvv[4], uvv[5], uvv[6], uvv[7]}; }
                else { int p0 = __builtin_amdgcn_cvt_pk_fp8_f32(hv[0], hv[1], 0, false); p0 = __builtin_amdgcn_cvt_pk_fp8_f32(hv[2], hv[3], p0, true);
                    int p1 = __builtin_amdgcn_cvt_pk_fp8_f32(hv[4], hv[5], 0, false); p1 = __builtin_amdgcn_cvt_pk_fp8_f32(hv[6], hv[7], p1, true);
                    *(PG8_GAS u32x2*)(H + (size_t)row * ldh + ch0) = (u32x2){(unsigned)p0, (unsigned)p1}; }
                if (m == 3 && fr >= 14) { const size_t ho = (size_t)((row >> 6) * 2 + fr - 14) * ldh + ch0;
                    *(PG8_GAS f32x4*)(HALO + ho) = (f32x4){gvv[0], gvv[1], gvv[2], gvv[3]}; *(PG8_GAS f32x4*)(HALO + ho + 4) = (f32x4){gvv[4], gvv[5], gvv[6], gvv[7]}; }
            }
    }
};

struct EpiDual {
    static constexpr bool AFTER_DRAIN = false;
    int mode; PG8_GAS bf16_t* O; int ldo; PG8_GAS bf16_t* Y; const PG8_GAS bf16_t* X; int split; int ldc; float alpha; PG8_GAS float* P;
    PG8_GAS unsigned char* H; const PG8_GAS float* cw; const PG8_GAS float* cb; PG8_GAS float* FIXG; PG8_GAS float* FIXU; PG8_GAS float* HALO; int ldh; const PG8_GAS float* SA; const PG8_GAS float* SWM;
    size_t kslab;
    __device__ __forceinline__ bool perm() const { return true; }
    __device__ __forceinline__ void operator()(const f32x4 (&acc)[2][2][4][2], const Unit& u, int wr, int wc, int fr, int fq) const {
        if (mode == 0) { EpiBf16P e{O, ldo, kslab, SA, SWM}; e(acc, u, wr, wc, fr, fq); } else if (mode == 1) { EpiF32R e{Y, X, split, ldc, alpha, P}; e(acc, u, wr, wc, fr, fq); }
        else { EpiConvGlu e{H, cw, cb, FIXG, FIXU, HALO, ldh, SA, SWM}; e(acc, u, wr, wc, fr, fq); }
    }
};
}
namespace pg8 {
template <class Epi, class Sched, bool ALIGN_EPI = false, bool SP2 = false, bool FP8 = false, bool I8 = false, int PV = 0>
__device__ __forceinline__ void gemm_phase(PG8_LAS unsigned char* lds, const Gemm g, const Sched& S, const Epi& E, const int tid) {
    const int wid = __builtin_amdgcn_readfirstlane(tid >> 6), lane = tid & 63, wr = wid >> 2, wc = wid & 3, fr = lane & 15, fq = lane >> 4;
    const int K = g.K, nt = K / BK;
    unsigned voffA[2], voffB[2];
#pragma unroll
    for (int i = 0; i < 2; ++i) { int R, C; stage_rc(tid * 16 + i * 8192, R, C); const int Rb = E.perm() ? ((R & ~31) + perm32(R & 31)) : R;
        voffA[i] = (unsigned)(R * K + C) * 2u; voffB[i] = (unsigned)(Rb * K + C) * 2u; }

#ifdef REP_KFIX
    const size_t kstep = g.kfix ? (size_t)0 : (size_t)(BK * 2);
#else
    const size_t kstep = (size_t)(BK * 2);
#endif
    const size_t hstep = (size_t)HALF * K * 2;
    const size_t tstep = 2 * hstep;
    const unsigned ldsw = (unsigned)wid * 1024u;
    const int aoff = lds_byte(wr * 64 + fr, fq * 8), boff = lds_byte(wc * 32 + fr, fq * 8);
#define PG8_SA(b, h) (((b) * 2 + (h)) * HTB)
#define PG8_SB(b, h) ((4 + (b) * 2 + (h)) * HTB)
#define PG8_STAGE(bufoff, gbase, voff) do { if constexpr (PV != 2) _Pragma("unroll") for (int _i = 0; _i < 2; ++_i) \
        __builtin_amdgcn_global_load_lds((const unsigned*)((const char*)(gbase) + (voff)[_i]), (PG8_LAS unsigned*)(lds + (bufoff) + ldsw + _i * 8192), 16, 0, 0); } while (0)
#define PG8_LDA(dst, b, h) do { _Pragma("unroll") for (int m = 0; m < 4; ++m) { if constexpr (FP8) { const bf16x8 lo_ = *(const PG8_LAS bf16x8*)(lds + PG8_SA(b, h) + aoff + m * 2048), hi_ = *(const PG8_LAS bf16x8*)(lds + PG8_SA(b, h) + aoff + m * 2048 + 1024); \
        dst##8[m] = __builtin_shufflevector(lo_, hi_, 0, 1, 2, 3, 4, 5, 6, 7, 8, 9, 10, 11, 12, 13, 14, 15); } else { _Pragma("unroll") for (int k = 0; k < 2; ++k) dst[m][k] = *(const PG8_LAS bf16x8*)(lds + PG8_SA(b, h) + aoff + m * 2048 + k * 1024); } } } while (0)
#define PG8_LDB(dst, b, h) do { _Pragma("unroll") for (int n = 0; n < 2; ++n) { if constexpr (FP8) { const bf16x8 lo_ = *(const PG8_LAS bf16x8*)(lds + PG8_SB(b, h) + boff + n * 2048), hi_ = *(const PG8_LAS bf16x8*)(lds + PG8_SB(b, h) + boff + n * 2048 + 1024); \
        dst##8[n] = __builtin_shufflevector(lo_, hi_, 0, 1, 2, 3, 4, 5, 6, 7, 8, 9, 10, 11, 12, 13, 14, 15); } else { _Pragma("unroll") for (int k = 0; k < 2; ++k) dst[n][k] = *(const PG8_LAS bf16x8*)(lds + PG8_SB(b, h) + boff + n * 2048 + k * 1024); } } } while (0)
#define PG8_MMA(ai, bj, At, Bt) do { __builtin_amdgcn_s_setprio(1); _Pragma("unroll") for (int m = 0; m < 4; ++m) _Pragma("unroll") for (int n = 0; n < 2; ++n) { \
        if constexpr (PV == 1) { if constexpr (FP8) asm volatile("" :: "v"(Bt##8[n]), "v"(At##8[m])); else asm volatile("" :: "v"(Bt[n][0]), "v"(At[m][0]), "v"(Bt[n][1]), "v"(At[m][1])); } else \
        if constexpr (FP8) asm volatile("v_mfma_scale_f32_16x16x128_f8f6f4 %0, %1, %2, %0, %3, %4 op_sel_hi:[0,0,0]" : "+v"(acc[ai][bj][m][n]) : "v"(__builtin_bit_cast(pg8_i32x8, Bt##8[n])), "v"(__builtin_bit_cast(pg8_i32x8, At##8[m])), "v"(swv), "v"(sav)); \
        else if constexpr (I8) { _Pragma("unroll") for (int k = 0; k < 2; ++k) asm volatile("v_mfma_i32_16x16x64_i8 %0, %1, %2, %0" : "+v"(acc[ai][bj][m][n]) : "v"(Bt[n][k]), "v"(At[m][k])); }     \
        else { _Pragma("unroll") for (int k = 0; k < 2; ++k) acc[ai][bj][m][n] = __builtin_amdgcn_mfma_f32_16x16x32_bf16(Bt[n][k], At[m][k], acc[ai][bj][m][n], 0, 0, 0); } } \
        __builtin_amdgcn_s_setprio(0); } while (0)
#define PG8_WAIT_V(n) asm volatile("s_waitcnt vmcnt(" #n ")" ::: "memory")
#define PG8_WAIT_L(n) asm volatile("s_waitcnt lgkmcnt(" #n ")" ::: "memory")
#define PG8_BAR __builtin_amdgcn_s_barrier()
#define PG8_SCHED __builtin_amdgcn_sched_barrier(0)
    Unit cur, nxt; int ui = 0;
    if (!S.next(0, cur)) return;
    int swv = g.sw, sav = g.sa; asm volatile("" : "+v"(swv), "+v"(sav));
    f32x4 acc[2][2][4][2];
#pragma unroll
    for (int a = 0; a < 2; ++a)
#pragma unroll
        for (int b = 0; b < 2; ++b)
#pragma unroll
            for (int m = 0; m < 4; ++m)
#pragma unroll
                for (int n = 0; n < 2; ++n) acc[a][b][m][n] = (f32x4){0.f, 0.f, 0.f, 0.f};
    typedef short pg8_s16x16 __attribute__((ext_vector_type(16))); typedef int pg8_i32x8 __attribute__((ext_vector_type(8)));
    bf16x8 At[4][2], B0[2][2], B1[2][2];
    pg8_s16x16 At8[4], B08[2], B18[2];
    const char* cA = (const char*)g.A + (size_t)cur.pm * tstep + (size_t)cur.k0 * kstep; const char* cB = (const char*)g.Bt + (size_t)cur.pn * tstep + (size_t)cur.k0 * kstep;
    int cnt = cur.ntk ? cur.ntk : nt;
    S.a_ready(cur);
    if constexpr (SP2) {
        PG8_STAGE(PG8_SB(0, 0), cB, voffB); PG8_STAGE(PG8_SB(0, 1), cB + hstep, voffB); PG8_STAGE(PG8_SA(0, 0), cA, voffA); PG8_STAGE(PG8_SA(0, 1), cA + hstep, voffA);
        if (wr == 1) PG8_BAR;
        PG8_WAIT_V(2); PG8_BAR;
        PG8_STAGE(PG8_SB(1, 0), cB + kstep, voffB); PG8_STAGE(PG8_SA(1, 0), cA + kstep, voffA); PG8_STAGE(PG8_SB(1, 1), cB + hstep + kstep, voffB);
        PG8_WAIT_V(6); PG8_BAR;
    } else {
        PG8_STAGE(PG8_SB(0, 0), cB, voffB); PG8_STAGE(PG8_SA(0, 0), cA, voffA); PG8_STAGE(PG8_SB(0, 1), cB + hstep, voffB); PG8_STAGE(PG8_SA(0, 1), cA + hstep, voffA);
        if (wr == 1) PG8_BAR;
        PG8_WAIT_V(4); PG8_BAR;
        PG8_STAGE(PG8_SB(1, 0), cB + kstep, voffB); PG8_STAGE(PG8_SA(1, 0), cA + kstep, voffA); PG8_STAGE(PG8_SB(1, 1), cB + hstep + kstep, voffB);
        PG8_WAIT_V(6); PG8_BAR;
    }
    for (;;) {
        const bool has_next = S.next(ui + 1, nxt);
        const char* nA = has_next ? (const char*)g.A + (size_t)nxt.pm * tstep + (size_t)nxt.k0 * kstep : cA; const char* nB = has_next ? (const char*)g.Bt + (size_t)nxt.pn * tstep + (size_t)nxt.k0 * kstep : cB;
        for (int t = 0; t < cnt; t += 2) {
            const bool last = (t == cnt - 2);
            const char* a1 = cA + (size_t)(t + 1) * kstep;
            const char* a2 = last ? nA : cA + (size_t)(t + 2) * kstep; const char* b2 = last ? nB : cB + (size_t)(t + 2) * kstep;
            const char* a3 = a2 + kstep; const char* b3 = b2 + kstep;
            if (last && has_next) S.a_ready(nxt);
            if constexpr (SP2) {
            PG8_LDB(B0, 0, 0); PG8_LDB(B1, 0, 1); PG8_SCHED; PG8_LDA(At, 0, 0); PG8_STAGE(PG8_SA(1, 1), a1 + hstep, voffA);
            PG8_WAIT_V(8); PG8_WAIT_L(0); PG8_BAR; PG8_MMA(0, 0, At, B0); PG8_MMA(0, 1, At, B1); PG8_BAR; PG8_SCHED;
            PG8_LDA(At, 0, 1); PG8_STAGE(PG8_SB(0, 0), b2, voffB); PG8_STAGE(PG8_SB(0, 1), b2 + hstep, voffB); PG8_STAGE(PG8_SA(0, 0), a2, voffA);
            PG8_WAIT_V(8); PG8_WAIT_L(0); PG8_BAR; PG8_MMA(1, 0, At, B0); PG8_MMA(1, 1, At, B1); PG8_BAR; PG8_SCHED;
            PG8_LDB(B0, 1, 0); PG8_LDB(B1, 1, 1); PG8_SCHED; PG8_LDA(At, 1, 0); PG8_STAGE(PG8_SA(0, 1), a2 + hstep, voffA);
            PG8_WAIT_V(8); PG8_WAIT_L(0); PG8_BAR; PG8_MMA(0, 0, At, B0); PG8_MMA(0, 1, At, B1); PG8_BAR; PG8_SCHED;
            PG8_LDA(At, 1, 1); PG8_STAGE(PG8_SB(1, 0), b3, voffB); PG8_STAGE(PG8_SB(1, 1), b3 + hstep, voffB); PG8_STAGE(PG8_SA(1, 0), a3, voffA);
            PG8_WAIT_V(8); PG8_WAIT_L(0); PG8_BAR; PG8_MMA(1, 0, At, B0); PG8_MMA(1, 1, At, B1); PG8_BAR; PG8_SCHED;
            } else {
            PG8_LDB(B0, 0, 0); PG8_SCHED; PG8_LDA(At, 0, 0); PG8_STAGE(PG8_SA(1, 1), a1 + hstep, voffA);
            PG8_WAIT_L(8); PG8_BAR; PG8_WAIT_L(0); PG8_MMA(0, 0, At, B0); PG8_BAR; PG8_SCHED;
            PG8_LDB(B1, 0, 1); PG8_STAGE(PG8_SB(0, 0), b2, voffB);
            PG8_BAR; PG8_WAIT_L(0); PG8_MMA(0, 1, At, B1); PG8_BAR;
            PG8_LDA(At, 0, 1); PG8_STAGE(PG8_SA(0, 0), a2, voffA);
            PG8_BAR; PG8_WAIT_L(0); PG8_MMA(1, 0, At, B0); PG8_BAR; PG8_SCHED;
            PG8_STAGE(PG8_SB(0, 1), b2 + hstep, voffB);
            PG8_WAIT_V(6); PG8_BAR; PG8_MMA(1, 1, At, B1); PG8_BAR;
            PG8_LDB(B0, 1, 0); PG8_SCHED; PG8_LDA(At, 1, 0); PG8_STAGE(PG8_SA(0, 1), a2 + hstep, voffA);
            PG8_WAIT_L(8); PG8_BAR; PG8_WAIT_L(0); PG8_MMA(0, 0, At, B0); PG8_BAR; PG8_SCHED;
            PG8_LDB(B1, 1, 1); PG8_STAGE(PG8_SB(1, 0), b3, voffB);
            PG8_BAR; PG8_WAIT_L(0); PG8_MMA(0, 1, At, B1); PG8_BAR;
            PG8_LDA(At, 1, 1); PG8_STAGE(PG8_SA(1, 0), a3, voffA);
            PG8_BAR; PG8_WAIT_L(0); PG8_MMA(1, 0, At, B0); PG8_BAR; PG8_SCHED;
            PG8_STAGE(PG8_SB(1, 1), b3 + hstep, voffB);
            PG8_WAIT_V(6); PG8_BAR; PG8_MMA(1, 1, At, B1); PG8_BAR;
            }
        }
        if constexpr (ALIGN_EPI) { if (wr == 0) PG8_BAR; }
        if constexpr (FP8 || I8) asm volatile("s_nop 15\n\ts_nop 15" ::: "memory");
        if constexpr (!Epi::AFTER_DRAIN) { int l2_; asm volatile("v_mbcnt_lo_u32_b32 %0, -1, 0\n\tv_mbcnt_hi_u32_b32 %0, -1, %0" : "=v"(l2_));
            E(acc, cur, wr, wc, l2_ & 15, l2_ >> 4); S.done(cur); }
        if (!has_next) break;
#pragma unroll
        for (int a = 0; a < 2; ++a)
#pragma unroll
            for (int b = 0; b < 2; ++b)
#pragma unroll
                for (int m = 0; m < 4; ++m)
#pragma unroll
                    for (int n = 0; n < 2; ++n) acc[a][b][m][n] = (f32x4){0.f, 0.f, 0.f, 0.f};
        cur = nxt; cA = nA; cB = nB; ++ui; cnt = cur.ntk ? cur.ntk : nt;
        if constexpr (ALIGN_EPI) { if (wr == 1) PG8_BAR; }
    }
    PG8_WAIT_V(0);
    if constexpr (!ALIGN_EPI) { if (wr == 0) PG8_BAR; }
    PG8_BAR;
    if constexpr (Epi::AFTER_DRAIN) { E.fused(acc, cur, wr, wc, fr, fq, lds, wid, lane); S.done(cur); }
#undef PG8_SA
#undef PG8_SB
#undef PG8_STAGE
#undef PG8_LDA
#undef PG8_LDB
#undef PG8_MMA
#undef PG8_WAIT_V
#undef PG8_WAIT_L
#undef PG8_BAR
#undef PG8_SCHED
}
}
#define GAS __attribute__((address_space(1)))
#define LAS __attribute__((address_space(3)))
typedef unsigned short bf16;
typedef unsigned v4u __attribute__((ext_vector_type(4)));
typedef float f32x4 __attribute__((ext_vector_type(4)));
typedef short bf16x8 __attribute__((ext_vector_type(8)));
typedef GAS unsigned gu32;
typedef GAS unsigned long long gu64;
#define RLX_AGENT __ATOMIC_RELAXED, __HIP_MEMORY_SCOPE_AGENT
#define LDS_WAIT() asm volatile("s_waitcnt lgkmcnt(0)" ::: "memory")
#define VM_WAIT() asm volatile("s_waitcnt vmcnt(0)" ::: "memory")
__device__ __forceinline__ unsigned long long rt() { return __builtin_amdgcn_s_memrealtime(); }
__device__ __forceinline__ unsigned f2bf(float f) { unsigned u = __builtin_bit_cast(unsigned, f); return (u + 0x7fffu + ((u >> 16) & 1u)) >> 16; }
__device__ __forceinline__ unsigned pk2(float lo, float hi) { return f2bf(lo) | (f2bf(hi) << 16); }
#define XB_TMO      128
#define XB_XCNT(j)  (256  + 64 * (j))
#define XB_XSUB(j)  (1280 + 64 * (j))
#define XB_XGEN(j)  (2304 + 64 * (j))
#define XB_TOP      3328
#define XB_TOPGEN   3392
#define XCD_BAR_WORDS 3456
#define XB_SPIN_CAP (1u << 18)

__device__ __forceinline__ unsigned xb_ld(unsigned* p)              { return __hip_atomic_load(p, __ATOMIC_RELAXED, __HIP_MEMORY_SCOPE_AGENT); }
__device__ __forceinline__ unsigned xb_add(unsigned* p, unsigned v) { return __hip_atomic_fetch_add(p, v, __ATOMIC_RELAXED, __HIP_MEMORY_SCOPE_AGENT); }
__device__ __forceinline__ unsigned xb_xcc_id() { return (unsigned)__builtin_amdgcn_s_getreg((3 << 11) | 20) & 0xFu; }
#define XB_SPIN(cond, bar) do { unsigned _sp = 0; while (cond) { __builtin_amdgcn_s_sleep(1); \
    if ((++_sp & 255u) == 0u) { if (xb_ld(&(bar)[XB_TMO])) break; if (_sp > XB_SPIN_CAP) { atomicAdd(&(bar)[XB_TMO], 1u); break; } } } } while (0)

struct XcdBarrier {
    unsigned* bar; unsigned x;
    volatile LAS unsigned* st;
};

__device__ __forceinline__ XcdBarrier xcd_barrier_post(unsigned* bar, volatile LAS unsigned* st) {
    XcdBarrier b; b.bar = bar; b.x = xb_xcc_id(); b.st = st;
    if (threadIdx.x == 0) (void)xb_add(&bar[XB_XCNT(b.x)], 1u);
    return b;
}
__device__ __forceinline__ void xcd_barrier_complete(unsigned* bar, unsigned x, unsigned& nloc, unsigned& nx) {
    const unsigned G = gridDim.x * gridDim.y * gridDim.z;
    unsigned sum, cnt, mine, sp = 0u;
    for (;;) {
        sum = 0u; cnt = 0u; mine = 0u;
#pragma unroll
        for (unsigned j = 0; j < 16; ++j) { const unsigned c = xb_ld(&bar[XB_XCNT(j)]); sum += c; cnt += (c > 0u) ? 1u : 0u; mine = (j == x) ? c : mine; }
        if (sum == G) break;
        __builtin_amdgcn_s_sleep(1);
        if ((++sp & 255u) == 0u) { if (xb_ld(&bar[XB_TMO])) break; if (sp > XB_SPIN_CAP) { atomicAdd(&bar[XB_TMO], 1u); break; } }
    }
    nloc = mine > 0u ? mine : 1u; nx = cnt > 0u ? cnt : 1u;
}

__device__ __forceinline__ void xcd_barrier(const XcdBarrier& b, const int tid_) {
    asm volatile("s_waitcnt vmcnt(0)" ::: "memory");
    __syncthreads();
    if (tid_ == 0) {
        unsigned* bar = b.bar;
        __builtin_amdgcn_s_waitcnt(0);
        unsigned nloc = b.st[0], nx = b.st[1];
        if (nloc == 0u) { xcd_barrier_complete(bar, b.x, nloc, nx); b.st[0] = nloc; b.st[1] = nx; }
        const unsigned old = xb_add(&bar[XB_XSUB(b.x)], 1u);
        const unsigned gen = old / nloc;
        if (old + 1u == (gen + 1u) * nloc) {
            __builtin_amdgcn_fence(__ATOMIC_RELEASE, "agent");
            asm volatile("s_waitcnt vmcnt(0)" ::: "memory");
            const unsigned og = xb_add(&bar[XB_TOP], 1u);
            const unsigned tg = og / nx;
            if (og + 1u == (tg + 1u) * nx) xb_add(&bar[XB_TOPGEN], 1u);
            else XB_SPIN(xb_ld(&bar[XB_TOPGEN]) == tg, bar);
            __builtin_amdgcn_fence(__ATOMIC_ACQUIRE, "agent");
            xb_add(&bar[XB_XGEN(b.x)], 1u);
            asm volatile("s_waitcnt vmcnt(0)" ::: "memory");
        } else {
            XB_SPIN(xb_ld(&bar[XB_XGEN(b.x)]) == gen, bar);
            __builtin_amdgcn_fence(__ATOMIC_ACQUIRE, "agent");
            asm volatile("s_waitcnt vmcnt(0)" ::: "memory");
        }
    }
    __syncthreads();
}

constexpr int NWAVES = 8, NTHR = 512;
constexpr int DM = 2048, NPROW = 8192, MROWS = 10240, SEQ = 4096, DSEQ = 64, PAST = 2048, LSK = 2112, DFF = 5632;
constexpr int NBCV = 6144, NGU = 11264, NPROJ = 5376, NATT = 5264, KVW = 512, IDXD = 128;
constexpr int SCS_LD = 2304;
constexpr float LN_EPS = 1e-5f, DN_ALPHA = 1.4142135623730951f, ATTN_SC2 = 0.08838834764831845f * 1.4426950408889634f, IDX_W_SCALE = 0.022097086912079608f;
constexpr size_t O_YP = 0, O_YS = 16777216, O_CMP = 20971520, O_KP = 20979712, O_VP = 25174016, O_IKP = 29368320, O_FCP = 30416896,
                 O_CMS = 30461952, O_KS = 30593024, O_VS = 31641600, O_IKS = 32690176, O_FCS = 32952320, O_END = 33673216;
constexpr size_t MiB = 1u << 20;
constexpr size_t WS_CTL = 0, CTL_ZERO_BYTES = 1 * MiB;
constexpr size_t WS_WMI = 1 * MiB, WS_WMO = 25 * MiB, WS_WAI = 33 * MiB, WS_WAO = 54 * MiB, WS_WF1 = 62 * MiB, WS_WF2 = 150 * MiB;
constexpr size_t WF1_STRIDE = 44 * MiB, WF2_STRIDE = 22 * MiB;
constexpr size_t WS_XB = 194 * MiB, WS_XF = 234 * MiB  , WS_Y = 314 * MiB, WS_BIG = 394 * MiB, WS_H = 614 * MiB, WS_END = 724 * MiB;
constexpr size_t WS_KP = 1 * MiB, WS_VP = 9 * MiB, WS_IKP = 17 * MiB, WS_IW = 19 * MiB, WS_SEL = 20 * MiB;
constexpr size_t WS_IKS = 62 * MiB;
constexpr size_t WS_KS = 314 * MiB;
constexpr size_t WS_PROJ = 394 * MiB, WS_SCP = 394 * MiB, WS_SCS = 522 * MiB, WS_VS = 548 * MiB;
constexpr size_t WS_QR = 614 * MiB, WS_IQ = 654 * MiB;
constexpr int CW_BAR = 4096;

typedef const GAS float* gcf; typedef GAS float* gf; typedef const GAS bf16* gcb; typedef GAS bf16* gb; typedef const GAS int* gci; typedef GAS int* gi;
typedef float f32x16 __attribute__((ext_vector_type(16)));
typedef float f32x2 __attribute__((ext_vector_type(2)));
__device__ __forceinline__ float bflo(unsigned w) { return __uint_as_float(w << 16); }
__device__ __forceinline__ float bfhi(unsigned w) { return __uint_as_float(w & 0xffff0000u); }
__device__ __forceinline__ float bf1(bf16 h) { return __uint_as_float((unsigned)h << 16); }
__device__ __forceinline__ void unpack8(const v4u w, float (&f)[8]) { f[0] = bflo(w.x); f[1] = bfhi(w.x); f[2] = bflo(w.y); f[3] = bfhi(w.y); f[4] = bflo(w.z); f[5] = bfhi(w.z); f[6] = bflo(w.w); f[7] = bfhi(w.w); }
__device__ __forceinline__ v4u pack8(const float (&f)[8]) { v4u o; o.x = pk2(f[0], f[1]); o.y = pk2(f[2], f[3]); o.z = pk2(f[4], f[5]); o.w = pk2(f[6], f[7]); return o; }
__device__ __forceinline__ void ldf8(gcf p, float (&f)[8]) { const f32x4 a = *(const GAS f32x4*)p, b = *(const GAS f32x4*)(p + 4); f[0] = a.x; f[1] = a.y; f[2] = a.z; f[3] = a.w; f[4] = b.x; f[5] = b.y; f[6] = b.z; f[7] = b.w; }
__device__ __forceinline__ void stf8(gf p, const float (&f)[8]) { *(GAS f32x4*)p = (f32x4){f[0], f[1], f[2], f[3]}; *(GAS f32x4*)(p + 4) = (f32x4){f[4], f[5], f[6], f[7]}; }
__device__ __forceinline__ unsigned pk4_fp8(float a, float b, float c, float d) {
    a = fminf(fmaxf(a, -448.f), 448.f); b = fminf(fmaxf(b, -448.f), 448.f); c = fminf(fmaxf(c, -448.f), 448.f); d = fminf(fmaxf(d, -448.f), 448.f);
    int w = __builtin_amdgcn_cvt_pk_fp8_f32(a, b, 0, false); w = __builtin_amdgcn_cvt_pk_fp8_f32(c, d, w, true); return (unsigned)w; }
__device__ __forceinline__ unsigned pk4_fp8_nc(float a, float b, float c, float d) {
    int w = __builtin_amdgcn_cvt_pk_fp8_f32(a, b, 0, false); w = __builtin_amdgcn_cvt_pk_fp8_f32(c, d, w, true); return (unsigned)w; }
__device__ __forceinline__ unsigned pk4_i8(float a, float b, float c, float d) {
    const int ia = (int)__builtin_rintf(a), ib = (int)__builtin_rintf(b), ic = (int)__builtin_rintf(c), id = (int)__builtin_rintf(d);
    return (unsigned)(ia & 0xff) | ((unsigned)(ib & 0xff) << 8) | ((unsigned)(ic & 0xff) << 16) | ((unsigned)id << 24); }
__device__ __forceinline__ float shfl_f(float v, int src) { return __int_as_float(__builtin_amdgcn_ds_bpermute(src << 2, __float_as_int(v))); }
__device__ __forceinline__ float wave_sum(float v, int lane) {
#pragma unroll
    for (int o = 1; o < 64; o <<= 1) v += shfl_f(v, lane ^ o);
    return v;
}
__device__ __forceinline__ int wave_sum_i(int v, int lane) {
#pragma unroll
    for (int o = 1; o < 64; o <<= 1) v += __builtin_amdgcn_ds_bpermute((lane ^ o) << 2, v);
    return v;
}

__device__ __forceinline__ void tr_col_bf16(gcf W, int N, int k0, int n_src, bool ok, GAS v4u* dst) {
    float v[64]; const int nc = ok ? n_src : 0;
#pragma unroll
    for (int j = 0; j < 64; ++j) v[j] = (W + (size_t)(k0 + j) * N)[nc];
#pragma unroll
    for (int c = 0; c < 8; ++c) { v4u o; o.x = pk2(v[8 * c], v[8 * c + 1]); o.y = pk2(v[8 * c + 2], v[8 * c + 3]); o.z = pk2(v[8 * c + 4], v[8 * c + 5]); o.w = pk2(v[8 * c + 6], v[8 * c + 7]);
        if (!ok) o = (v4u){0u, 0u, 0u, 0u}; dst[c] = o; }
}
__device__ __forceinline__ void tr_col_fp8(gcf W, int N, int k0, int n_src, GAS v4u* dst) {
    float v[64];
#pragma unroll
    for (int j = 0; j < 64; ++j) v[j] = (W + (size_t)(k0 + j) * N)[n_src] * 256.f;
#pragma unroll
    for (int c = 0; c < 4; ++c) { v4u o; o.x = pk4_fp8(v[16 * c], v[16 * c + 1], v[16 * c + 2], v[16 * c + 3]); o.y = pk4_fp8(v[16 * c + 4], v[16 * c + 5], v[16 * c + 6], v[16 * c + 7]);
        o.z = pk4_fp8(v[16 * c + 8], v[16 * c + 9], v[16 * c + 10], v[16 * c + 11]); o.w = pk4_fp8(v[16 * c + 12], v[16 * c + 13], v[16 * c + 14], v[16 * c + 15]); dst[c] = o; }
}
__device__ __forceinline__ void absmax_item(gcf W, int N, int item, int lane, GAS unsigned* SWMbits, int glu) {
    const int nblk = N / 64, kb = item / nblk, nb = item - kb * nblk, k0 = 64 * kb, n = 64 * nb + lane;
    float v[64]; float mx = 0.f;
#pragma unroll
    for (int j = 0; j < 64; ++j) v[j] = (W + (size_t)(k0 + j) * N)[n];
#pragma unroll
    for (int j = 0; j < 64; ++j) mx = fmaxf(mx, fabsf(v[j]));
    int no = n; if (glu) { const int up = n >= N / 2, c = up ? n - N / 2 : n; no = 256 * (c >> 7) + (c & 127) + (up ? 128 : 0); }
    __hip_atomic_fetch_max(SWMbits + no, __float_as_uint(mx), __ATOMIC_RELAXED, __HIP_MEMORY_SCOPE_AGENT);
}
__device__ __forceinline__ void quant_item(gcf W, int K, int N, GAS unsigned char* WI, gb WG, gcf SWM, int item, int lane, int glu) {
    const int nblk = N / 64, kb = item / nblk, nb = item - kb * nblk, k0 = 64 * kb, n = 64 * nb + lane;
    int up, c, no; if (glu) { up = n >= N / 2; c = up ? n - N / 2 : n; no = 256 * (c >> 7) + (c & 127) + (up ? 128 : 0); } else { up = n < 2048; c = n - 2048; no = n; }
    float v[64];
#pragma unroll
    for (int j = 0; j < 64; ++j) v[j] = (W + (size_t)(k0 + j) * N)[n];
    const float mx = SWM[no], inv = mx > 0.f ? 127.f / mx : 0.f;
    GAS v4u* dst = (GAS v4u*)(WI + (size_t)no * K + k0);
#pragma unroll
    for (int q = 0; q < 4; ++q) { v4u o; o.x = pk4_i8(v[16 * q] * inv, v[16 * q + 1] * inv, v[16 * q + 2] * inv, v[16 * q + 3] * inv); o.y = pk4_i8(v[16 * q + 4] * inv, v[16 * q + 5] * inv, v[16 * q + 6] * inv, v[16 * q + 7] * inv);
        o.z = pk4_i8(v[16 * q + 8] * inv, v[16 * q + 9] * inv, v[16 * q + 10] * inv, v[16 * q + 11] * inv); o.w = pk4_i8(v[16 * q + 12] * inv, v[16 * q + 13] * inv, v[16 * q + 14] * inv, v[16 * q + 15] * inv); dst[q] = o; }
    if (!up) { GAS v4u* dg = (GAS v4u*)(WG + (size_t)c * K + k0);
#pragma unroll
        for (int q = 0; q < 8; ++q) { v4u o; o.x = pk2(v[8 * q], v[8 * q + 1]); o.y = pk2(v[8 * q + 2], v[8 * q + 3]); o.z = pk2(v[8 * q + 4], v[8 * q + 5]); o.w = pk2(v[8 * q + 6], v[8 * q + 7]); dg[q] = o; } }
}
__device__ __forceinline__ void transpose_item(gcf W, int K, int N, int Npad, gb WT, int item, int lane, int glu = 0) {
    const int nblk = Npad / 64, kb = item / nblk, nb = item - kb * nblk, k0 = 64 * kb, n = 64 * nb + lane;
    int no = n; if (glu) { const int up = n >= N / 2, c = up ? n - N / 2 : n; no = 256 * (c >> 7) + (c & 127) + (up ? 128 : 0); }
    tr_col_bf16(W, N, k0, n, n < N, (GAS v4u*)(WT + (size_t)no * K + k0));
}
__device__ __forceinline__ void transpose_item8(gcf W, int K, int N, GAS unsigned char* WT, int item, int lane) {
    const int nblk = N / 64, kb = item / nblk, nb = item - kb * nblk, k0 = 64 * kb, n = 64 * nb + lane;
    tr_col_fp8(W, N, k0, n, (GAS v4u*)(WT + (size_t)n * K + k0));
}
__device__ __forceinline__ void cvt_rows(gcf src, gb dst, int cps, size_t dstride, int total, int gt, int GT) {
    for (int e = gt; e < total; e += GT) { const int sb = e / cps, rem = e - sb * cps; float f[8]; ldf8(src + (size_t)e * 8, f); *(GAS v4u*)(dst + (size_t)sb * dstride + (size_t)rem * 8) = pack8(f); }
}

__device__ __forceinline__ int kperm(int d) { return (d & 64) | ((d & 24) << 1) | ((d & 32) >> 2) | (d & 7); }
__device__ __forceinline__ void cvt_rows_k8(gcf src, GAS unsigned char* dst, int cps, size_t dstride, int total, int gt, int GT) {
    typedef unsigned u32x2t __attribute__((ext_vector_type(2)));
    for (int e = gt; e < total; e += GT) { const int sb = e / cps, rem = e - sb * cps; const int row = rem >> 6, c = rem & 63; float f[8]; ldf8(src + (size_t)e * 8, f);
        *(GAS u32x2t*)(dst + (size_t)sb * dstride + ((size_t)(c >> 4) * LSK + row) * 128 + kperm((c & 15) * 8)) = (u32x2t){pk4_fp8(f[0] * 16.f, f[1] * 16.f, f[2] * 16.f, f[3] * 16.f), pk4_fp8(f[4] * 16.f, f[5] * 16.f, f[6] * 16.f, f[7] * 16.f)}; }
}

__device__ __forceinline__ void cvt_rows_v8(gcf src, GAS unsigned char* dst, int cps, size_t dstride, int total, int gt, int GT) {
    typedef unsigned u32x2t __attribute__((ext_vector_type(2)));
    for (int e = gt; e < total; e += GT) { const int sb = e / cps, rem = e - sb * cps; const int row = rem >> 6, c = rem & 63; float f[8]; ldf8(src + (size_t)e * 8, f);
        *(GAS u32x2t*)(dst + (size_t)sb * dstride + ((size_t)(c >> 4) * LSK + row) * 128 + (c & 15) * 8) = (u32x2t){pk4_fp8(f[0] * 16.f, f[1] * 16.f, f[2] * 16.f, f[3] * 16.f), pk4_fp8(f[4] * 16.f, f[5] * 16.f, f[6] * 16.f, f[7] * 16.f)}; }
}

__device__ __forceinline__ void xrows_phase(gcf xp, gcf xs, gb XB, GAS unsigned char* XI, gf SA, gb XS, int gw, int NGW, int lane) {
    for (int row = gw; row < MROWS; row += NGW) {
        gcf xr = row < NPROW ? xp + (size_t)row * DM : xs + (size_t)(row - NPROW) * DM; float v[4][8]; float amax = 0.f;
#pragma unroll
        for (int j = 0; j < 4; ++j) { ldf8(xr + 8 * lane + 512 * j, v[j]);
#pragma unroll
            for (int e = 0; e < 8; ++e) amax = fmaxf(amax, fabsf(v[j][e])); }
#pragma unroll
        for (int o_ = 1; o_ < 64; o_ <<= 1) amax = fmaxf(amax, shfl_f(amax, lane ^ o_));
        const float inv = amax > 0.f ? 127.f / amax : 0.f; typedef unsigned u32x2t __attribute__((ext_vector_type(2)));
        const bool is_s = row >= NPROW; const int t = is_s ? ((row - NPROW) & 63) : (row & 4095), T = is_s ? DSEQ : SEQ;
        const int srow = (is_s ? 4 + ((row - NPROW) >> 6) * 2 : (row >> 12) * 2) + (t - (T - 2));
#pragma unroll
        for (int j = 0; j < 4; ++j) { const v4u pb = pack8(v[j]); *(GAS v4u*)(XB + (size_t)row * DM + 8 * lane + 512 * j) = pb;
            *(GAS u32x2t*)(XI + (size_t)row * DM + 8 * lane + 512 * j) = (u32x2t){pk4_i8(v[j][0] * inv, v[j][1] * inv, v[j][2] * inv, v[j][3] * inv), pk4_i8(v[j][4] * inv, v[j][5] * inv, v[j][6] * inv, v[j][7] * inv)};
            if (t >= T - 2) *(GAS v4u*)(XS + (size_t)srow * DM + 8 * lane + 512 * j) = pb; }
        if (lane == 0) SA[row] = amax * (1.f / 127.f);
    }
}

__device__ __forceinline__ void conv_mix_phase(gcb BCV, gb Z, gcf cw, gcf state, gf out, gcb GS, int gt, int GT) {
    for (int task = gt; task < (MROWS / 16) * 256; task += GT) {
        const int cg = task & 255, seg = task >> 8, row0 = seg * 16, c0 = cg * 8;
        const bool is_s = row0 >= NPROW; const int tl = is_s ? ((row0 - NPROW) & 63) : (row0 & 4095); const int sb = is_s ? ((row0 - NPROW) >> 6) : (row0 >> 12); const int T = is_s ? DSEQ : SEQ;
        float w0[8], w1[8], w2[8]; ldf8(cw + c0, w0); ldf8(cw + DM + c0, w1); ldf8(cw + 2 * DM + c0, w2);
        float um2[8], um1[8];
        if (tl == 0) {
            if (is_s) { ldf8(state + (size_t)(sb * 2 + 0) * DM + c0, um2); ldf8(state + (size_t)(sb * 2 + 1) * DM + c0, um1); }
            else {
#pragma unroll
                for (int e = 0; e < 8; ++e) { um2[e] = 0.f; um1[e] = 0.f; } }
        } else {
            float c8[8], v8[8];
            gcb p2 = BCV + (size_t)(row0 - 2) * NBCV + c0; unpack8(*(const GAS v4u*)(p2 + DM), c8); unpack8(*(const GAS v4u*)(p2 + 2 * DM), v8);
#pragma unroll
            for (int e = 0; e < 8; ++e) um2[e] = c8[e] * v8[e];
            gcb p1 = p2 + NBCV; unpack8(*(const GAS v4u*)(p1 + DM), c8); unpack8(*(const GAS v4u*)(p1 + 2 * DM), v8);
#pragma unroll
            for (int e = 0; e < 8; ++e) um1[e] = c8[e] * v8[e];
        }
#pragma unroll 4
        for (int r = 0; r < 16; ++r) {
            const int row = row0 + r; gcb p = BCV + (size_t)row * NBCV + c0;
            float b8[8], c8[8], v8[8], u[8], z[8];
            unpack8(*(const GAS v4u*)p, b8); unpack8(*(const GAS v4u*)(p + DM), c8); unpack8(*(const GAS v4u*)(p + 2 * DM), v8);
#pragma unroll
            for (int e = 0; e < 8; ++e) { u[e] = c8[e] * v8[e]; z[e] = b8[e] * (w0[e] * um2[e] + w1[e] * um1[e] + w2[e] * u[e]); }
            *(GAS v4u*)(Z + (size_t)row * DM + c0) = pack8(z);
            const int j = tl + r - (T - 2);
            if (j >= 0) { const int srow = (is_s ? 4 + sb * 2 : sb * 2) + j; float ca[8], cb_[8], va[8], vb[8], us[8];
                unpack8(*(const GAS v4u*)(GS + (size_t)srow * 4096 + c0), ca); unpack8(*(const GAS v4u*)(GS + (size_t)(256 + srow) * 4096 + c0), cb_);
                unpack8(*(const GAS v4u*)(GS + (size_t)srow * 4096 + 2048 + c0), va); unpack8(*(const GAS v4u*)(GS + (size_t)(256 + srow) * 4096 + 2048 + c0), vb);
#pragma unroll
                for (int e = 0; e < 8; ++e) us[e] = (ca[e] + cb_[e]) * (va[e] + vb[e]);
                stf8(out + (is_s ? O_CMS : O_CMP) + (size_t)(sb * 2 + j) * DM + c0, us); }
#pragma unroll
            for (int e = 0; e < 8; ++e) { um2[e] = um1[e]; um1[e] = u[e]; }
        }
    }
}
__device__ __forceinline__ void glu_fixup_phase(gcf FIXG, gcf FIXU, gcf HALO, GAS unsigned char* H, gcf cw, gcf cb, gcf state, gf out, gcb GS, int layer, int gt, int GT) {
    constexpr int NCG = DFF / 8;
    for (int task = gt; task < 320 * NCG; task += GT) {
        const int rid = task / NCG, cg = task - rid * NCG, bk = rid >> 1, j = rid & 1, c0 = cg * 8, row = 64 * bk + j;
        const bool is_s = bk >= 128; const int sb = is_s ? bk - 128 : bk >> 6; const bool seq_start = is_s || (bk & 63) == 0, seq_end = is_s || (bk & 63) == 63;
        float w0[8], w1[8], w2[8], bb[8], g0[8], u0[8], h1[8], h0[8];
        ldf8(cw + c0, w0); ldf8(cw + DFF + c0, w1); ldf8(cw + 2 * DFF + c0, w2); ldf8(cb + c0, bb); ldf8(FIXG + (size_t)rid * DFF + c0, g0); ldf8(FIXU + (size_t)rid * DFF + c0, u0);
        if (seq_start) { if (is_s) { ldf8(state + (size_t)(sb * 2 + 0) * DFF + c0, h0); ldf8(state + (size_t)(sb * 2 + 1) * DFF + c0, h1); } else {
#pragma unroll
            for (int e = 0; e < 8; ++e) { h0[e] = 0.f; h1[e] = 0.f; } } }
        else { ldf8(HALO + (size_t)((bk - 1) * 2 + 0) * DFF + c0, h0); ldf8(HALO + (size_t)((bk - 1) * 2 + 1) * DFF + c0, h1); }
        float g1[8], g2[8];
        if (j == 0) {
#pragma unroll
            for (int e = 0; e < 8; ++e) { g1[e] = h1[e]; g2[e] = h0[e]; } }
        else { ldf8(FIXG + (size_t)(bk * 2) * DFF + c0, g1);
#pragma unroll
            for (int e = 0; e < 8; ++e) g2[e] = h1[e]; }
        float h[8];
#pragma unroll
        for (int e = 0; e < 8; ++e) { const float a = w0[e] * g2[e] + w1[e] * g1[e] + w2[e] * g0[e] + bb[e];
            const float sg = __builtin_amdgcn_rcpf(1.f + __builtin_amdgcn_exp2f(-a * 1.4426950408889634f)); h[e] = a * sg * u0[e] * 16.f; }
        { typedef unsigned u32x2t __attribute__((ext_vector_type(2)));
          *(GAS u32x2t*)(H + (size_t)row * DFF + c0) = (u32x2t){pk4_fp8(h[0], h[1], h[2], h[3]), pk4_fp8(h[4], h[5], h[6], h[7])}; }
        if (seq_end) { float s8[8], t8[8]; const int srow = (is_s ? 4 + sb * 2 : sb * 2) + j;
            unpack8(*(const GAS v4u*)(GS + (size_t)srow * DFF + c0), s8); unpack8(*(const GAS v4u*)(GS + (size_t)(256 + srow) * DFF + c0), t8);
#pragma unroll
            for (int e = 0; e < 8; ++e) s8[e] += t8[e];
            stf8(out + (is_s ? O_FCS + (size_t)((layer * 32 + sb) * 2 + j) * DFF : O_FCP + (size_t)((layer * 2 + sb) * 2 + j) * DFF) + c0, s8); }
    }
}
__device__ __forceinline__ void ln_phase(gcb Y, gcf P, gcf g, gcf b, gf XF, gb XB, GAS unsigned char* X8, GAS unsigned char* XI, gf SA, gb XS, int gw, int NGW, int lane) {
    for (int row = gw; row < MROWS; row += NGW) {
        float v[4][8]; float s = 0.f;
#pragma unroll
        for (int j = 0; j < 4; ++j) unpack8(*(const GAS v4u*)(Y + (size_t)row * DM + 8 * lane + 512 * j), v[j]);
        if (row >= NPROW) {
#pragma unroll
            for (int q = 0; q < 3; ++q) { gcf pr = P + ((size_t)q * 2048 + (size_t)(row - NPROW)) * DM + 8 * lane;
#pragma unroll
                for (int j = 0; j < 4; ++j) { float t[8]; ldf8(pr + 512 * j, t);
#pragma unroll
                    for (int e = 0; e < 8; ++e) v[j][e] += t[e]; } }
        }
#pragma unroll
        for (int j = 0; j < 4; ++j)
#pragma unroll
            for (int e = 0; e < 8; ++e) s += v[j][e];
        const float mean = wave_sum(s, lane) * (1.f / DM); float s2 = 0.f;
#pragma unroll
        for (int j = 0; j < 4; ++j)
#pragma unroll
            for (int e = 0; e < 8; ++e) { v[j][e] -= mean; s2 += v[j][e] * v[j][e]; }
        const float rstd = 1.f / sqrtf(wave_sum(s2, lane) * (1.f / DM) + LN_EPS);
        float amax = 0.f;
#pragma unroll
        for (int j = 0; j < 4; ++j) { float g8[8], b8[8], o[8]; ldf8(g + 8 * lane + 512 * j, g8); ldf8(b + 8 * lane + 512 * j, b8);
#pragma unroll
            for (int e = 0; e < 8; ++e) { o[e] = v[j][e] * rstd * g8[e] + b8[e]; v[j][e] = o[e]; amax = fmaxf(amax, fabsf(o[e])); }
            if (XF) stf8(XF + (size_t)row * DM + 8 * lane + 512 * j, o);
            if (XB) *(GAS v4u*)(XB + (size_t)row * DM + 8 * lane + 512 * j) = pack8(o);
            if (X8) { typedef unsigned u32x2t __attribute__((ext_vector_type(2))); *(GAS u32x2t*)(X8 + (size_t)row * DM + 8 * lane + 512 * j) = (u32x2t){pk4_fp8(o[0] * 16.f, o[1] * 16.f, o[2] * 16.f, o[3] * 16.f), pk4_fp8(o[4] * 16.f, o[5] * 16.f, o[6] * 16.f, o[7] * 16.f)}; } }
        if (XI) {
#pragma unroll
            for (int o_ = 1; o_ < 64; o_ <<= 1) amax = fmaxf(amax, shfl_f(amax, lane ^ o_));
            const float inv = amax > 0.f ? 127.f / amax : 0.f; typedef unsigned u32x2t __attribute__((ext_vector_type(2)));
#pragma unroll
            for (int j = 0; j < 4; ++j) *(GAS u32x2t*)(XI + (size_t)row * DM + 8 * lane + 512 * j) = (u32x2t){pk4_i8(v[j][0] * inv, v[j][1] * inv, v[j][2] * inv, v[j][3] * inv), pk4_i8(v[j][4] * inv, v[j][5] * inv, v[j][6] * inv, v[j][7] * inv)};
            if (lane == 0) SA[row] = amax * (1.f / 127.f);
            const bool is_s = row >= NPROW; const int t = is_s ? ((row - NPROW) & 63) : (row & 4095), T = is_s ? DSEQ : SEQ;
            if (t >= T - 2) { const int srow = (is_s ? 4 + ((row - NPROW) >> 6) * 2 : (row >> 12) * 2) + (t - (T - 2));
#pragma unroll
                for (int j = 0; j < 4; ++j) *(GAS v4u*)(XS + (size_t)srow * DM + 8 * lane + 512 * j) = pack8(v[j]); }
        }
    }
}

__device__ __forceinline__ void postproj_phase(gcb PQ, gcb PK, const __attribute__((address_space(4))) float* inv_freq, gcf kng, gcf knb, gf out,
                                               gb QR, gb IQ, gb KP, gb VP, gb IKP, gb KS, gb VS, gb IKS, gf IW, int gw, int NGW, int lane) {
    typedef unsigned u32x2t __attribute__((ext_vector_type(2)));
    const int c = lane & 7, hh = lane >> 3, d0 = 8 * c;
    float invf[8], g1[8], g2[8], bb1[8], bb2[8];
#pragma unroll
    for (int e = 0; e < 8; ++e) { invf[e] = inv_freq[d0 + e]; g1[e] = kng[d0 + e]; g2[e] = kng[64 + d0 + e]; bb1[e] = knb[d0 + e]; bb2[e] = knb[64 + d0 + e]; }
    for (int row = gw; row < MROWS; row += NGW) {
        const bool is_s = row >= NPROW; const int sb = is_s ? ((row - NPROW) >> 6) : (row >> 12); const int t = is_s ? ((row - NPROW) & 63) : (row & 4095);
        const int pos = is_s ? PAST + t : t;
        float cs[8], sn[8];
#pragma unroll
        for (int e = 0; e < 8; ++e) { const float ang = (float)pos * invf[e];
            const double rev = (double)ang * 0.15915494309189535; const float fr = (float)(rev - __builtin_rint(rev));
            cs[e] = __builtin_amdgcn_cosf(fr); sn[e] = __builtin_amdgcn_sinf(fr); }
        gcb Pq = PQ + (size_t)row * 4096; gcb P = PK + (size_t)row * 1280;
        gb qo = QR + (size_t)row * DM; gb iqo = IQ + (size_t)row * DM;
#pragma unroll
        for (int p = 0; p < 2; ++p) { const int h = 8 * p + hh;
            float x1[8], x2[8], y1[8], y2[8], o1[8], o2[8];
            unpack8(*(const GAS v4u*)(Pq + h * 128 + d0), x1); unpack8(*(const GAS v4u*)(Pq + h * 128 + 64 + d0), x2);
            unpack8(*(const GAS v4u*)(Pq + 2048 + h * 128 + d0), y1); unpack8(*(const GAS v4u*)(Pq + 2048 + h * 128 + 64 + d0), y2);
#pragma unroll
            for (int e = 0; e < 8; ++e) { o1[e] = x1[e] * cs[e] - x2[e] * sn[e]; o2[e] = x1[e] * sn[e] + x2[e] * cs[e]; }
            *(GAS v4u*)(qo + h * 128 + d0) = pack8(o1); *(GAS v4u*)(qo + h * 128 + 64 + d0) = pack8(o2);
#pragma unroll
            for (int e = 0; e < 8; ++e) { o1[e] = y1[e] * cs[e] - y2[e] * sn[e]; o2[e] = y1[e] * sn[e] + y2[e] * cs[e]; }
            *(GAS v4u*)(iqo + h * 128 + d0) = pack8(o1); *(GAS v4u*)(iqo + h * 128 + 64 + d0) = pack8(o2);
        }
        gf kof = out + (is_s ? O_KS + (size_t)(row - NPROW) * KVW : O_KP + (size_t)row * KVW);
        gf vof = out + (is_s ? O_VS + (size_t)(row - NPROW) * KVW : O_VP + (size_t)row * KVW);
        GAS unsigned char* kob = is_s ? (GAS unsigned char*)KS + ((size_t)sb * 4 * LSK + PAST + t) * 128 : (GAS unsigned char*)KP + ((size_t)sb * 4 * SEQ + t) * 128;
        GAS unsigned char* vob = is_s ? (GAS unsigned char*)VS + ((size_t)sb * 4 * LSK + PAST + t) * 128 : (GAS unsigned char*)VP + ((size_t)sb * 4 * SEQ + t) * 128;
        const size_t gstr = (size_t)(is_s ? LSK : SEQ) * 128;
        if (hh < 4) { const int g = hh;
            float x1[8], x2[8], o1[8], o2[8];
            unpack8(*(const GAS v4u*)(P + g * 128 + d0), x1); unpack8(*(const GAS v4u*)(P + g * 128 + 64 + d0), x2);
#pragma unroll
            for (int e = 0; e < 8; ++e) { o1[e] = x1[e] * cs[e] - x2[e] * sn[e]; o2[e] = x1[e] * sn[e] + x2[e] * cs[e]; }
            stf8(kof + g * 128 + d0, o1); stf8(kof + g * 128 + 64 + d0, o2);
            *(GAS u32x2t*)(kob + g * gstr + kperm(d0)) = (u32x2t){pk4_fp8(o1[0] * 16.f, o1[1] * 16.f, o1[2] * 16.f, o1[3] * 16.f), pk4_fp8(o1[4] * 16.f, o1[5] * 16.f, o1[6] * 16.f, o1[7] * 16.f)};
            *(GAS u32x2t*)(kob + g * gstr + kperm(64 + d0)) = (u32x2t){pk4_fp8(o2[0] * 16.f, o2[1] * 16.f, o2[2] * 16.f, o2[3] * 16.f), pk4_fp8(o2[4] * 16.f, o2[5] * 16.f, o2[6] * 16.f, o2[7] * 16.f)};
        }
        { float vf[8]; unpack8(*(const GAS v4u*)(P + 512 + 8 * lane), vf); stf8(vof + 8 * lane, vf);
          *(GAS u32x2t*)(vob + (size_t)(lane >> 4) * gstr + ((8 * lane) & 127)) = (u32x2t){pk4_fp8(vf[0] * 16.f, vf[1] * 16.f, vf[2] * 16.f, vf[3] * 16.f), pk4_fp8(vf[4] * 16.f, vf[5] * 16.f, vf[6] * 16.f, vf[7] * 16.f)}; }
        {
            float x1[8], x2[8]; float s = 0.f;
            if (hh == 0) { unpack8(*(const GAS v4u*)(P + 1024 + d0), x1); unpack8(*(const GAS v4u*)(P + 1024 + 64 + d0), x2); }
            else {
#pragma unroll
                for (int e = 0; e < 8; ++e) { x1[e] = 0.f; x2[e] = 0.f; } }
#pragma unroll
            for (int e = 0; e < 8; ++e) s += x1[e] + x2[e];
            const float mean = wave_sum(s, lane) * (1.f / 128.f); float s2 = 0.f;
#pragma unroll
            for (int e = 0; e < 8; ++e) { x1[e] -= mean; x2[e] -= mean; s2 += x1[e] * x1[e] + x2[e] * x2[e]; }
            if (hh != 0) s2 = 0.f;
            const float rstd = 1.f / sqrtf(wave_sum(s2, lane) * (1.f / 128.f) + LN_EPS);
            if (hh == 0) {
                float o1[8], o2[8];
#pragma unroll
                for (int e = 0; e < 8; ++e) { const float n1 = x1[e] * rstd * g1[e] + bb1[e], n2 = x2[e] * rstd * g2[e] + bb2[e]; o1[e] = n1 * cs[e] - n2 * sn[e]; o2[e] = n1 * sn[e] + n2 * cs[e]; }
                gf iof = out + (is_s ? O_IKS + (size_t)(row - NPROW) * IDXD : O_IKP + (size_t)row * IDXD);
                gb iob = is_s ? IKS + ((size_t)sb * LSK + PAST + t) * IDXD : IKP + (size_t)row * IDXD;
                stf8(iof + d0, o1); stf8(iof + 64 + d0, o2); *(GAS v4u*)(iob + d0) = pack8(o1); *(GAS v4u*)(iob + 64 + d0) = pack8(o2);
            }
        }
        if (lane < 16) IW[(size_t)row * 16 + lane] = bf1(P[1152 + lane]) * IDX_W_SCALE;
    }
}

__device__ __forceinline__ void indexer_phase(LAS unsigned char* L, gcb IQ, gcf IW, gcb IKP, gcb IKS, gf SCP, gf SCS,
                                              int vcu, int G, int tid, int lane, int wave) {
    const int r32 = lane & 31, hi = lane >> 5;
    for (int u = vcu; u < 1376; u += G) {
        int qrow0, kt, scld; gcb IKb; gf scb;
        if (u < 1088) { const int b = u / 544; int r = u - b * 544; int gq = 0; while (r >= 4 * (gq + 1)) { r -= 4 * (gq + 1); ++gq; }
            const int c = 4 * gq + r / (gq + 1); kt = r % (gq + 1); qrow0 = b * SEQ + 64 * c; IKb = IKP + (size_t)b * SEQ * IDXD; scb = SCP + (size_t)qrow0 * SEQ; scld = SEQ; }
        else { const int us = u - 1088; const int sb = us / 9; kt = us - sb * 9; qrow0 = NPROW + 64 * sb; IKb = IKS + (size_t)sb * LSK * IDXD; scb = SCS + (size_t)(64 * sb) * SCS_LD; scld = SCS_LD; }
        const int key0 = kt * 256 + 32 * wave;
        pg8::bf16x8 a[8];
#pragma unroll
        for (int ks = 0; ks < 8; ++ks) a[ks] = *(const GAS pg8::bf16x8*)(IKb + (size_t)(key0 + r32) * IDXD + 16 * ks + 8 * hi);
        f32x16 I0, I1;
#pragma unroll
        for (int r = 0; r < 16; ++r) { I0[r] = 0.f; I1[r] = 0.f; }
        const int sq = tid >> 3, sc0 = tid & 7;
        gcb iqsrc = IQ + (size_t)(qrow0 + sq) * DM + sc0 * 8;
        const unsigned wofs0 = (unsigned)(sq * 256 + ((sc0 ^ (sq & 15)) * 16)), wofs1 = (unsigned)(sq * 256 + (((sc0 + 8) ^ (sq & 15)) * 16));
        gcf iw0 = IW + (size_t)(qrow0 + r32) * 16; gcf iw1 = iw0 + 32 * 16;
        v4u se0 = *(const GAS v4u*)iqsrc, se1 = *(const GAS v4u*)(iqsrc + 64), so0 = *(const GAS v4u*)(iqsrc + 128), so1 = *(const GAS v4u*)(iqsrc + 128 + 64);
        float wn0 = iw0[0], wn1 = iw1[0];
        *(LAS v4u*)(L + wofs0) = se0; *(LAS v4u*)(L + wofs1) = se1;
        const unsigned rofs = (unsigned)(r32 * 256), rx = (unsigned)(r32 & 15);
        const f32x2 csc2 = {9.094947017729282e-13f, 9.094947017729282e-13f};
#define IDX_HEAD(h_, LDNEXT, STNEXT) do { __syncthreads(); const float wc0_ = wn0, wc1_ = wn1; LDNEXT; if ((h_) < 15) { wn0 = iw0[(h_) + 1]; wn1 = iw1[(h_) + 1]; } \
            LAS unsigned char* buf_ = L + ((h_) & 1) * 16384; f32x16 S0_, S1_; _Pragma("unroll") for (int r_ = 0; r_ < 16; ++r_) { S0_[r_] = 0.f; S1_[r_] = 0.f; } \
            _Pragma("unroll") for (int ks_ = 0; ks_ < 8; ++ks_) { const unsigned co_ = (((unsigned)(2 * ks_ + hi)) ^ rx) * 16u; \
                const pg8::bf16x8 b0_ = *(const LAS pg8::bf16x8*)(buf_ + rofs + co_), b1_ = *(const LAS pg8::bf16x8*)(buf_ + 8192 + rofs + co_); \
                S0_ = __builtin_amdgcn_mfma_f32_32x32x16_bf16(a[ks_], b0_, S0_, 0, 0, 0); S1_ = __builtin_amdgcn_mfma_f32_32x32x16_bf16(a[ks_], b1_, S1_, 0, 0, 0); } \
              \
            asm volatile("s_nop 7\n\ts_nop 7\n\ts_nop 7" ::: "memory");     \
            _Pragma("unroll") for (int r_ = 0; r_ < 8; ++r_) { f32x2 s0_ = {S0_[2 * r_], S0_[2 * r_ + 1]}, s1_ = {S1_[2 * r_], S1_[2 * r_ + 1]}, t0_, t1_; \
                asm("v_pk_mul_f32 %0, %1, %2 clamp" : "=v"(t0_) : "v"(s0_), "v"(csc2)); asm("v_pk_mul_f32 %0, %1, %2 clamp" : "=v"(t1_) : "v"(s1_), "v"(csc2)); \
                const float wa_ = wc0_ * 1099511627776.f, wb_ = wc1_ * 1099511627776.f; \
                I0[2 * r_] += wa_ * t0_[0]; I0[2 * r_ + 1] += wa_ * t0_[1]; I1[2 * r_] += wb_ * t1_[0]; I1[2 * r_ + 1] += wb_ * t1_[1]; } \
            STNEXT; } while (0)
#pragma unroll 1
        for (int h = 0; h < 16; h += 2) {
            IDX_HEAD(h, if (h + 2 < 16) { se0 = *(const GAS v4u*)(iqsrc + (h + 2) * 128); se1 = *(const GAS v4u*)(iqsrc + (h + 2) * 128 + 64); },
                     { LAS unsigned char* nb_ = L + 16384; *(LAS v4u*)(nb_ + wofs0) = so0; *(LAS v4u*)(nb_ + wofs1) = so1; });
            IDX_HEAD(h + 1, if (h + 3 < 16) { so0 = *(const GAS v4u*)(iqsrc + (h + 3) * 128); so1 = *(const GAS v4u*)(iqsrc + (h + 3) * 128 + 64); },
                     if (h + 2 < 16) { *(LAS v4u*)(L + wofs0) = se0; *(LAS v4u*)(L + wofs1) = se1; });
        }
#undef IDX_HEAD
#pragma unroll
        for (int j = 0; j < 4; ++j) {
            *(GAS f32x4*)(scb + (size_t)r32 * scld + key0 + 8 * j + 4 * hi) = (f32x4){I0[4 * j], I0[4 * j + 1], I0[4 * j + 2], I0[4 * j + 3]};
            *(GAS f32x4*)(scb + (size_t)(32 + r32) * scld + key0 + 8 * j + 4 * hi) = (f32x4){I1[4 * j], I1[4 * j + 1], I1[4 * j + 2], I1[4 * j + 3]};
        }
        __syncthreads();
    }
}

__device__ __forceinline__ void topk_phase(LAS unsigned char* L, gcf SCP, gcf SCS, gi SEL, int gw, int NGW, int lane, int wave) {
    typedef unsigned u32x4t __attribute__((ext_vector_type(4)));
    LAS unsigned* hist = (LAS unsigned*)(L + wave * 17408);
#define TK_ROW(q0_, q_, Lk_, src_) do { q_ = ((q0_) < NPROW && ((q0_) & 2048)) ? (((q0_) & ~4095) | (4095 - ((q0_) & 2047))) : (q0_); \
        if (q_ < NPROW) { const int t_ = q_ & 4095; Lk_ = ((t_ >> 6) + 1) * 64; src_ = SCP + (size_t)q_ * SEQ; } else { Lk_ = LSK; src_ = SCS + (size_t)(q_ - NPROW) * SCS_LD; } } while (0)
#define TK_LOAD(Lk_, src_) do { const int nv_ = (Lk_) >> 6; _Pragma("unroll") for (int gI_ = 0; gI_ < 8; ++gI_) if (nv_ > gI_ * 8) { \
        _Pragma("unroll") for (int i_ = gI_ * 8; i_ < gI_ * 8 + 8; ++i_) raw[i_] = __float_as_uint((src_)[i_ < nv_ ? i_ * 64 + lane : 0]); } } while (0)
    unsigned raw[64];
    if (gw < MROWS) { int q_, Lk_; gcf src_; TK_ROW(gw, q_, Lk_, src_); if (Lk_ > 256) TK_LOAD(Lk_, src_); }
    for (int q0 = gw; q0 < MROWS; q0 += NGW) {
        int q, Lk; gcf src; TK_ROW(q0, q, Lk, src);
        gi selq = SEL + (size_t)q * 256;
        const int nv = Lk >> 6;
        unsigned key[64];
        if (Lk > 256) {
#pragma unroll
            for (int i = 0; i < 64; ++i) { const unsigned ub = raw[i]; key[i] = i < nv ? ((ub & 0x80000000u) ? ~ub : (ub | 0x80000000u)) : 0u; }
        }
        if (q0 + NGW < MROWS) { int qn_, Lkn_; gcf srcn_; TK_ROW(q0 + NGW, qn_, Lkn_, srcn_); if (Lkn_ > 256) TK_LOAD(Lkn_, srcn_); }
        if (Lk <= 256) { for (int i = lane; i < Lk; i += 64) selq[i] = i; continue; }
        unsigned prefix = 0u; int need = 256;
#pragma unroll 1
        for (int pass = 0; pass < 4; ++pass) {
            const int sh = 24 - 8 * pass; const unsigned himask = pass == 0 ? 0u : (0xffffffffu << (sh + 8));
            *(LAS u32x4t*)(hist + 4 * lane) = (u32x4t){0u, 0u, 0u, 0u};
#pragma unroll
            for (int gI = 0; gI < 8; ++gI) if (nv > gI * 8) {
#pragma unroll
                for (int i = gI * 8; i < gI * 8 + 8; ++i) { const unsigned k = key[i];
                    const bool hit = k != 0u && ((k ^ prefix) & himask) == 0u;
                    if (pass < 2 || __ballot(hit) != 0ull)
                        __hip_atomic_fetch_add(hist + (hit ? ((k >> sh) & 255u) : 256u + (unsigned)lane), 1u, __ATOMIC_RELAXED, __HIP_MEMORY_SCOPE_WORKGROUP); }
            }
            const u32x4t h4 = *(const LAS u32x4t*)(hist + 4 * lane);
            const int s = (int)(h4.x + h4.y + h4.z + h4.w); int S = s;
#pragma unroll
            for (int off = 1; off < 64; off <<= 1) { const int t = __builtin_amdgcn_ds_bpermute(((lane + off) & 63) << 2, S); if (lane + off < 64) S += t; }
            const int above = S - s;
            const bool here = above < need && need <= S;
            int c = above, d = -1, nn = 0;
            { const int hb[4] = {(int)h4.x, (int)h4.y, (int)h4.z, (int)h4.w};
#pragma unroll
              for (int b = 3; b >= 0; --b) { if (d < 0) { if (c + hb[b] >= need) { d = b; nn = need - c; } else c += hb[b]; } } }
            const unsigned long long bal = __ballot(here);
            const int fl = __builtin_amdgcn_readfirstlane(bal ? __ffsll((long long)bal) - 1 : 0);
            const int digit = __builtin_amdgcn_readlane(4 * lane + d, fl);
            need = __builtin_amdgcn_readlane(nn, fl);
            prefix |= ((unsigned)digit & 255u) << sh;
        }
        int cge = 0, ceq = 0;
#pragma unroll
        for (int gI = 0; gI < 8; ++gI) if (nv > gI * 8) {
#pragma unroll
            for (int i = gI * 8; i < gI * 8 + 8; ++i) { cge += key[i] >= prefix ? 1 : 0; ceq += key[i] == prefix ? 1 : 0; }
        }
        const int eq_total = wave_sum_i(ceq, lane);
        if (eq_total == need) {
            int S = cge;
#pragma unroll
            for (int off = 1; off < 64; off <<= 1) { const int t = __builtin_amdgcn_ds_bpermute(((lane - off) & 63) << 2, S); if (lane >= off) S += t; }
            int pos = S - cge;
            LAS int* lst = (LAS int*)(hist + 512);
#pragma unroll
            for (int gI = 0; gI < 8; ++gI) if (nv > gI * 8) {
#pragma unroll
                for (int i = gI * 8; i < gI * 8 + 8; ++i) { const bool take = key[i] >= prefix; lst[take && pos < 256 ? pos : 256 + lane] = i * 64 + lane; pos += take ? 1 : 0; }
            }
#pragma unroll
            for (int i = 0; i < 4; ++i) selq[i * 64 + lane] = lst[i * 64 + lane];
        } else {
            int base = 0, eqtaken = 0;
#pragma unroll
            for (int gI = 0; gI < 8; ++gI) if (nv > gI * 8) {
#pragma unroll
                for (int i = gI * 8; i < gI * 8 + 8; ++i) {
                    const bool gtb = key[i] > prefix, eqb = key[i] == prefix;
                    const unsigned long long be = __ballot(eqb);
                    const int eqrank = eqtaken + (int)__builtin_amdgcn_mbcnt_hi((unsigned)(be >> 32), __builtin_amdgcn_mbcnt_lo((unsigned)be, 0u));
                    const bool take = gtb || (eqb && eqrank < need);
                    const unsigned long long bt = __ballot(take);
                    const int pos = base + (int)__builtin_amdgcn_mbcnt_hi((unsigned)(bt >> 32), __builtin_amdgcn_mbcnt_lo((unsigned)bt, 0u));
                    if (take && pos < 256) selq[pos] = i * 64 + lane;
                    base += __popcll(bt); eqtaken += __popcll(be);
                }
            }
        }
    }
}

#undef TK_ROW
#undef TK_LOAD
constexpr int ATT_WAVE_LDS = 17408;
__device__ __forceinline__ void attn_phase(LAS unsigned char* L, gcb QR, gb O, gci SEL, gcb KP, gcb VP, gcb KS, gcb VS, int vcu, int G, int lane, int wave) {
    const int kq = lane & 15, lg = lane >> 4;
    LAS unsigned char* Vt = L + wave * ATT_WAVE_LDS;
    LAS int* Sl = (LAS int*)(L + wave * ATT_WAVE_LDS + 16384);
    const int trrow = 8 * lg + (kq >> 1), trx = (trrow >> 1) & 7;
    const unsigned trbase_u = (unsigned)(uintptr_t)(Vt + trrow * 128 + 8 * (kq & 1)) | (unsigned)(trx << 4);
    const int drow = lane >> 3, dslot = lane & 7;
    const int cpx = G >> 3, x = cpx ? vcu / cpx : 8, li = cpx ? (vcu - x * cpx) * NWAVES + wave : 0, nwx = cpx * NWAVES;
    if (x >= 8 || li >= 5120) return;
#define TASK(tl_, q_, g_, nsel_, Kb8_, Vb8_) do { if ((tl_) < 4096) { const int b_ = x >> 2, t_ = (tl_); g_ = x & 3; q_ = b_ * SEQ + t_; const int Lk_ = ((t_ >> 6) + 1) * 64; nsel_ = Lk_ < 256 ? Lk_ : 256; \
            Kb8_ = (const GAS unsigned char*)KP + (size_t)(b_ * 4 + g_) * SEQ * 128; Vb8_ = (const GAS unsigned char*)VP + (size_t)(b_ * 4 + g_) * SEQ * 128; } \
        else { const int s_ = (tl_) - 4096, c_ = x * 16 + (s_ >> 6), sb_ = c_ >> 2; g_ = c_ & 3; q_ = NPROW + sb_ * 64 + (s_ & 63); nsel_ = 256; \
            Kb8_ = (const GAS unsigned char*)KS + (size_t)(sb_ * 4 + g_) * LSK * 128; Vb8_ = (const GAS unsigned char*)VS + (size_t)(sb_ * 4 + g_) * LSK * 128; } } while (0)
#define QCVT(dst_, raw_) do { _Pragma("unroll") for (int ks_ = 0; ks_ < 4; ++ks_) { float f_[8]; unpack8(raw_[ks_], f_); \
            const unsigned lo_ = pk4_fp8(f_[0] * 16.f, f_[1] * 16.f, f_[2] * 16.f, f_[3] * 16.f), hi_ = pk4_fp8(f_[4] * 16.f, f_[5] * 16.f, f_[6] * 16.f, f_[7] * 16.f); \
            dst_[ks_] = kq < 4 ? (long)(((unsigned long long)hi_ << 32) | lo_) : 0l; } } while (0)
    int tl = li, q, g, nsel; const GAS unsigned char* Kb8; const GAS unsigned char* Vb8;
    TASK(tl, q, g, nsel, Kb8, Vb8);
    long qf8[4];
    v4u kb[8][2];
#define KLDX(kg_, Kb8_) do { const GAS unsigned char* kr_ = Kb8_ + ((unsigned)Sl[(kg_) * 16 + kq] * 128u + 16u * (unsigned)lg);         kb[(kg_) & 7][0] = *(const GAS v4u*)kr_; kb[(kg_) & 7][1] = *(const GAS v4u*)(kr_ + 64); } while (0)
    {
        gci selq = SEL + (size_t)q * 256;
#pragma unroll
        for (int i = 0; i < 4; ++i) Sl[i * 64 + lane] = (i * 64 < nsel) ? selq[i * 64 + lane] : 0;
        v4u qraw[4];
#pragma unroll
        for (int ks = 0; ks < 4; ++ks) qraw[ks] = *(const GAS v4u*)(QR + (size_t)q * DM + (4 * g + (kq & 3)) * 128 + 32 * ks + 8 * lg);
        QCVT(qf8, qraw);
#pragma unroll
        for (int kg = 0; kg < 7; ++kg) KLDX(kg, Kb8);
    }
    for (;;) {
        const int tn = tl + nwx; const bool has_next = tn < 5120;
        int qn, gn, nseln; const GAS unsigned char* Kb8n; const GAS unsigned char* Vb8n;
        TASK(has_next ? tn : tl, qn, gn, nseln, Kb8n, Vb8n);
        const int nkg = nsel >> 4, nt = nkg >> 1;
#define VDMA(t_) do { LAS unsigned char* dst_ = Vt + ((t_) & 3) * 4096; \
            _Pragma("unroll") for (int i_ = 0; i_ < 4; ++i_) { const int sx_ = Sl[(2 * (t_) + (drow >> 2)) * 16 + 4 * i_ + (drow & 3)];     \
                const int n_ = dslot ^ ((4 * (i_ & 1) + (drow >> 1)) & 7);                                                         \
                __builtin_amdgcn_global_load_lds((const GAS unsigned*)(Vb8 + ((unsigned)sx_ * 128u + (unsigned)n_ * 16u)), (LAS unsigned*)(dst_ + i_ * 1024), 16, 0, 0); } } while (0)
        VDMA(0); VDMA(1); if (nt > 2) VDMA(2);
        f32x4 sc[16];
#pragma unroll
        for (int kg = 0; kg < 16; ++kg) {
            if (kg < nkg) {
                if (kg + 7 < nkg) { if (kg + 7 < 16) KLDX((kg + 7) & 15, Kb8); }
                f32x4 acc = {0.f, 0.f, 0.f, 0.f};
#pragma unroll
                for (int ks = 0; ks < 4; ++ks) { const v4u w = kb[kg & 7][ks >> 1]; const long a8 = (ks & 1) ? (long)(((unsigned long long)w.w << 32) | w.z) : (long)(((unsigned long long)w.y << 32) | w.x);
                    acc = __builtin_amdgcn_mfma_f32_16x16x32_fp8_fp8(a8, qf8[ks], acc, 0, 0, 0); }
                sc[kg] = acc;
            } else sc[kg] = (f32x4){-INFINITY, -INFINITY, -INFINITY, -INFINITY};
        }
        int selraw[4]; v4u qrawn[4];
        { gci selqn = SEL + (size_t)qn * 256;
#pragma unroll
          for (int i = 0; i < 4; ++i) selraw[i] = (i * 64 < nseln) ? selqn[i * 64 + lane] : 0;
#pragma unroll
          for (int ks = 0; ks < 4; ++ks) qrawn[ks] = *(const GAS v4u*)(QR + (size_t)qn * DM + (4 * gn + (kq & 3)) * 128 + 32 * ks + 8 * lg); }
        float mx = sc[0][0];
#pragma unroll
        for (int kg = 0; kg < 16; ++kg)
#pragma unroll
            for (int r = 0; r < 4; ++r) mx = fmaxf(mx, sc[kg][r]);
        mx = fmaxf(mx, shfl_f(mx, lane ^ 16)); mx = fmaxf(mx, shfl_f(mx, lane ^ 32));
        float sm = 0.f; unsigned pp[16];
        const float e_c = ATTN_SC2 * (1.f / 256.f), e_b = 8.f - mx * e_c;
#pragma unroll
        for (int kg = 0; kg < 16; ++kg) { float p[4];
#pragma unroll
            for (int r = 0; r < 4; ++r) { p[r] = __builtin_amdgcn_exp2f(__builtin_fmaf(sc[kg][r], e_c, e_b)); sm += p[r]; }
            pp[kg] = pk4_fp8_nc(p[0], p[1], p[2], p[3]); }
        sm += shfl_f(sm, lane ^ 16); sm += shfl_f(sm, lane ^ 32);
        f32x4 oacc[8];
#pragma unroll
        for (int n = 0; n < 8; ++n) oacc[n] = (f32x4){0.f, 0.f, 0.f, 0.f};
#define VMM(t_) do { unsigned ta_ = trbase_u + ((t_) & 3) * 4096; asm volatile("" : "+v"(ta_)); long va_[8];     \
            const long pb_ = (long)(((unsigned long long)pp[2 * (t_) + 1] << 32) | (unsigned long long)pp[2 * (t_)]); \
            _Pragma("unroll") for (int n_ = 0; n_ < 8; ++n_) asm volatile("ds_read_b64_tr_b8 %0, %1" : "=&v"(va_[n_]) : "v"(ta_ ^ (unsigned)(n_ << 4)) : "memory"); \
            asm volatile("s_waitcnt lgkmcnt(0)" ::: "memory"); __builtin_amdgcn_sched_barrier(0); \
            _Pragma("unroll") for (int n_ = 0; n_ < 8; ++n_) oacc[n_] = __builtin_amdgcn_mfma_f32_16x16x32_fp8_fp8(va_[n_], pb_, oacc[n_], 0, 0, 0); } while (0)
#define KNEXT do { _Pragma("unroll") for (int i_ = 0; i_ < 4; ++i_) Sl[i_ * 64 + lane] = selraw[i_]; QCVT(qf8, qrawn); \
            _Pragma("unroll") for (int kg_ = 0; kg_ < 7; ++kg_) KLDX(kg_, Kb8n); } while (0)
        if (nt == 2) { asm volatile("s_waitcnt vmcnt(0)" ::: "memory"); KNEXT; }
#pragma unroll
        for (int t = 0; t < 8; ++t) {
            if (t < nt) {
                if (t + 3 < nt) { VDMA(t + 3); if (t >= 3) asm volatile("s_waitcnt vmcnt(12)" ::: "memory"); }
                else if (t >= 3) {
                    if (t + 2 < nt) asm volatile("s_waitcnt vmcnt(22)" ::: "memory");
                    else if (t + 1 < nt) asm volatile("s_waitcnt vmcnt(18)" ::: "memory");
                    else asm volatile("s_waitcnt vmcnt(14)" ::: "memory");
                }
                VMM(t);
                if (t + 4 == nt) KNEXT;
            }
        }
#undef VDMA
#undef VMM
#undef KNEXT
        const float inv = 4.f / sm;
        if (kq < 4) {
#pragma unroll
            for (int n = 0; n < 8; ++n) { const f32x4 v = oacc[n] * inv;
                *(GAS unsigned*)((GAS unsigned char*)O + (size_t)q * DM + (4 * g + kq) * 128 + 16 * n + 4 * lg) = pk4_fp8(v[0], v[1], v[2], v[3]); }
        }
        if (!has_next) break;
        tl = tn; q = qn; g = gn; nsel = nseln; Kb8 = Kb8n; Vb8 = Vb8n;
    }
#undef KLDX
#undef TASK
#undef QCVT
}

constexpr int RING_BYTES = 131072, LDSCTL_OFF = 139264  , MISC_OFF = LDSCTL_OFF + 320, LDS_BYTES = 147456;
struct Args { const float* in[22]; float* out; unsigned char* ws; float inv_freq[64]; };
constexpr int NSTEP = 25;
#ifndef PH_MASK
#define PH_MASK 0x3ff
#endif
#define PHM(k) (((PH_MASK) >> (k)) & 1)
#ifndef REP_MASK
#define REP_MASK 0
#endif

#define PH_ENV \
        int tid; asm volatile("v_mbcnt_lo_u32_b32 %0, -1, 0\n\tv_mbcnt_hi_u32_b32 %0, -1, %0" : "=v"(tid)); tid += wave_s * 64; \
        const __attribute__((address_space(4))) Args* ap = (const __attribute__((address_space(4))) Args*)__builtin_amdgcn_kernarg_segment_ptr(); asm volatile("" : "+s"(ap)); \
        const int lane = tid & 63, wave = wave_s; \
        const int G = gridDim.x, bx = blockIdx.x; const int vcu = (G % 8 == 0) ? (bx % 8) * (G / 8) + bx / 8 : bx; \
        const int gt = vcu * NTHR + tid, GT = G * NTHR, gw = vcu * NWAVES + wave, NGW = G * NWAVES; \
        GAS unsigned char* ws = (GAS unsigned char*)ap->ws; gf out = (gf)ap->out; \
        gcf xp = (gcf)ap->in[0]; gcf xs = (gcf)ap->in[1]; \
        gb WMI = (gb)(ws + WS_WMI); gb WMO = (gb)(ws + WS_WMO); gb WAI = (gb)(ws + WS_WAI); gb WAO = (gb)(ws + WS_WAO); \
        gb WF1 = (gb)(ws + WS_WF1); gb WF2 = (gb)(ws + WS_WF2); \
        gb XB = (gb)(ws + WS_XB); gf XF = (gf)(ws + WS_XF); gb Y = (gb)(ws + WS_Y); gb BIG = (gb)(ws + WS_BIG); gb HB = (gb)(ws + WS_H); \
        gb KP = (gb)(ws + WS_KP); gb VP = (gb)(ws + WS_VP); gb IKP = (gb)(ws + WS_IKP); gf IW = (gf)(ws + WS_IW); gi SEL = (gi)(ws + WS_SEL); \
        gb IKS = (gb)(ws + WS_IKS); gb KS = (gb)(ws + WS_KS); gb VS = (gb)(ws + WS_VS); \
        gf SCP = (gf)(ws + WS_SCP); gf SCS = (gf)(ws + WS_SCS); gb QR = (gb)(ws + WS_QR); gb IQ = (gb)(ws + WS_IQ);
__global__ void __launch_bounds__(NTHR, 2) mega_fwd(Args args) {
    extern __shared__ __attribute__((aligned(16))) unsigned char lds[];
    LAS unsigned char* L = (LAS unsigned char*)lds;
    volatile LAS unsigned* MISC = (volatile LAS unsigned*)(L + MISC_OFF);
    for (int u = threadIdx.x; u < (LDS_BYTES - LDSCTL_OFF) / 4; u += NTHR) ((LAS unsigned*)(L + LDSCTL_OFF))[u] = 0u;
    __syncthreads();
    const int wave_s = __builtin_amdgcn_readfirstlane(threadIdx.x >> 6);
    XcdBarrier bar = xcd_barrier_post((unsigned*)((gu32*)(args.ws + WS_CTL) + CW_BAR), MISC + 8);

#pragma unroll 1
    for (int sidx = 0; sidx < NSTEP * 2; ++sidx) {
        const int pos = sidx >> 1, step = pos == 0 ? 0 : pos == 1 ? 21 : pos == 2 ? 1 : pos == 3 ? 24 : pos <= 7 ? pos - 2 : pos == 8 ? 22 : pos <= 11 ? pos - 3 : pos == 12 ? 20 : pos <= 20 ? pos - 4 : pos == 21 ? 23 : pos - 5;
        if (sidx & 1) { const int kind = (step == 0 || step == 21) ? 0 : (step == 1 || step == 3 || step == 5 || step == 9 || step == 16 || step == 22 || step == 23 || step == 24) ? 1 : (step == 7 || step == 14 || step == 18 || step == 20) ? 2 : step == 2 ? 3 : (step == 6 || step == 17) ? 4
                : (step == 4 || step == 8 || step == 15 || step == 19) ? 5 : step == 10 ? 6 : step == 11 ? 7 : step == 12 ? 8 : 9;
            if (!((REP_MASK >> kind) & 1)) continue;
#ifdef REP_STEP
            if (step != REP_STEP) continue;
#endif
        }
        if (PHM(0) && step == 0) {
            PH_ENV
            constexpr int I_MI = 32 * 96, I_MO = 32 * 32, I_AI = 32 * 84, I_AO = 32 * 32, I_F1 = 32 * 176, I_F2 = 88 * 32;
            constexpr int NITEMS = I_MI + I_MO + I_AI + I_AO + 2 * I_F1 + 2 * I_F2;
            for (int it = gw; it < NITEMS; it += NGW) {
                int r = it;
                if (r < I_MI) { absmax_item((gcf)ap->in[7], NBCV, r, lane, (GAS unsigned*)(ws + WS_CTL + 131072) + 2 * NGU, 0); continue; } r -= I_MI;
                if (r < I_MO) { transpose_item((gcf)ap->in[9], DM, DM, DM, WMO, r, lane); continue; } r -= I_MO;
                if (r < I_AI) { const int kb = r / 84, nb = r - kb * 84, k0 = 64 * kb; gcf Wa = (gcf)ap->in[10];
                    if (nb < 64) { const int n_src = (nb < 32 ? 64 * nb : 3072 + 64 * (nb - 32)) + lane; tr_col_fp8(Wa, NATT, k0, n_src, (GAS v4u*)((GAS unsigned char*)WAI + (size_t)(64 * nb + lane) * DM + k0)); }
                    else { const int nbb = nb - 64; const int n_src = (nbb < 16 ? 2048 + 64 * nbb : nbb < 18 ? 5120 + 64 * (nbb - 16) : 5248) + lane; const bool ok = nbb < 18 || (nbb == 18 && lane < 16);
                        tr_col_bf16(Wa, NATT, k0, n_src, ok, (GAS v4u*)((gb)((GAS unsigned char*)WAI + 8 * MiB) + (size_t)(64 * nbb + lane) * DM + k0)); }
                    continue; } r -= I_AI;
                if (r < I_AO) { transpose_item8((gcf)ap->in[13], DM, DM, (GAS unsigned char*)WAO, r, lane); continue; } r -= I_AO;
                if (r < 2 * I_F1) { const int l = r / I_F1; absmax_item((gcf)ap->in[14] + (size_t)l * DM * NGU, NGU, r - l * I_F1, lane, (GAS unsigned*)(ws + WS_CTL + 131072) + l * NGU, 1); continue; } r -= 2 * I_F1;
                { const int l = r / I_F2; transpose_item8((gcf)ap->in[17] + (size_t)l * DFF * DM, DFF, DM, (GAS unsigned char*)WF2 + (size_t)l * DM * DFF, r - l * I_F2, lane); }
            }
            xrows_phase(xp, xs, XB, (GAS unsigned char*)(ws + WS_XF + 20 * MiB), (gf)(ws + WS_XF + 40 * MiB), (gb)(ws + WS_XF + 41 * MiB), gw, NGW, lane);
            for (int e = gt; e < 188 * DM / 8; e += GT) *(GAS v4u*)((gb)(ws + WS_XF + 41 * MiB) + (size_t)68 * DM + (size_t)e * 8) = (v4u){0u, 0u, 0u, 0u};
        } else if (PHM(0) && step == 21) {
            PH_ENV
            constexpr int I_F1 = 32 * 176, I_MI = 32 * 96;
            for (int it = gw; it < I_MI; it += NGW) quant_item((gcf)ap->in[7], DM, NBCV, (GAS unsigned char*)WMI, (gb)(ws + WS_WF2 + 22 * MiB), (gcf)(ws + WS_CTL + 131072) + 2 * NGU, it, lane, 0);
            for (int it = gw; it < 2 * I_F1; it += NGW) { const int l = it / I_F1;
                quant_item((gcf)ap->in[14] + (size_t)l * DM * NGU, DM, NGU, (GAS unsigned char*)WF1 + (size_t)l * 44 * MiB, (gb)((GAS unsigned char*)WF1 + (size_t)l * 44 * MiB + 22 * MiB), (gcf)(ws + WS_CTL + 131072) + l * NGU, it - l * I_F1, lane, 1); }
        } else if (PHM(1) && step == 1) {
            PH_ENV
            pg8::Gemm g{(gcb)(ws + WS_XF + 20 * MiB), (gcb)WMI, MROWS, NBCV, DM / 2, 127, 127, 1}; pg8::DualOrder S; S.init(MROWS, NBCV, DM / 2, G, bx, 0);
            pg8::EpiBf16P E{BIG, NBCV, 0, (gcf)(ws + WS_XF + 40 * MiB), (gcf)(ws + WS_CTL + 131072) + 2 * NGU};
            pg8::gemm_phase<pg8::EpiBf16P, pg8::DualOrder, true, true, false, true>(L, g, S, E, tid);
        } else if (PHM(1) && (step == 5 || step == 16)) {
            PH_ENV
            const int fl = step == 16 ? 1 : 0;
            pg8::Gemm g{(gcb)(ws + WS_XF + 20 * MiB), (gcb)((const GAS unsigned char*)WF1 + (size_t)fl * 44 * MiB), MROWS, NGU, DM / 2, 127, 127, 1}; pg8::DualOrder S; S.init(MROWS, NGU, DM / 2, G, bx, 0);
#ifdef REP_KFIX
            if (step == REP_STEP && !(sidx & 1)) g.kfix = 1;
#endif

            gf FIX = (gf)((GAS unsigned char*)BIG + 64 * MiB);
            pg8::EpiConvGlu E{(GAS unsigned char*)HB, (gcf)ap->in[15] + (size_t)fl * 3 * DFF, (gcf)ap->in[16] + (size_t)fl * DFF, FIX, FIX + (size_t)320 * DFF, FIX + (size_t)640 * DFF, DFF, (gcf)(ws + WS_XF + 40 * MiB), (gcf)(ws + WS_CTL + 131072) + fl * NGU};
            pg8::gemm_phase<pg8::EpiConvGlu, pg8::DualOrder, true, true, false, true>(L, g, S, E, tid);
        } else if (PHM(1) && (step == 3 || step == 9 || step == 22 || step == 23 || step == 24)) {
            PH_ENV
            gcb A = XB; gcb Bt; int N, M = MROWS, tail = 0, c = bx, mode = 0; gb O = BIG; size_t kslab = 0;
            if (step == 3) { A = HB; Bt = WMO; N = DM; tail = 1; mode = 1; }
            else if (step == 9) { Bt = (gcb)((const GAS unsigned char*)WAI + 8 * MiB); N = 1280; c = G - 1 - bx; O = (gb)((GAS unsigned char*)BIG + 96 * MiB); }
            else if (step == 24) { A = (gcb)(ws + WS_XF + 41 * MiB); Bt = (gcb)(ws + WS_WF2 + 22 * MiB); N = 4096; M = 256; tail = 2; c = G - 1 - bx; O = (gb)(ws + WS_XF + 42 * MiB); kslab = (size_t)256 * 4096; }
            else { const int fl = step == 23 ? 1 : 0;
                A = (gcb)(ws + WS_XF + 41 * MiB); Bt = (gcb)((const GAS unsigned char*)WF1 + (size_t)fl * 44 * MiB + 22 * MiB); N = DFF; M = 256; tail = 2; c = G - 1 - bx; O = (gb)(ws + WS_XF + 42 * MiB); kslab = (size_t)256 * DFF; }
            pg8::Gemm g{A, Bt, M, N, DM, 127, 127, 0}; pg8::DualOrder S; S.init(M, N, DM, G, c, tail);
            pg8::EpiDual E{mode, O, N, Y, XB, NPROW, DM, DN_ALPHA, (gf)BIG, nullptr, nullptr, nullptr, nullptr, nullptr, nullptr, 0, nullptr, nullptr, kslab};
            pg8::gemm_phase<pg8::EpiDual, pg8::DualOrder, true, true, false, false>(L, g, S, E, tid);
            if (step == 9 && (bx < 56 || bx >= 128) && G == 256) {
                const int gt2 = (bx < 56 ? bx : bx - 72) * NTHR + tid, GT2 = 184 * NTHR;
                cvt_rows((gcf)ap->in[5], IKS, PAST * IDXD / 8, (size_t)LSK * IDXD, 32 * PAST * IDXD / 8, gt2, GT2);
                cvt_rows_k8((gcf)ap->in[3], (GAS unsigned char*)KS, PAST * KVW / 8, (size_t)LSK * KVW, 32 * PAST * KVW / 8, gt2, GT2);
                cvt_rows_v8((gcf)ap->in[4], (GAS unsigned char*)VS, PAST * KVW / 8, (size_t)LSK * KVW, 32 * PAST * KVW / 8, gt2, GT2); }
        } else if (PHM(2) && (step == 7 || step == 14 || step == 18 || step == 20)) {
            PH_ENV
            gcb A = HB; gcb Bt; int K8 = DM, sa = 123;
            if (step == 7) { Bt = WF2; K8 = DFF; } else if (step == 14) { A = IQ; Bt = WAO; sa = 121; } else { Bt = (gcb)((const GAS unsigned char*)WF2 + (size_t)DM * DFF); K8 = DFF; }
            int N = DM, mode = 1;
            if (step == 20) { A = (gcb)(ws + WS_XF); Bt = WAI; N = 4096; mode = 0; K8 = DM; sa = 123; }
            pg8::Gemm g{A, Bt, MROWS, N, K8 / 2, 119, sa, 0}; pg8::DualOrder S; S.init(MROWS, N, K8 / 2, G, bx, mode);
#ifdef REP_KFIX
            if (step == REP_STEP && !(sidx & 1)) g.kfix = 1;
#endif

            pg8::EpiDual E{mode, BIG, N, Y, XB, NPROW, DM, DN_ALPHA, (gf)BIG, nullptr, nullptr, nullptr, nullptr, nullptr, nullptr, 0, nullptr, nullptr, 0};
#ifdef REP_PV
            if (step == REP_STEP && !(sidx & 1)) pg8::gemm_phase<pg8::EpiDual, pg8::DualOrder, true, true, true, false, REP_PV>(L, g, S, E, tid); else
#endif
            pg8::gemm_phase<pg8::EpiDual, pg8::DualOrder, true, true, true>(L, g, S, E, tid);
        } else if (PHM(3) && step == 2) {
            PH_ENV
            conv_mix_phase(BIG, HB, (gcf)ap->in[8], (gcf)ap->in[2], out, (gcb)(ws + WS_XF + 42 * MiB), gt, GT);
        } else if (PHM(4) && (step == 6 || step == 17)) {
            PH_ENV
            const int l = step == 6 ? 0 : 1;
            gcf FIX = (gcf)((GAS unsigned char*)BIG + 64 * MiB);
            glu_fixup_phase(FIX, FIX + (size_t)320 * DFF, FIX + (size_t)640 * DFF, (GAS unsigned char*)HB, (gcf)ap->in[15] + (size_t)l * 3 * DFF, (gcf)ap->in[16] + (size_t)l * DFF, (gcf)ap->in[6] + (size_t)l * 32 * 2 * DFF, out, (gcb)(ws + WS_XF + 42 * MiB), l, gt, GT);
        } else if (PHM(5) && (step == 4 || step == 8 || step == 15 || step == 19)) {
            PH_ENV
            gcf g_; gcf b_; gf xo = nullptr; gb xb = XB;
            if (step == 4) { g_ = (gcf)ap->in[18]; b_ = (gcf)ap->in[19]; } else if (step == 8) { g_ = (gcf)ap->in[20]; b_ = (gcf)ap->in[21]; } else if (step == 15) { g_ = (gcf)ap->in[18] + DM; b_ = (gcf)ap->in[19] + DM; }
            else { g_ = (gcf)ap->in[20] + DM; b_ = (gcf)ap->in[21] + DM; xo = out; xb = nullptr; }
            const bool ffn_next = step == 4 || step == 15;
            ln_phase(Y, (gcf)BIG, g_, b_, xo, xb, step == 8 ? (GAS unsigned char*)(ws + WS_XF) : (GAS unsigned char*)nullptr, ffn_next ? (GAS unsigned char*)(ws + WS_XF + 20 * MiB) : (GAS unsigned char*)nullptr, (gf)(ws + WS_XF + 40 * MiB), (gb)(ws + WS_XF + 41 * MiB), gw, NGW, lane);
        } else if (PHM(6) && step == 10) {
            PH_ENV
            postproj_phase(BIG, (gcb)((GAS unsigned char*)BIG + 96 * MiB), ap->inv_freq, (gcf)ap->in[11], (gcf)ap->in[12], out, QR, IQ, KP, VP, IKP, KS, VS, IKS, IW, gw, NGW, lane);
            if (G != 256) {
                cvt_rows((gcf)ap->in[5], IKS, PAST * IDXD / 8, (size_t)LSK * IDXD, 32 * PAST * IDXD / 8, gt, GT);
                cvt_rows_k8((gcf)ap->in[3], (GAS unsigned char*)KS, PAST * KVW / 8, (size_t)LSK * KVW, 32 * PAST * KVW / 8, gt, GT);
                cvt_rows_v8((gcf)ap->in[4], (GAS unsigned char*)VS, PAST * KVW / 8, (size_t)LSK * KVW, 32 * PAST * KVW / 8, gt, GT); }
        } else if (PHM(7) && step == 11) {
            PH_ENV
            indexer_phase(L, IQ, IW, IKP, IKS, SCP, SCS, vcu, G, tid, lane, wave);
        } else if (PHM(8) && step == 12) {
            PH_ENV
            topk_phase(L, SCP, SCS, SEL, gw, NGW, lane, wave);
        } else if (PHM(9) && step == 13) {
            PH_ENV
            attn_phase(L, QR, IQ, SEL, KP, VP, KS, VS, vcu, G, lane, wave);
        }
        if ((sidx + 1 < NSTEP * 2 - 1 || REP_MASK) && step != 20 && step != 1 && step != 5 && step != 16) {   int tb; asm volatile("v_mbcnt_lo_u32_b32 %0, -1, 0\n\tv_mbcnt_hi_u32_b32 %0, -1, %0" : "=v"(tb)); xcd_barrier(bar, tb + wave_s * 64); }
    }
}

extern "C" void kernel_launch(void* const* d_in, const int* in_sizes, int n_in, void* d_out, int out_size, void* d_ws, size_t ws_size, hipStream_t stream) {
    static int grid = 0;
    if (grid == 0) {
        if (n_in != 22 || out_size != (int)O_END || ws_size < WS_END) { fprintf(stderr, "kernel_launch: built for 22 inputs, %zu outputs, >= %zu bytes of workspace; got n_in %d, out %d, ws %zu; nothing launched\n", (size_t)O_END, (size_t)WS_END, n_in, out_size, ws_size); grid = -1; return; }
        int dev = 0, cus = 0;
        if (hipGetDevice(&dev) != hipSuccess || hipDeviceGetAttribute(&cus, hipDeviceAttributeMultiprocessorCount, dev) != hipSuccess) { fprintf(stderr, "kernel_launch: device query failed\n"); grid = -1; return; }
        if (hipFuncSetAttribute((const void*)mega_fwd, hipFuncAttributeMaxDynamicSharedMemorySize, LDS_BYTES) != hipSuccess) { fprintf(stderr, "kernel_launch: hipFuncSetAttribute failed\n"); grid = -1; return; }
        (void)hipGetLastError();
        grid = cus;
    }
    if (grid < 0) return;
    if (hipMemsetAsync((char*)d_ws + WS_CTL, 0, CTL_ZERO_BYTES, stream) != hipSuccess) { fprintf(stderr, "kernel_launch: hipMemsetAsync failed\n"); return; }
    Args a{};
    for (int i = 0; i < 22; ++i) a.in[i] = (const float*)d_in[i];
    a.out = (float*)d_out; a.ws = (unsigned char*)d_ws;
    for (int d = 0; d < 64; ++d) a.inv_freq[d] = (float)pow(10000.0, -(double)d / 64.0);
    hipLaunchKernelGGL(mega_fwd, dim3(grid), dim3(NTHR), LDS_BYTES, stream, a);
    const hipError_t le = hipPeekAtLastError();
    if (le != hipSuccess) fprintf(stderr, "kernel_launch: launch failed: %s\n", hipGetErrorName(le));
}
```

```cpp
#include <hip/hip_runtime.h>
#include <cstdio>
#include <cstdint>
#include <cmath>
namespace pg8 {
#define PG8_LAS __attribute__((address_space(3)))
typedef unsigned short bf16_t;
typedef short bf16x8 __attribute__((ext_vector_type(8)));
typedef float f32x4 __attribute__((ext_vector_type(4)));
typedef unsigned u32x4 __attribute__((ext_vector_type(4)));
constexpr int BM = 256, BK = 64, HALF = 128, HTB = HALF * BK * 2  , STAGE_BYTES = 8 * HTB, NXCD = 8, WGM = 8;

__host__ __device__ __forceinline__ int lds_byte(int r, int c) { const int st = (r >> 4) * 2 + (c >> 5), rr = r & 15, cc = c & 31, ob = rr * 64 + cc * 2; return st * 1024 + (ob ^ (((ob >> 9) & 1) << 5)); }
__host__ __device__ __forceinline__ void stage_rc(int b, int& R, int& C) { const int st = b / 1024, sb = b % 1024, swz = sb ^ (((sb >> 9) & 1) << 5); R = (st >> 1) * 16 + swz / 64; C = (st & 1) * 32 + (swz % 64) / 2; }
__host__ __device__ __forceinline__ int perm32(int rho) { const int n = rho >> 4, i = rho & 15; return 8 * (i >> 2) + 4 * n + (i & 3); }

struct Unit { int pm, pn, k0, ntk, kq; };
struct Gemm { const __attribute__((address_space(1))) bf16_t* A; const __attribute__((address_space(1))) bf16_t* Bt; int M, N, K; int sw, sa; int i8; int kfix; };

struct StaticOrder {
    int nM, nN, nwg, G, c;
    __host__ __device__ void init(int M, int N, int G_, int c_) { nM = M / BM; nN = N / BM; nwg = nM * nN; G = G_; c = c_; }
    __host__ __device__ bool next(int i, Unit& u) const {
        const long L = (long)i * G + c; if (L >= nwg) return false;
        int wgid = (int)L; { const int q = nwg / NXCD, r = nwg % NXCD, xcd = wgid % NXCD, off = wgid / NXCD; wgid = (xcd < r ? xcd * (q + 1) : r * (q + 1) + (xcd - r) * q) + off; }
        const int nig = WGM * nN, gid = wgid / nig, fm = gid * WGM, gsz = (nM - fm) < WGM ? (nM - fm) : WGM;
        u.pm = fm + ((wgid % nig) % gsz); u.pn = (wgid % nig) / gsz; u.k0 = 0; u.ntk = 0; u.kq = 0; return true;
    }
    __device__ __forceinline__ void a_ready(const Unit&) const {}
    __device__ __forceinline__ void done(const Unit&) const {}
};

struct DualOrder {
    int nM, nN, nwg, tail, G, c, qhi, qlo;
    __device__ __forceinline__ void init(int M, int N, int K, int G_, int c_, int tail_) { tail = tail_; G = G_; c = c_; { const int nt = K / BK; qhi = 2 * ((nt + 7) / 8); qlo = (nt - 2 * qhi) / 2; } nM = (tail_ == 1 ? 8192 : M) / BM; nN = N / BM; nwg = tail_ == 2 ? 0 : nM * nN; }
    __device__ __forceinline__ bool next(int i, Unit& u) const {
        const long L = (long)i * G + c; int pm = 0, pn = 0, k0 = 0, ntk = 0, kq = 0; bool ok = true;
        if (L < nwg) {
            int wgid = (int)L; { const int q = nwg / NXCD, r = nwg % NXCD, xcd = wgid % NXCD, off = wgid / NXCD; wgid = (xcd < r ? xcd * (q + 1) : r * (q + 1) + (xcd - r) * q) + off; }
            const int nig = WGM * nN, gid = wgid / nig, fm = gid * WGM, gsz = (nM - fm) < WGM ? (nM - fm) : WGM;
            pm = fm + ((wgid % nig) % gsz); pn = (wgid % nig) / gsz;
        } else if (tail == 2) {
            if (L < 2 * nN) { pn = (int)(L % nN); kq = (int)(L / nN); ntk = 16; k0 = kq * 16; } else ok = false;
        } else if (tail == 1 && L < nwg + 256) {
            const int t = (int)(L - nwg), x = t & 7, j = t >> 3; pm = 32 + (j & 7); pn = x; kq = j >> 3; ntk = kq < 2 ? qhi : qlo; k0 = kq < 2 ? kq * qhi : 2 * qhi + (kq - 2) * qlo;
        } else ok = false;
        u.pm = pm; u.pn = pn; u.k0 = k0; u.ntk = ntk; u.kq = kq; return ok;
    }
    __device__ __forceinline__ void a_ready(const Unit&) const {}
    __device__ __forceinline__ void done(const Unit&) const {}
};
}
namespace pg8 {
#define PG8_GAS __attribute__((address_space(1)))
__device__ __forceinline__ unsigned cvt_pk_bf16(float lo, float hi) { unsigned r; asm volatile("v_cvt_pk_bf16_f32 %0, %1, %2" : "=v"(r) : "v"(lo), "v"(hi)); return r; }
struct EpiBf16P {
    static constexpr bool AFTER_DRAIN = false; __device__ __forceinline__ bool perm() const { return true; }
    PG8_GAS bf16_t* O; int ldc; size_t kslab;
    const PG8_GAS float* SA; const PG8_GAS float* SWM;
    __device__ __forceinline__ void operator()(const f32x4 (&acc)[2][2][4][2], const Unit& u, int wr, int wc, int fr, int fq) const {
        const int row0 = u.pm * BM + wr * 64 + fr, col0 = u.pn * BM + wc * 32 + 8 * fq;
        f32x4 sw[2][2];
#pragma unroll
        for (int bj = 0; bj < 2; ++bj)
#pragma unroll
            for (int n = 0; n < 2; ++n) sw[bj][n] = SA ? *(const PG8_GAS f32x4*)(SWM + col0 + bj * HALF + 4 * n) * (1.f / 127.f) : (f32x4){0.f, 0.f, 0.f, 0.f};
#pragma unroll
        for (int ai = 0; ai < 2; ++ai)
#pragma unroll
            for (int m = 0; m < 4; ++m) { PG8_GAS bf16_t* rowp = O + (size_t)u.kq * kslab + (size_t)(row0 + ai * HALF + m * 16) * ldc + col0;
                const float sar = SA ? SA[row0 + ai * HALF + m * 16] : 0.f;
#pragma unroll
                for (int bj = 0; bj < 2; ++bj) { f32x4 v0 = acc[ai][bj][m][0], v1 = acc[ai][bj][m][1];
                    if (SA) {
#pragma unroll
                        for (int i = 0; i < 4; ++i) { v0[i] = (float)__float_as_int(v0[i]) * (sw[bj][0][i] * sar); v1[i] = (float)__float_as_int(v1[i]) * (sw[bj][1][i] * sar); } }
                    u32x4 w; w.x = cvt_pk_bf16(v0[0], v0[1]); w.y = cvt_pk_bf16(v0[2], v0[3]); w.z = cvt_pk_bf16(v1[0], v1[1]); w.w = cvt_pk_bf16(v1[2], v1[3]);
                    *(PG8_GAS u32x4*)(rowp + bj * HALF) = w; } }
    }
};
struct EpiF32R {
    static constexpr bool AFTER_DRAIN = false; __device__ __forceinline__ bool perm() const { return true; }
    PG8_GAS bf16_t* Y; const PG8_GAS bf16_t* X; int split; int ldc; float alpha; PG8_GAS float* P;
    __device__ __forceinline__ void operator()(const f32x4 (&acc)[2][2][4][2], const Unit& u, int wr, int wc, int fr, int fq) const {
        const int row0 = u.pm * BM + wr * 64 + fr, col0 = u.pn * BM + wc * 32 + 8 * fq;
        if (u.kq > 0) {
#pragma unroll
            for (int ai = 0; ai < 2; ++ai)
#pragma unroll
                for (int m = 0; m < 4; ++m) { PG8_GAS float* pr = P + ((size_t)(u.kq - 1) * 2048 + (size_t)(row0 + ai * HALF + m * 16 - split)) * ldc + col0;
#pragma unroll
                    for (int bj = 0; bj < 2; ++bj)
#pragma unroll
                        for (int n = 0; n < 2; ++n) *(PG8_GAS f32x4*)(pr + bj * HALF + n * 4) = acc[ai][bj][m][n]; }
            return;
        }
#pragma unroll
        for (int ai = 0; ai < 2; ++ai) {
            u32x4 xv[4][2];
#pragma unroll
            for (int m = 0; m < 4; ++m)
#pragma unroll
                for (int bj = 0; bj < 2; ++bj) xv[m][bj] = *(const PG8_GAS u32x4*)(X + (size_t)(row0 + ai * HALF + m * 16) * ldc + col0 + bj * HALF);
#pragma unroll
            for (int m = 0; m < 4; ++m)
#pragma unroll
                for (int bj = 0; bj < 2; ++bj) { const u32x4 w = xv[m][bj]; const f32x4 a0 = acc[ai][bj][m][0], a1 = acc[ai][bj][m][1];
                    u32x4 o; o.x = cvt_pk_bf16(__uint_as_float(w.x << 16) * alpha + a0[0], __uint_as_float(w.x & 0xffff0000u) * alpha + a0[1]); o.y = cvt_pk_bf16(__uint_as_float(w.y << 16) * alpha + a0[2], __uint_as_float(w.y & 0xffff0000u) * alpha + a0[3]);
                    o.z = cvt_pk_bf16(__uint_as_float(w.z << 16) * alpha + a1[0], __uint_as_float(w.z & 0xffff0000u) * alpha + a1[1]); o.w = cvt_pk_bf16(__uint_as_float(w.w << 16) * alpha + a1[2], __uint_as_float(w.w & 0xffff0000u) * alpha + a1[3]);
                    *(PG8_GAS u32x4*)(Y + (size_t)(row0 + ai * HALF + m * 16) * ldc + col0 + bj * HALF) = o; }
            asm volatile("" ::: "memory");
        }
    }
};

struct EpiConvGlu {
    static constexpr bool AFTER_DRAIN = false; __device__ __forceinline__ bool perm() const { return true; }
    PG8_GAS unsigned char* H; const PG8_GAS float* cw; const PG8_GAS float* cb; PG8_GAS float* FIXG; PG8_GAS float* FIXU; PG8_GAS float* HALO; int ldh;
    const PG8_GAS float* SA; const PG8_GAS float* SWM;
    __device__ __forceinline__ void operator()(const f32x4 (&acc)[2][2][4][2], const Unit& u, int wr, int wc, int fr, int fq) const {
        typedef unsigned u32x2 __attribute__((ext_vector_type(2)));
        const int ch0 = u.pn * 128 + wc * 32 + 8 * fq;
        float w0[8], w1[8], w2[8], bb[8];
#pragma unroll
        for (int h4 = 0; h4 < 2; ++h4) { const f32x4 a = *(const PG8_GAS f32x4*)(cw + ch0 + 4 * h4), b = *(const PG8_GAS f32x4*)(cw + ldh + ch0 + 4 * h4), c = *(const PG8_GAS f32x4*)(cw + 2 * ldh + ch0 + 4 * h4), d = *(const PG8_GAS f32x4*)(cb + ch0 + 4 * h4);
#pragma unroll
            for (int i = 0; i < 4; ++i) { w0[4 * h4 + i] = a[i]; w1[4 * h4 + i] = b[i]; w2[4 * h4 + i] = c[i]; bb[4 * h4 + i] = d[i]; } }
        float sg8[8], su8[8];
#pragma unroll
        for (int h4 = 0; h4 < 2; ++h4) { const f32x4 a = *(const PG8_GAS f32x4*)(SWM + u.pn * BM + wc * 32 + 8 * fq + 4 * h4), b = *(const PG8_GAS f32x4*)(SWM + u.pn * BM + HALF + wc * 32 + 8 * fq + 4 * h4);
#pragma unroll
            for (int i = 0; i < 4; ++i) { sg8[4 * h4 + i] = a[i] * (1.f / 127.f); su8[4 * h4 + i] = b[i] * (1.f / 127.f); } }
        const int src1 = ((fq << 4) | ((fr + 15) & 15)) << 2, src2 = ((fq << 4) | ((fr + 14) & 15)) << 2;
#pragma unroll
        for (int ai = 0; ai < 2; ++ai)
#pragma unroll
            for (int m = 0; m < 4; ++m) {
                const int row = u.pm * BM + ai * HALF + wr * 64 + m * 16 + fr; float hv[8], gvv[8], uvv[8];
                const float sar = SA[row], sam1 = m > 0 ? SA[row - 16] : 0.f;
#pragma unroll
                for (int e8 = 0; e8 < 8; ++e8) { const int n = e8 >> 2, i = e8 & 3;
                    const float gv = (float)__float_as_int(acc[ai][0][m][n][i]) * sar * sg8[e8], gp = m > 0 ? (float)__float_as_int(acc[ai][0][m > 0 ? m - 1 : 0][n][i]) * sam1 * sg8[e8] : 0.f, uv = (float)__float_as_int(acc[ai][1][m][n][i]) * sar * su8[e8];
                    const float g1 = __int_as_float(__builtin_amdgcn_update_dpp(0, __float_as_int(fr == 15 ? gp : gv), 0x121, 0xf, 0xf, false));
                    const float g2 = __int_as_float(__builtin_amdgcn_update_dpp(0, __float_as_int(fr >= 14 ? gp : gv), 0x122, 0xf, 0xf, false));
                    const float a = w0[e8] * g2 + w1[e8] * g1 + w2[e8] * gv + bb[e8];
                    const float sg = __builtin_amdgcn_rcpf(1.f + __builtin_amdgcn_exp2f(-a * 1.4426950408889634f));
                    hv[e8] = fminf(fmaxf(a * sg * uv * 16.f, -448.f), 448.f); gvv[e8] = gv; uvv[e8] = uv; }
                if (m == 0 && fr < 2) { const size_t fo = (size_t)((row >> 6) * 2 + fr) * ldh + ch0;
                    *(PG8_GAS f32x4*)(FIXG + fo) = (f32x4){gvv[0], gvv[1], gvv[2], gvv[3]}; *(PG8_GAS f32x4*)(FIXG + fo + 4) = (f32x4){gvv[4], gvv[5], gvv[6], gvv[7]};
                    *(PG8_GAS f32x4*)(FIXU + fo) = (f32x4){uvv[0], uvv[1], uvv[2], uvv[3]}; *(PG8_GAS f32x4*)(FIXU + fo + 4) = (f32x4){uvv[4], uvv[5], uvv[6], uvv[7]}; }
                else { int p0 = __builtin_amdgcn_cvt_pk_fp8_f32(hv[0], hv[1], 0, false); p0 = __builtin_amdgcn_cvt_pk_fp8_f32(hv[2], hv[3], p0, true);
                    int p1 = __builtin_amdgcn_cvt_pk_fp8_f32(hv[4], hv[5], 0, false); p1 = __builtin_amdgcn_cvt_pk_fp8_f32(hv[6], hv[7], p1, true);
                    *(PG8_GAS u32x2*)(H + (size_t)row * ldh + ch0) = (u32x2){(unsigned)p0, (unsigned)p1}; }
                if (m == 3 && fr >= 14) { const size_t ho = (size_t)((row >> 6) * 2 + fr - 14) * ldh + ch0;
                    *(PG8_GAS f32x4*)(HALO + ho) = (f32x4){gvv[0], gvv[1], gvv[2], gvv[3]}; *(PG8_GAS f32x4*)(HALO + ho + 4) = (f32x4){gvv[4], gvv[5], gvv[6], gvv[7]}; }
            }
    }
};

struct EpiDual {
    static constexpr bool AFTER_DRAIN = false;
    int mode; PG8_GAS bf16_t* O; int ldo; PG8_GAS bf16_t* Y; const PG8_GAS bf16_t* X; int split; int ldc; float alpha; PG8_GAS float* P;
    PG8_GAS unsigned char* H; const PG8_GAS float* cw; const PG8_GAS float* cb; PG8_GAS float* FIXG; PG8_GAS float* FIXU; PG8_GAS float* HALO; int ldh; const PG8_GAS float* SA; const PG8_GAS float* SWM;
    size_t kslab;
    __device__ __forceinline__ bool perm() const { return true; }
    __device__ __forceinline__ void operator()(const f32x4 (&acc)[2][2][4][2], const Unit& u, int wr, int wc, int fr, int fq) const {
        if (mode == 0) { EpiBf16P e{O, ldo, kslab, SA, SWM}; e(acc, u, wr, wc, fr, fq); } else if (mode == 1) { EpiF32R e{Y, X, split, ldc, alpha, P}; e(acc, u, wr, wc, fr, fq); }
        else { EpiConvGlu e{H, cw, cb, FIXG, FIXU, HALO, ldh, SA, SWM}; e(acc, u, wr, wc, fr, fq); }
    }
};
}
namespace pg8 {
template <class Epi, class Sched, bool ALIGN_EPI = false, bool SP2 = false, bool FP8 = false, bool I8 = false, int PV = 0>
__device__ __forceinline__ void gemm_phase(PG8_LAS unsigned char* lds, const Gemm g, const Sched& S, const Epi& E, const int tid) {
    const int wid = __builtin_amdgcn_readfirstlane(tid >> 6), lane = tid & 63, wr = wid >> 2, wc = wid & 3, fr = lane & 15, fq = lane >> 4;
    const int K = g.K, nt = K / BK;
    unsigned voffA[2], voffB[2];
#pragma unroll
    for (int i = 0; i < 2; ++i) { int R, C; stage_rc(tid * 16 + i * 8192, R, C); const int Rb = E.perm() ? ((R & ~31) + perm32(R & 31)) : R;
        voffA[i] = (unsigned)(R * K + C) * 2u; voffB[i] = (unsigned)(Rb * K + C) * 2u; }

#ifdef REP_KFIX
    const size_t kstep = g.kfix ? (size_t)0 : (size_t)(BK * 2);
#else
    const size_t kstep = (size_t)(BK * 2);
#endif
    const size_t hstep = (size_t)HALF * K * 2;
    const size_t tstep = 2 * hstep;
    const unsigned ldsw = (unsigned)wid * 1024u;
    const int aoff = lds_byte(wr * 64 + fr, fq * 8), boff = lds_byte(wc * 32 + fr, fq * 8);
#define PG8_SA(b, h) (((b) * 2 + (h)) * HTB)
#define PG8_SB(b, h) ((4 + (b) * 2 + (h)) * HTB)
#define PG8_STAGE(bufoff, gbase, voff) do { if constexpr (PV != 2) _Pragma("unroll") for (int _i = 0; _i < 2; ++_i) \
        __builtin_amdgcn_global_load_lds((const unsigned*)((const char*)(gbase) + (voff)[_i]), (PG8_LAS unsigned*)(lds + (bufoff) + ldsw + _i * 8192), 16, 0, 0); } while (0)
#define PG8_LDA(dst, b, h) do { _Pragma("unroll") for (int m = 0; m < 4; ++m) { if constexpr (FP8) { const bf16x8 lo_ = *(const PG8_LAS bf16x8*)(lds + PG8_SA(b, h) + aoff + m * 2048), hi_ = *(const PG8_LAS bf16x8*)(lds + PG8_SA(b, h) + aoff + m * 2048 + 1024); \
        dst##8[m] = __builtin_shufflevector(lo_, hi_, 0, 1, 2, 3, 4, 5, 6, 7, 8, 9, 10, 11, 12, 13, 14, 15); } else { _Pragma("unroll") for (int k = 0; k < 2; ++k) dst[m][k] = *(const PG8_LAS bf16x8*)(lds + PG8_SA(b, h) + aoff + m * 2048 + k * 1024); } } } while (0)
#define PG8_LDB(dst, b, h) do { _Pragma("unroll") for (int n = 0; n < 2; ++n) { if constexpr (FP8) { const bf16x8 lo_ = *(const PG8_LAS bf16x8*)(lds + PG8_SB(b, h) + boff + n * 2048), hi_ = *(const PG8_LAS bf16x8*)(lds + PG8_SB(b, h) + boff + n * 2048 + 1024); \
        dst##8[n] = __builtin_shufflevector(lo_, hi_, 0, 1, 2, 3, 4, 5, 6, 7, 8, 9, 10, 11, 12, 13, 14, 15); } else { _Pragma("unroll") for (int k = 0; k < 2; ++k) dst[n][k] = *(const PG8_LAS bf16x8*)(lds + PG8_SB(b, h) + boff + n * 2048 + k * 1024); } } } while (0)
#define PG8_MMA(ai, bj, At, Bt) do { __builtin_amdgcn_s_setprio(1); _Pragma("unroll") for (int m = 0; m < 4; ++m) _Pragma("unroll") for (int n = 0; n < 2; ++n) { \
        if constexpr (PV == 1) { if constexpr (FP8) asm volatile("" :: "v"(Bt##8[n]), "v"(At##8[m])); else asm volatile("" :: "v"(Bt[n][0]), "v"(At[m][0]), "v"(Bt[n][1]), "v"(At[m][1])); } else \
        if constexpr (FP8) asm volatile("v_mfma_scale_f32_16x16x128_f8f6f4 %0, %1, %2, %0, %3, %4 op_sel_hi:[0,0,0]" : "+v"(acc[ai][bj][m][n]) : "v"(__builtin_bit_cast(pg8_i32x8, Bt##8[n])), "v"(__builtin_bit_cast(pg8_i32x8, At##8[m])), "v"(swv), "v"(sav)); \
        else if constexpr (I8) { _Pragma("unroll") for (int k = 0; k < 2; ++k) asm volatile("v_mfma_i32_16x16x64_i8 %0, %1, %2, %0" : "+v"(acc[ai][bj][m][n]) : "v"(Bt[n][k]), "v"(At[m][k])); }     \
        else { _Pragma("unroll") for (int k = 0; k < 2; ++k) acc[ai][bj][m][n] = __builtin_amdgcn_mfma_f32_16x16x32_bf16(Bt[n][k], At[m][k], acc[ai][bj][m][n], 0, 0, 0); } } \
        __builtin_amdgcn_s_setprio(0); } while (0)
#define PG8_WAIT_V(n) asm volatile("s_waitcnt vmcnt(" #n ")" ::: "memory")
#define PG8_WAIT_L(n) asm volatile("s_waitcnt lgkmcnt(" #n ")" ::: "memory")
#define PG8_BAR __builtin_amdgcn_s_barrier()
#define PG8_SCHED __builtin_amdgcn_sched_barrier(0)
    Unit cur, nxt; int ui = 0;
    if (!S.next(0, cur)) return;
    int swv = g.sw, sav = g.sa; asm volatile("" : "+v"(swv), "+v"(sav));
    f32x4 acc[2][2][4][2];
#pragma unroll
    for (int a = 0; a < 2; ++a)
#pragma unroll
        for (int b = 0; b < 2; ++b)
#pragma unroll
            for (int m = 0; m < 4; ++m)
#pragma unroll
                for (int n = 0; n < 2; ++n) acc[a][b][m][n] = (f32x4){0.f, 0.f, 0.f, 0.f};
    typedef short pg8_s16x16 __attribute__((ext_vector_type(16))); typedef int pg8_i32x8 __attribute__((ext_vector_type(8)));
    bf16x8 At[4][2], B0[2][2], B1[2][2];
    pg8_s16x16 At8[4], B08[2], B18[2];
    const char* cA = (const char*)g.A + (size_t)cur.pm * tstep + (size_t)cur.k0 * kstep; const char* cB = (const char*)g.Bt + (size_t)cur.pn * tstep + (size_t)cur.k0 * kstep;
    int cnt = cur.ntk ? cur.ntk : nt;
    S.a_ready(cur);
    if constexpr (SP2) {
        PG8_STAGE(PG8_SB(0, 0), cB, voffB); PG8_STAGE(PG8_SB(0, 1), cB + hstep, voffB); PG8_STAGE(PG8_SA(0, 0), cA, voffA); PG8_STAGE(PG8_SA(0, 1), cA + hstep, voffA);
        if (wr == 1) PG8_BAR;
        PG8_WAIT_V(2); PG8_BAR;
        PG8_STAGE(PG8_SB(1, 0), cB + kstep, voffB); PG8_STAGE(PG8_SA(1, 0), cA + kstep, voffA); PG8_STAGE(PG8_SB(1, 1), cB + hstep + kstep, voffB);
        PG8_WAIT_V(6); PG8_BAR;
    } else {
        PG8_STAGE(PG8_SB(0, 0), cB, voffB); PG8_STAGE(PG8_SA(0, 0), cA, voffA); PG8_STAGE(PG8_SB(0, 1), cB + hstep, voffB); PG8_STAGE(PG8_SA(0, 1), cA + hstep, voffA);
        if (wr == 1) PG8_BAR;
        PG8_WAIT_V(4); PG8_BAR;
        PG8_STAGE(PG8_SB(1, 0), cB + kstep, voffB); PG8_STAGE(PG8_SA(1, 0), cA + kstep, voffA); PG8_STAGE(PG8_SB(1, 1), cB + hstep + kstep, voffB);
        PG8_WAIT_V(6); PG8_BAR;
    }
    for (;;) {
        const bool has_next = S.next(ui + 1, nxt);
        const char* nA = has_next ? (const char*)g.A + (size_t)nxt.pm * tstep + (size_t)nxt.k0 * kstep : cA; const char* nB = has_next ? (const char*)g.Bt + (size_t)nxt.pn * tstep + (size_t)nxt.k0 * kstep : cB;
        for (int t = 0; t < cnt; t += 2) {
            const bool last = (t == cnt - 2);
            const char* a1 = cA + (size_t)(t + 1) * kstep;
            const char* a2 = last ? nA : cA + (size_t)(t + 2) * kstep; const char* b2 = last ? nB : cB + (size_t)(t + 2) * kstep;
            const char* a3 = a2 + kstep; const char* b3 = b2 + kstep;
            if (last && has_next) S.a_ready(nxt);
            if constexpr (SP2) {
            PG8_LDB(B0, 0, 0); PG8_LDB(B1, 0, 1); PG8_SCHED; PG8_LDA(At, 0, 0); PG8_STAGE(PG8_SA(1, 1), a1 + hstep, voffA);
            PG8_WAIT_V(8); PG8_WAIT_L(0); PG8_BAR; PG8_MMA(0, 0, At, B0); PG8_MMA(0, 1, At, B1); PG8_BAR; PG8_SCHED;
            PG8_LDA(At, 0, 1); PG8_STAGE(PG8_SB(0, 0), b2, voffB); PG8_STAGE(PG8_SB(0, 1), b2 + hstep, voffB); PG8_STAGE(PG8_SA(0, 0), a2, voffA);
            PG8_WAIT_V(8); PG8_WAIT_L(0); PG8_BAR; PG8_MMA(1, 0, At, B0); PG8_MMA(1, 1, At, B1); PG8_BAR; PG8_SCHED;
            PG8_LDB(B0, 1, 0); PG8_LDB(B1, 1, 1); PG8_SCHED; PG8_LDA(At, 1, 0); PG8_STAGE(PG8_SA(0, 1), a2 + hstep, voffA);
            PG8_WAIT_V(8); PG8_WAIT_L(0); PG8_BAR; PG8_MMA(0, 0, At, B0); PG8_MMA(0, 1, At, B1); PG8_BAR; PG8_SCHED;
            PG8_LDA(At, 1, 1); PG8_STAGE(PG8_SB(1, 0), b3, voffB); PG8_STAGE(PG8_SB(1, 1), b3 + hstep, voffB); PG8_STAGE(PG8_SA(1, 0), a3, voffA);
            PG8_WAIT_V(8); PG8_WAIT_L(0); PG8_BAR; PG8_MMA(1, 0, At, B0); PG8_MMA(1, 1, At, B1); PG8_BAR; PG8_SCHED;
            } else {
            PG8_LDB(B0, 0, 0); PG8_SCHED; PG8_LDA(At, 0, 0); PG8_STAGE(PG8_SA(1, 1), a1 + hstep, voffA);
            PG8_WAIT_L(8); PG8_BAR; PG8_WAIT_L(0); PG8_MMA(0, 0, At, B0); PG8_BAR; PG8_SCHED;
            PG8_LDB(B1, 0, 1); PG8_STAGE(PG8_SB(0, 0), b2, voffB);
            PG8_BAR; PG8_WAIT_L(0); PG8_MMA(0, 1, At, B1); PG8_BAR;
            PG8_LDA(At, 0, 1); PG8_STAGE(PG8_SA(0, 0), a2, voffA);
            PG8_BAR; PG8_WAIT_L(0); PG8_MMA(1, 0, At, B0); PG8_BAR; PG8_SCHED;
            PG8_STAGE(PG8_SB(0, 1), b2 + hstep, voffB);
            PG8_WAIT_V(6); PG8_BAR; PG8_MMA(1, 1, At, B1); PG8_BAR;
            PG8_LDB(B0, 1, 0); PG8_SCHED; PG8_LDA(At, 1, 0); PG8_STAGE(PG8_SA(0, 1), a2 + hstep, voffA);
            PG8_WAIT_L(8); PG8_BAR; PG8_WAIT_L(0); PG8_MMA(0, 0, At, B0); PG8_BAR; PG8_SCHED;
            PG8_LDB(B1, 1, 1); PG8_STAGE(PG8_SB(1, 0), b3, voffB);
            PG8_BAR; PG8_WAIT_L(0); PG8_MMA(0, 1, At, B1); PG8_BAR;
            PG8_LDA(At, 1, 1); PG8_STAGE(PG8_SA(1, 0), a3, voffA);
            PG8_BAR; PG8_WAIT_L(0); PG8_MMA(1, 0, At, B0); PG8_BAR; PG8_SCHED;
            PG8_STAGE(PG8_SB(1, 1), b3 + hstep, voffB);
            PG8_WAIT_V(6); PG8_BAR; PG8_MMA(1, 1, At, B1); PG8_BAR;
            }
        }
        if constexpr (ALIGN_EPI) { if (wr == 0) PG8_BAR; }
        if constexpr (FP8 || I8) asm volatile("s_nop 15\n\ts_nop 15" ::: "memory");
        if constexpr (!Epi::AFTER_DRAIN) { int l2_; asm volatile("v_mbcnt_lo_u32_b32 %0, -1, 0\n\tv_mbcnt_hi_u32_b32 %0, -1, %0" : "=v"(l2_));
            E(acc, cur, wr, wc, l2_ & 15, l2_ >> 4); S.done(cur); }
        if (!has_next) break;
#pragma unroll
        for (int a = 0; a < 2; ++a)
#pragma unroll
            for (int b = 0; b < 2; ++b)
#pragma unroll
                for (int m = 0; m < 4; ++m)
#pragma unroll
                    for (int n = 0; n < 2; ++n) acc[a][b][m][n] = (f32x4){0.f, 0.f, 0.f, 0.f};
        cur = nxt; cA = nA; cB = nB; ++ui; cnt = cur.ntk ? cur.ntk : nt;
        if constexpr (ALIGN_EPI) { if (wr == 1) PG8_BAR; }
    }
    PG8_WAIT_V(0);
    if constexpr (!ALIGN_EPI) { if (wr == 0) PG8_BAR; }
    PG8_BAR;
    if constexpr (Epi::AFTER_DRAIN) { E.fused(acc, cur, wr, wc, fr, fq, lds, wid, lane); S.done(cur); }
#undef PG8_SA
#undef PG8_SB
#undef PG8_STAGE
#undef PG8_LDA
#undef PG8_LDB
#undef PG8_MMA
#undef PG8_WAIT_V
#undef PG8_WAIT_L
#undef PG8_BAR
#undef PG8_SCHED
}
}
#define GAS __attribute__((address_space(1)))
#define LAS __attribute__((address_space(3)))
typedef unsigned short bf16;
typedef unsigned v4u __attribute__((ext_vector_type(4)));
typedef float f32x4 __attribute__((ext_vector_type(4)));
typedef short bf16x8 __attribute__((ext_vector_type(8)));
typedef GAS unsigned gu32;
typedef GAS unsigned long long gu64;
#define RLX_AGENT __ATOMIC_RELAXED, __HIP_MEMORY_SCOPE_AGENT
#define LDS_WAIT() asm volatile("s_waitcnt lgkmcnt(0)" ::: "memory")
#define VM_WAIT() asm volatile("s_waitcnt vmcnt(0)" ::: "memory")
__device__ __forceinline__ unsigned long long rt() { return __builtin_amdgcn_s_memrealtime(); }
__device__ __forceinline__ unsigned f2bf(float f) { unsigned u = __builtin_bit_cast(unsigned, f); return (u + 0x7fffu + ((u >> 16) & 1u)) >> 16; }
__device__ __forceinline__ unsigned pk2(float lo, float hi) { return f2bf(lo) | (f2bf(hi) << 16); }
#define XB_TMO      128
#define XB_XCNT(j)  (256  + 64 * (j))
#define XB_XSUB(j)  (1280 + 64 * (j))
#define XB_XGEN(j)  (2304 + 64 * (j))
#define XB_TOP      3328
#define XB_TOPGEN   3392
#define XCD_BAR_WORDS 3456
#define XB_SPIN_CAP (1u << 18)

__device__ __forceinline__ unsigned xb_ld(unsigned* p)              { return __hip_atomic_load(p, __ATOMIC_RELAXED, __HIP_MEMORY_SCOPE_AGENT); }
__device__ __forceinline__ unsigned xb_add(unsigned* p, unsigned v) { return __hip_atomic_fetch_add(p, v, __ATOMIC_RELAXED, __HIP_MEMORY_SCOPE_AGENT); }
__device__ __forceinline__ unsigned xb_xcc_id() { return (unsigned)__builtin_amdgcn_s_getreg((3 << 11) | 20) & 0xFu; }
#define XB_SPIN(cond, bar) do { unsigned _sp = 0; while (cond) { __builtin_amdgcn_s_sleep(1); \
    if ((++_sp & 255u) == 0u) { if (xb_ld(&(bar)[XB_TMO])) break; if (_sp > XB_SPIN_CAP) { atomicAdd(&(bar)[XB_TMO], 1u); break; } } } } while (0)

struct XcdBarrier {
    unsigned* bar; unsigned x;
    volatile LAS unsigned* st;
};

__device__ __forceinline__ XcdBarrier xcd_barrier_post(unsigned* bar, volatile LAS unsigned* st) {
    XcdBarrier b; b.bar = bar; b.x = xb_xcc_id(); b.st = st;
    if (threadIdx.x == 0) (void)xb_add(&bar[XB_XCNT(b.x)], 1u);
    return b;
}
__device__ __forceinline__ void xcd_barrier_complete(unsigned* bar, unsigned x, unsigned& nloc, unsigned& nx) {
    const unsigned G = gridDim.x * gridDim.y * gridDim.z;
    unsigned sum, cnt, mine, sp = 0u;
    for (;;) {
        sum = 0u; cnt = 0u; mine = 0u;
#pragma unroll
        for (unsigned j = 0; j < 16; ++j) { const unsigned c = xb_ld(&bar[XB_XCNT(j)]); sum += c; cnt += (c > 0u) ? 1u : 0u; mine = (j == x) ? c : mine; }
        if (sum == G) break;
        __builtin_amdgcn_s_sleep(1);
        if ((++sp & 255u) == 0u) { if (xb_ld(&bar[XB_TMO])) break; if (sp > XB_SPIN_CAP) { atomicAdd(&bar[XB_TMO], 1u); break; } }
    }
    nloc = mine > 0u ? mine : 1u; nx = cnt > 0u ? cnt : 1u;
}

__device__ __forceinline__ void xcd_barrier(const XcdBarrier& b, const int tid_) {
    asm volatile("s_waitcnt vmcnt(0)" ::: "memory");
    __syncthreads();
    if (tid_ == 0) {
        unsigned* bar = b.bar;
        __builtin_amdgcn_s_waitcnt(0);
        unsigned nloc = b.st[0], nx = b.st[1];
        if (nloc == 0u) { xcd_barrier_complete(bar, b.x, nloc, nx); b.st[0] = nloc; b.st[1] = nx; }
        const unsigned old = xb_add(&bar[XB_XSUB(b.x)], 1u);
        const unsigned gen = old / nloc;
        if (old + 1u == (gen + 1u) * nloc) {
            __builtin_amdgcn_fence(__ATOMIC_RELEASE, "agent");
            asm volatile("s_waitcnt vmcnt(0)" ::: "memory");
            const unsigned og = xb_add(&bar[XB_TOP], 1u);
            const unsigned tg = og / nx;
            if (og + 1u == (tg + 1u) * nx) xb_add(&bar[XB_TOPGEN], 1u);
            else XB_SPIN(xb_ld(&bar[XB_TOPGEN]) == tg, bar);
            __builtin_amdgcn_fence(__ATOMIC_ACQUIRE, "agent");
            xb_add(&bar[XB_XGEN(b.x)], 1u);
            asm volatile("s_waitcnt vmcnt(0)" ::: "memory");
        } else {
            XB_SPIN(xb_ld(&bar[XB_XGEN(b.x)]) == gen, bar);
            __builtin_amdgcn_fence(__ATOMIC_ACQUIRE, "agent");
            asm volatile("s_waitcnt vmcnt(0)" ::: "memory");
        }
    }
    __syncthreads();
}

constexpr int NWAVES = 8, NTHR = 512;
constexpr int DM = 2048, NPROW = 8192, MROWS = 10240, SEQ = 4096, DSEQ = 64, PAST = 2048, LSK = 2112, DFF = 5632;
constexpr int NBCV = 6144, NGU = 11264, NPROJ = 5376, NATT = 5264, KVW = 512, IDXD = 128;
constexpr int SCS_LD = 2304;
constexpr float LN_EPS = 1e-5f, DN_ALPHA = 1.4142135623730951f, ATTN_SC2 = 0.08838834764831845f * 1.4426950408889634f, IDX_W_SCALE = 0.022097086912079608f;
constexpr size_t O_YP = 0, O_YS = 16777216, O_CMP = 20971520, O_KP = 20979712, O_VP = 25174016, O_IKP = 29368320, O_FCP = 30416896,
                 O_CMS = 30461952, O_KS = 30593024, O_VS = 31641600, O_IKS = 32690176, O_FCS = 32952320, O_END = 33673216;
constexpr size_t MiB = 1u << 20;
constexpr size_t WS_CTL = 0, CTL_ZERO_BYTES = 1 * MiB;
constexpr size_t WS_WMI = 1 * MiB, WS_WMO = 25 * MiB, WS_WAI = 33 * MiB, WS_WAO = 54 * MiB, WS_WF1 = 62 * MiB, WS_WF2 = 150 * MiB;
constexpr size_t WF1_STRIDE = 44 * MiB, WF2_STRIDE = 22 * MiB;
constexpr size_t WS_XB = 194 * MiB, WS_XF = 234 * MiB  , WS_Y = 314 * MiB, WS_BIG = 394 * MiB, WS_H = 614 * MiB, WS_END = 724 * MiB;
constexpr size_t WS_KP = 1 * MiB, WS_VP = 9 * MiB, WS_IKP = 17 * MiB, WS_IW = 19 * MiB, WS_SEL = 20 * MiB;
constexpr size_t WS_IKS = 62 * MiB;
constexpr size_t WS_KS = 314 * MiB;
constexpr size_t WS_PROJ = 394 * MiB, WS_SCP = 394 * MiB, WS_SCS = 522 * MiB, WS_VS = 548 * MiB;
constexpr size_t WS_QR = 614 * MiB, WS_IQ = 654 * MiB;
constexpr int CW_BAR = 4096;

typedef const GAS float* gcf; typedef GAS float* gf; typedef const GAS bf16* gcb; typedef GAS bf16* gb; typedef const GAS int* gci; typedef GAS int* gi;
typedef float f32x16 __attribute__((ext_vector_type(16)));
typedef float f32x2 __attribute__((ext_vector_type(2)));
__device__ __forceinline__ float bflo(unsigned w) { return __uint_as_float(w << 16); }
__device__ __forceinline__ float bfhi(unsigned w) { return __uint_as_float(w & 0xffff0000u); }
__device__ __forceinline__ float bf1(bf16 h) { return __uint_as_float((unsigned)h << 16); }
__device__ __forceinline__ void unpack8(const v4u w, float (&f)[8]) { f[0] = bflo(w.x); f[1] = bfhi(w.x); f[2] = bflo(w.y); f[3] = bfhi(w.y); f[4] = bflo(w.z); f[5] = bfhi(w.z); f[6] = bflo(w.w); f[7] = bfhi(w.w); }
__device__ __forceinline__ v4u pack8(const float (&f)[8]) { v4u o; o.x = pk2(f[0], f[1]); o.y = pk2(f[2], f[3]); o.z = pk2(f[4], f[5]); o.w = pk2(f[6], f[7]); return o; }
__device__ __forceinline__ void ldf8(gcf p, float (&f)[8]) { const f32x4 a = *(const GAS f32x4*)p, b = *(const GAS f32x4*)(p + 4); f[0] = a.x; f[1] = a.y; f[2] = a.z; f[3] = a.w; f[4] = b.x; f[5] = b.y; f[6] = b.z; f[7] = b.w; }
__device__ __forceinline__ void stf8(gf p, const float (&f)[8]) { *(GAS f32x4*)p = (f32x4){f[0], f[1], f[2], f[3]}; *(GAS f32x4*)(p + 4) = (f32x4){f[4], f[5], f[6], f[7]}; }
__device__ __forceinline__ unsigned pk4_fp8(float a, float b, float c, float d) {
    a = fminf(fmaxf(a, -448.f), 448.f); b = fminf(fmaxf(b, -448.f), 448.f); c = fminf(fmaxf(c, -448.f), 448.f); d = fminf(fmaxf(d, -448.f), 448.f);
    int w = __builtin_amdgcn_cvt_pk_fp8_f32(a, b, 0, false); w = __builtin_amdgcn_cvt_pk_fp8_f32(c, d, w, true); return (unsigned)w; }
__device__ __forceinline__ unsigned pk4_fp8_nc(float a, float b, float c, float d) {
    int w = __builtin_amdgcn_cvt_pk_fp8_f32(a, b, 0, false); w = __builtin_amdgcn_cvt_pk_fp8_f32(c, d, w, true); return (unsigned)w; }
__device__ __forceinline__ unsigned pk4_i8(float a, float b, float c, float d) {
    const int ia = (int)__builtin_rintf(a), ib = (int)__builtin_rintf(b), ic = (int)__builtin_rintf(c), id = (int)__builtin_rintf(d);
    return (unsigned)(ia & 0xff) | ((unsigned)(ib & 0xff) << 8) | ((unsigned)(ic & 0xff) << 16) | ((unsigned)id << 24); }
__device__ __forceinline__ float shfl_f(float v, int src) { return __int_as_float(__builtin_amdgcn_ds_bpermute(src << 2, __float_as_int(v))); }
__device__ __forceinline__ float wave_sum(float v, int lane) {
#pragma unroll
    for (int o = 1; o < 64; o <<= 1) v += shfl_f(v, lane ^ o);
    return v;
}
__device__ __forceinline__ int wave_sum_i(int v, int lane) {
#pragma unroll
    for (int o = 1; o < 64; o <<= 1) v += __builtin_amdgcn_ds_bpermute((lane ^ o) << 2, v);
    return v;
}

__device__ __forceinline__ void tr_col_bf16(gcf W, int N, int k0, int n_src, bool ok, GAS v4u* dst) {
    float v[64]; const int nc = ok ? n_src : 0;
#pragma unroll
    for (int j = 0; j < 64; ++j) v[j] = (W + (size_t)(k0 + j) * N)[nc];
#pragma unroll
    for (int c = 0; c < 8; ++c) { v4u o; o.x = pk2(v[8 * c], v[8 * c + 1]); o.y = pk2(v[8 * c + 2], v[8 * c + 3]); o.z = pk2(v[8 * c + 4], v[8 * c + 5]); o.w = pk2(v[8 * c + 6], v[8 * c + 7]);
        if (!ok) o = (v4u){0u, 0u, 0u, 0u}; dst[c] = o; }
}
__device__ __forceinline__ void tr_col_fp8(gcf W, int N, int k0, int n_src, GAS v4u* dst) {
    float v[64];
#pragma unroll
    for (int j = 0; j < 64; ++j) v[j] = (W + (size_t)(k0 + j) * N)[n_src] * 256.f;
#pragma unroll
    for (int c = 0; c < 4; ++c) { v4u o; o.x = pk4_fp8(v[16 * c], v[16 * c + 1], v[16 * c + 2], v[16 * c + 3]); o.y = pk4_fp8(v[16 * c + 4], v[16 * c + 5], v[16 * c + 6], v[16 * c + 7]);
        o.z = pk4_fp8(v[16 * c + 8], v[16 * c + 9], v[16 * c + 10], v[16 * c + 11]); o.w = pk4_fp8(v[16 * c + 12], v[16 * c + 13], v[16 * c + 14], v[16 * c + 15]); dst[c] = o; }
}
__device__ __forceinline__ void absmax_item(gcf W, int N, int item, int lane, GAS unsigned* SWMbits, int glu) {
    const int nblk = N / 64, kb = item / nblk, nb = item - kb * nblk, k0 = 64 * kb, n = 64 * nb + lane;
    float v[64]; float mx = 0.f;
#pragma unroll
    for (int j = 0; j < 64; ++j) v[j] = (W + (size_t)(k0 + j) * N)[n];
#pragma unroll
    for (int j = 0; j < 64; ++j) mx = fmaxf(mx, fabsf(v[j]));
    int no = n; if (glu) { const int up = n >= N / 2, c = up ? n - N / 2 : n; no = 256 * (c >> 7) + (c & 127) + (up ? 128 : 0); }
    __hip_atomic_fetch_max(SWMbits + no, __float_as_uint(mx), __ATOMIC_RELAXED, __HIP_MEMORY_SCOPE_AGENT);
}
__device__ __forceinline__ void quant_item(gcf W, int K, int N, GAS unsigned char* WI, gb WG, gcf SWM, int item, int lane, int glu) {
    const int nblk = N / 64, kb = item / nblk, nb = item - kb * nblk, k0 = 64 * kb, n = 64 * nb + lane;
    int up, c, no; if (glu) { up = n >= N / 2; c = up ? n - N / 2 : n; no = 256 * (c >> 7) + (c & 127) + (up ? 128 : 0); } else { up = n < 2048; c = n - 2048; no = n; }
    float v[64];
#pragma unroll
    for (int j = 0; j < 64; ++j) v[j] = (W + (size_t)(k0 + j) * N)[n];
    const float mx = SWM[no], inv = mx > 0.f ? 127.f / mx : 0.f;
    GAS v4u* dst = (GAS v4u*)(WI + (size_t)no * K + k0);
#pragma unroll
    for (int q = 0; q < 4; ++q) { v4u o; o.x = pk4_i8(v[16 * q] * inv, v[16 * q + 1] * inv, v[16 * q + 2] * inv, v[16 * q + 3] * inv); o.y = pk4_i8(v[16 * q + 4] * inv, v[16 * q + 5] * inv, v[16 * q + 6] * inv, v[16 * q + 7] * inv);
        o.z = pk4_i8(v[16 * q + 8] * inv, v[16 * q + 9] * inv, v[16 * q + 10] * inv, v[16 * q + 11] * inv); o.w = pk4_i8(v[16 * q + 12] * inv, v[16 * q + 13] * inv, v[16 * q + 14] * inv, v[16 * q + 15] * inv); dst[q] = o; }
    if (!up) { GAS v4u* dg = (GAS v4u*)(WG + (size_t)c * K + k0);
#pragma unroll
        for (int q = 0; q < 8; ++q) { v4u o; o.x = pk2(v[8 * q], v[8 * q + 1]); o.y = pk2(v[8 * q + 2], v[8 * q + 3]); o.z = pk2(v[8 * q + 4], v[8 * q + 5]); o.w = pk2(v[8 * q + 6], v[8 * q + 7]); dg[q] = o; } }
}
__device__ __forceinline__ void transpose_item(gcf W, int K, int N, int Npad, gb WT, int item, int lane, int glu = 0) {
    const int nblk = Npad / 64, kb = item / nblk, nb = item - kb * nblk, k0 = 64 * kb, n = 64 * nb + lane;
    int no = n; if (glu) { const int up = n >= N / 2, c = up ? n - N / 2 : n; no = 256 * (c >> 7) + (c & 127) + (up ? 128 : 0); }
    tr_col_bf16(W, N, k0, n, n < N, (GAS v4u*)(WT + (size_t)no * K + k0));
}
__device__ __forceinline__ void transpose_item8(gcf W, int K, int N, GAS unsigned char* WT, int item, int lane) {
    const int nblk = N / 64, kb = item / nblk, nb = item - kb * nblk, k0 = 64 * kb, n = 64 * nb + lane;
    tr_col_fp8(W, N, k0, n, (GAS v4u*)(WT + (size_t)n * K + k0));
}
__device__ __forceinline__ void cvt_rows(gcf src, gb dst, int cps, size_t dstride, int total, int gt, int GT) {
    for (int e = gt; e < total; e += GT) { const int sb = e / cps, rem = e - sb * cps; float f[8]; ldf8(src + (size_t)e * 8, f); *(GAS v4u*)(dst + (size_t)sb * dstride + (size_t)rem * 8) = pack8(f); }
}

__device__ __forceinline__ int kperm(int d) { return (d & 64) | ((d & 24) << 1) | ((d & 32) >> 2) | (d & 7); }
__device__ __forceinline__ void cvt_rows_k8(gcf src, GAS unsigned char* dst, int cps, size_t dstride, int total, int gt, int GT) {
    typedef unsigned u32x2t __attribute__((ext_vector_type(2)));
    for (int e = gt; e < total; e += GT) { const int sb = e / cps, rem = e - sb * cps; const int row = rem >> 6, c = rem & 63; float f[8]; ldf8(src + (size_t)e * 8, f);
        *(GAS u32x2t*)(dst + (size_t)sb * dstride + ((size_t)(c >> 4) * LSK + row) * 128 + kperm((c & 15) * 8)) = (u32x2t){pk4_fp8(f[0] * 16.f, f[1] * 16.f, f[2] * 16.f, f[3] * 16.f), pk4_fp8(f[4] * 16.f, f[5] * 16.f, f[6] * 16.f, f[7] * 16.f)}; }
}

__device__ __forceinline__ void cvt_rows_v8(gcf src, GAS unsigned char* dst, int cps, size_t dstride, int total, int gt, int GT) {
    typedef unsigned u32x2t __attribute__((ext_vector_type(2)));
    for (int e = gt; e < total; e += GT) { const int sb = e / cps, rem = e - sb * cps; const int row = rem >> 6, c = rem & 63; float f[8]; ldf8(src + (size_t)e * 8, f);
        *(GAS u32x2t*)(dst + (size_t)sb * dstride + ((size_t)(c >> 4) * LSK + row) * 128 + (c & 15) * 8) = (u32x2t){pk4_fp8(f[0] * 16.f, f[1] * 16.f, f[2] * 16.f, f[3] * 16.f), pk4_fp8(f[4] * 16.f, f[5] * 16.f, f[6] * 16.f, f[7] * 16.f)}; }
}

__device__ __forceinline__ void xrows_phase(gcf xp, gcf xs, gb XB, GAS unsigned char* XI, gf SA, gb XS, int gw, int NGW, int lane) {
    for (int row = gw; row < MROWS; row += NGW) {
        gcf xr = row < NPROW ? xp + (size_t)row * DM : xs + (size_t)(row - NPROW) * DM; float v[4][8]; float amax = 0.f;
#pragma unroll
        for (int j = 0; j < 4; ++j) { ldf8(xr + 8 * lane + 512 * j, v[j]);
#pragma unroll
            for (int e = 0; e < 8; ++e) amax = fmaxf(amax, fabsf(v[j][e])); }
#pragma unroll
        for (int o_ = 1; o_ < 64; o_ <<= 1) amax = fmaxf(amax, shfl_f(amax, lane ^ o_));
        const float inv = amax > 0.f ? 127.f / amax : 0.f; typedef unsigned u32x2t __attribute__((ext_vector_type(2)));
        const bool is_s = row >= NPROW; const int t = is_s ? ((row - NPROW) & 63) : (row & 4095), T = is_s ? DSEQ : SEQ;
        const int srow = (is_s ? 4 + ((row - NPROW) >> 6) * 2 : (row >> 12) * 2) + (t - (T - 2));
#pragma unroll
        for (int j = 0; j < 4; ++j) { const v4u pb = pack8(v[j]); *(GAS v4u*)(XB + (size_t)row * DM + 8 * lane + 512 * j) = pb;
            *(GAS u32x2t*)(XI + (size_t)row * DM + 8 * lane + 512 * j) = (u32x2t){pk4_i8(v[j][0] * inv, v[j][1] * inv, v[j][2] * inv, v[j][3] * inv), pk4_i8(v[j][4] * inv, v[j][5] * inv, v[j][6] * inv, v[j][7] * inv)};
            if (t >= T - 2) *(GAS v4u*)(XS + (size_t)srow * DM + 8 * lane + 512 * j) = pb; }
        if (lane == 0) SA[row] = amax * (1.f / 127.f);
    }
}

__device__ __forceinline__ void conv_mix_phase(gcb BCV, gb Z, gcf cw, gcf state, gf out, gcb GS, int gt, int GT) {
    for (int task = gt; task < (MROWS / 16) * 256; task += GT) {
        const int cg = task & 255, seg = task >> 8, row0 = seg * 16, c0 = cg * 8;
        const bool is_s = row0 >= NPROW; const int tl = is_s ? ((row0 - NPROW) & 63) : (row0 & 4095); const int sb = is_s ? ((row0 - NPROW) >> 6) : (row0 >> 12); const int T = is_s ? DSEQ : SEQ;
        float w0[8], w1[8], w2[8]; ldf8(cw + c0, w0); ldf8(cw + DM + c0, w1); ldf8(cw + 2 * DM + c0, w2);
        float um2[8], um1[8];
        if (tl == 0) {
            if (is_s) { ldf8(state + (size_t)(sb * 2 + 0) * DM + c0, um2); ldf8(state + (size_t)(sb * 2 + 1) * DM + c0, um1); }
            else {
#pragma unroll
                for (int e = 0; e < 8; ++e) { um2[e] = 0.f; um1[e] = 0.f; } }
        } else {
            float c8[8], v8[8];
            gcb p2 = BCV + (size_t)(row0 - 2) * NBCV + c0; unpack8(*(const GAS v4u*)(p2 + DM), c8); unpack8(*(const GAS v4u*)(p2 + 2 * DM), v8);
#pragma unroll
            for (int e = 0; e < 8; ++e) um2[e] = c8[e] * v8[e];
            gcb p1 = p2 + NBCV; unpack8(*(const GAS v4u*)(p1 + DM), c8); unpack8(*(const GAS v4u*)(p1 + 2 * DM), v8);
#pragma unroll
            for (int e = 0; e < 8; ++e) um1[e] = c8[e] * v8[e];
        }
#pragma unroll 4
        for (int r = 0; r < 16; ++r) {
            const int row = row0 + r; gcb p = BCV + (size_t)row * NBCV + c0;
            float b8[8], c8[8], v8[8], u[8], z[8];
            unpack8(*(const GAS v4u*)p, b8); unpack8(*(const GAS v4u*)(p + DM), c8); unpack8(*(const GAS v4u*)(p + 2 * DM), v8);
#pragma unroll
            for (int e = 0; e < 8; ++e) { u[e] = c8[e] * v8[e]; z[e] = b8[e] * (w0[e] * um2[e] + w1[e] * um1[e] + w2[e] * u[e]); }
            *(GAS v4u*)(Z + (size_t)row * DM + c0) = pack8(z);
            const int j = tl + r - (T - 2);
            if (j >= 0) { const int srow = (is_s ? 4 + sb * 2 : sb * 2) + j; float ca[8], cb_[8], va[8], vb[8], us[8];
                unpack8(*(const GAS v4u*)(GS + (size_t)srow * 4096 + c0), ca); unpack8(*(const GAS v4u*)(GS + (size_t)(256 + srow) * 4096 + c0), cb_);
                unpack8(*(const GAS v4u*)(GS + (size_t)srow * 4096 + 2048 + c0), va); unpack8(*(const GAS v4u*)(GS + (size_t)(256 + srow) * 4096 + 2048 + c0), vb);
#pragma unroll
                for (int e = 0; e < 8; ++e) us[e] = (ca[e] + cb_[e]) * (va[e] + vb[e]);
                stf8(out + (is_s ? O_CMS : O_CMP) + (size_t)(sb * 2 + j) * DM + c0, us); }
#pragma unroll
            for (int e = 0; e < 8; ++e) { um2[e] = um1[e]; um1[e] = u[e]; }
        }
    }
}
__device__ __forceinline__ void glu_fixup_phase(gcf FIXG, gcf FIXU, gcf HALO, GAS unsigned char* H, gcf cw, gcf cb, gcf state, gf out, gcb GS, int layer, int gt, int GT) {
    constexpr int NCG = DFF / 8;
    for (int task = gt; task < 320 * NCG; task += GT) {
        const int rid = task / NCG, cg = task - rid * NCG, bk = rid >> 1, j = rid & 1, c0 = cg * 8, row = 64 * bk + j;
        const bool is_s = bk >= 128; const int sb = is_s ? bk - 128 : bk >> 6; const bool seq_start = is_s || (bk & 63) == 0, seq_end = is_s || (bk & 63) == 63;
        float w0[8], w1[8], w2[8], bb[8], g0[8], u0[8], h1[8], h0[8];
        ldf8(cw + c0, w0); ldf8(cw + DFF + c0, w1); ldf8(cw + 2 * DFF + c0, w2); ldf8(cb + c0, bb); ldf8(FIXG + (size_t)rid * DFF + c0, g0); ldf8(FIXU + (size_t)rid * DFF + c0, u0);
        if (seq_start) { if (is_s) { ldf8(state + (size_t)(sb * 2 + 0) * DFF + c0, h0); ldf8(state + (size_t)(sb * 2 + 1) * DFF + c0, h1); } else {
#pragma unroll
            for (int e = 0; e < 8; ++e) { h0[e] = 0.f; h1[e] = 0.f; } } }
        else { ldf8(HALO + (size_t)((bk - 1) * 2 + 0) * DFF + c0, h0); ldf8(HALO + (size_t)((bk - 1) * 2 + 1) * DFF + c0, h1); }
        float g1[8], g2[8];
        if (j == 0) {
#pragma unroll
            for (int e = 0; e < 8; ++e) { g1[e] = h1[e]; g2[e] = h0[e]; } }
        else { ldf8(FIXG + (size_t)(bk * 2) * DFF + c0, g1);
#pragma unroll
            for (int e = 0; e < 8; ++e) g2[e] = h1[e]; }
        float h[8];
#pragma unroll
        for (int e = 0; e < 8; ++e) { const float a = w0[e] * g2[e] + w1[e] * g1[e] + w2[e] * g0[e] + bb[e];
            const float sg = __builtin_amdgcn_rcpf(1.f + __builtin_amdgcn_exp2f(-a * 1.4426950408889634f)); h[e] = a * sg * u0[e] * 16.f; }
        { typedef unsigned u32x2t __attribute__((ext_vector_type(2)));
          *(GAS u32x2t*)(H + (size_t)row * DFF + c0) = (u32x2t){pk4_fp8(h[0], h[1], h[2], h[3]), pk4_fp8(h[4], h[5], h[6], h[7])}; }
        if (seq_end) { float s8[8], t8[8]; const int srow = (is_s ? 4 + sb * 2 : sb * 2) + j;
            unpack8(*(const GAS v4u*)(GS + (size_t)srow * DFF + c0), s8); unpack8(*(const GAS v4u*)(GS + (size_t)(256 + srow) * DFF + c0), t8);
#pragma unroll
            for (int e = 0; e < 8; ++e) s8[e] += t8[e];
            stf8(out + (is_s ? O_FCS + (size_t)((layer * 32 + sb) * 2 + j) * DFF : O_FCP + (size_t)((layer * 2 + sb) * 2 + j) * DFF) + c0, s8); }
    }
}
__device__ __forceinline__ void ln_phase(gcb Y, gcf P, gcf g, gcf b, gf XF, gb XB, GAS unsigned char* X8, GAS unsigned char* XI, gf SA, gb XS, int gw, int NGW, int lane) {
    for (int row = gw; row < MROWS; row += NGW) {
        float v[4][8]; float s = 0.f;
#pragma unroll
        for (int j = 0; j < 4; ++j) unpack8(*(const GAS v4u*)(Y + (size_t)row * DM + 8 * lane + 512 * j), v[j]);
        if (row >= NPROW) {
#pragma unroll
            for (int q = 0; q < 3; ++q) { gcf pr = P + ((size_t)q * 2048 + (size_t)(row - NPROW)) * DM + 8 * lane;
#pragma unroll
                for (int j = 0; j < 4; ++j) { float t[8]; ldf8(pr + 512 * j, t);
#pragma unroll
                    for (int e = 0; e < 8; ++e) v[j][e] += t[e]; } }
        }
#pragma unroll
        for (int j = 0; j < 4; ++j)
#pragma unroll
            for (int e = 0; e < 8; ++e) s += v[j][e];
        const float mean = wave_sum(s, lane) * (1.f / DM); float s2 = 0.f;
#pragma unroll
        for (int j = 0; j < 4; ++j)
#pragma unroll
            for (int e = 0; e < 8; ++e) { v[j][e] -= mean; s2 += v[j][e] * v[j][e]; }
        const float rstd = 1.f / sqrtf(wave_sum(s2, lane) * (1.f / DM) + LN_EPS);
        float amax = 0.f;
#pragma unroll
        for (int j = 0; j < 4; ++j) { float g8[8], b8[8], o[8]; ldf8(g + 8 * lane + 512 * j, g8); ldf8(b + 8 * lane + 512 * j, b8);
#pragma unroll
            for (int e = 0; e < 8; ++e) { o[e] = v[j][e] * rstd * g8[e] + b8[e]; v[j][e] = o[e]; amax = fmaxf(amax, fabsf(o[e])); }
            if (XF) stf8(XF + (size_t)row * DM + 8 * lane + 512 * j, o);
            if (XB) *(GAS v4u*)(XB + (size_t)row * DM + 8 * lane + 512 * j) = pack8(o);
            if (X8) { typedef unsigned u32x2t __attribute__((ext_vector_type(2))); *(GAS u32x2t*)(X8 + (size_t)row * DM + 8 * lane + 512 * j) = (u32x2t){pk4_fp8(o[0] * 16.f, o[1] * 16.f, o[2] * 16.f, o[3] * 16.f), pk4_fp8(o[4] * 16.f, o[5] * 16.f, o[6] * 16.f, o[7] * 16.f)}; } }
        if (XI) {
#pragma unroll
            for (int o_ = 1; o_ < 64; o_ <<= 1) amax = fmaxf(amax, shfl_f(amax, lane ^ o_));
            const float inv = amax > 0.f ? 127.f / amax : 0.f; typedef unsigned u32x2t __attribute__((ext_vector_type(2)));
#pragma unroll
            for (int j = 0; j < 4; ++j) *(GAS u32x2t*)(XI + (size_t)row * DM + 8 * lane + 512 * j) = (u32x2t){pk4_i8(v[j][0] * inv, v[j][1] * inv, v[j][2] * inv, v[j][3] * inv), pk4_i8(v[j][4] * inv, v[j][5] * inv, v[j][6] * inv, v[j][7] * inv)};
            if (lane == 0) SA[row] = amax * (1.f / 127.f);
            const bool is_s = row >= NPROW; const int t = is_s ? ((row - NPROW) & 63) : (row & 4095), T = is_s ? DSEQ : SEQ;
            if (t >= T - 2) { const int srow = (is_s ? 4 + ((row - NPROW) >> 6) * 2 : (row >> 12) * 2) + (t - (T - 2));
#pragma unroll
                for (int j = 0; j < 4; ++j) *(GAS v4u*)(XS + (size_t)srow * DM + 8 * lane + 512 * j) = pack8(v[j]); }
        }
    }
}

__device__ __forceinline__ void postproj_phase(gcb PQ, gcb PK, const __attribute__((address_space(4))) float* inv_freq, gcf kng, gcf knb, gf out,
                                               gb QR, gb IQ, gb KP, gb VP, gb IKP, gb KS, gb VS, gb IKS, gf IW, int gw, int NGW, int lane) {
    typedef unsigned u32x2t __attribute__((ext_vector_type(2)));
    const int c = lane & 7, hh = lane >> 3, d0 = 8 * c;
    float invf[8], g1[8], g2[8], bb1[8], bb2[8];
#pragma unroll
    for (int e = 0; e < 8; ++e) { invf[e] = inv_freq[d0 + e]; g1[e] = kng[d0 + e]; g2[e] = kng[64 + d0 + e]; bb1[e] = knb[d0 + e]; bb2[e] = knb[64 + d0 + e]; }
    for (int row = gw; row < MROWS; row += NGW) {
        const bool is_s = row >= NPROW; const int sb = is_s ? ((row - NPROW) >> 6) : (row >> 12); const int t = is_s ? ((row - NPROW) & 63) : (row & 4095);
        const int pos = is_s ? PAST + t : t;
        float cs[8], sn[8];
#pragma unroll
        for (int e = 0; e < 8; ++e) { const float ang = (float)pos * invf[e];
            const double rev = (double)ang * 0.15915494309189535; const float fr = (float)(rev - __builtin_rint(rev));
            cs[e] = __builtin_amdgcn_cosf(fr); sn[e] = __builtin_amdgcn_sinf(fr); }
        gcb Pq = PQ + (size_t)row * 4096; gcb P = PK + (size_t)row * 1280;
        gb qo = QR + (size_t)row * DM; gb iqo = IQ + (size_t)row * DM;
#pragma unroll
        for (int p = 0; p < 2; ++p) { const int h = 8 * p + hh;
            float x1[8], x2[8], y1[8], y2[8], o1[8], o2[8];
            unpack8(*(const GAS v4u*)(Pq + h * 128 + d0), x1); unpack8(*(const GAS v4u*)(Pq + h * 128 + 64 + d0), x2);
            unpack8(*(const GAS v4u*)(Pq + 2048 + h * 128 + d0), y1); unpack8(*(const GAS v4u*)(Pq + 2048 + h * 128 + 64 + d0), y2);
#pragma unroll
            for (int e = 0; e < 8; ++e) { o1[e] = x1[e] * cs[e] - x2[e] * sn[e]; o2[e] = x1[e] * sn[e] + x2[e] * cs[e]; }
            *(GAS v4u*)(qo + h * 128 + d0) = pack8(o1); *(GAS v4u*)(qo + h * 128 + 64 + d0) = pack8(o2);
#pragma unroll
            for (int e = 0; e < 8; ++e) { o1[e] = y1[e] * cs[e] - y2[e] * sn[e]; o2[e] = y1[e] * sn[e] + y2[e] * cs[e]; }
            *(GAS v4u*)(iqo + h * 128 + d0) = pack8(o1); *(GAS v4u*)(iqo + h * 128 + 64 + d0) = pack8(o2);
        }
        gf kof = out + (is_s ? O_KS + (size_t)(row - NPROW) * KVW : O_KP + (size_t)row * KVW);
        gf vof = out + (is_s ? O_VS + (size_t)(row - NPROW) * KVW : O_VP + (size_t)row * KVW);
        GAS unsigned char* kob = is_s ? (GAS unsigned char*)KS + ((size_t)sb * 4 * LSK + PAST + t) * 128 : (GAS unsigned char*)KP + ((size_t)sb * 4 * SEQ + t) * 128;
        GAS unsigned char* vob = is_s ? (GAS unsigned char*)VS + ((size_t)sb * 4 * LSK + PAST + t) * 128 : (GAS unsigned char*)VP + ((size_t)sb * 4 * SEQ + t) * 128;
        const size_t gstr = (size_t)(is_s ? LSK : SEQ) * 128;
        if (hh < 4) { const int g = hh;
            float x1[8], x2[8], o1[8], o2[8];
            unpack8(*(const GAS v4u*)(P + g * 128 + d0), x1); unpack8(*(const GAS v4u*)(P + g * 128 + 64 + d0), x2);
#pragma unroll
            for (int e = 0; e < 8; ++e) { o1[e] = x1[e] * cs[e] - x2[e] * sn[e]; o2[e] = x1[e] * sn[e] + x2[e] * cs[e]; }
            stf8(kof + g * 128 + d0, o1); stf8(kof + g * 128 + 64 + d0, o2);
            *(GAS u32x2t*)(kob + g * gstr + kperm(d0)) = (u32x2t){pk4_fp8(o1[0] * 16.f, o1[1] * 16.f, o1[2] * 16.f, o1[3] * 16.f), pk4_fp8(o1[4] * 16.f, o1[5] * 16.f, o1[6] * 16.f, o1[7] * 16.f)};
            *(GAS u32x2t*)(kob + g * gstr + kperm(64 + d0)) = (u32x2t){pk4_fp8(o2[0] * 16.f, o2[1] * 16.f, o2[2] * 16.f, o2[3] * 16.f), pk4_fp8(o2[4] * 16.f, o2[5] * 16.f, o2[6] * 16.f, o2[7] * 16.f)};
        }
        { float vf[8]; unpack8(*(const GAS v4u*)(P + 512 + 8 * lane), vf); stf8(vof + 8 * lane, vf);
          *(GAS u32x2t*)(vob + (size_t)(lane >> 4) * gstr + ((8 * lane) & 127)) = (u32x2t){pk4_fp8(vf[0] * 16.f, vf[1] * 16.f, vf[2] * 16.f, vf[3] * 16.f), pk4_fp8(vf[4] * 16.f, vf[5] * 16.f, vf[6] * 16.f, vf[7] * 16.f)}; }
        {
            float x1[8], x2[8]; float s = 0.f;
            if (hh == 0) { unpack8(*(const GAS v4u*)(P + 1024 + d0), x1); unpack8(*(const GAS v4u*)(P + 1024 + 64 + d0), x2); }
            else {
#pragma unroll
                for (int e = 0; e < 8; ++e) { x1[e] = 0.f; x2[e] = 0.f; } }
#pragma unroll
            for (int e = 0; e < 8; ++e) s += x1[e] + x2[e];
            const float mean = wave_sum(s, lane) * (1.f / 128.f); float s2 = 0.f;
#pragma unroll
            for (int e = 0; e < 8; ++e) { x1[e] -= mean; x2[e] -= mean; s2 += x1[e] * x1[e] + x2[e] * x2[e]; }
            if (hh != 0) s2 = 0.f;
            const float rstd = 1.f / sqrtf(wave_sum(s2, lane) * (1.f / 128.f) + LN_EPS);
            if (hh == 0) {
                float o1[8], o2[8];
#pragma unroll
                for (int e = 0; e < 8; ++e) { const float n1 = x1[e] * rstd * g1[e] + bb1[e], n2 = x2[e] * rstd * g2[e] + bb2[e]; o1[e] = n1 * cs[e] - n2 * sn[e]; o2[e] = n1 * sn[e] + n2 * cs[e]; }
                gf iof = out + (is_s ? O_IKS + (size_t)(row - NPROW) * IDXD : O_IKP + (size_t)row * IDXD);
                gb iob = is_s ? IKS + ((size_t)sb * LSK + PAST + t) * IDXD : IKP + (size_t)row * IDXD;
                stf8(iof + d0, o1); stf8(iof + 64 + d0, o2); *(GAS v4u*)(iob + d0) = pack8(o1); *(GAS v4u*)(iob + 64 + d0) = pack8(o2);
            }
        }
        if (lane < 16) IW[(size_t)row * 16 + lane] = bf1(P[1152 + lane]) * IDX_W_SCALE;
    }
}

__device__ __forceinline__ void indexer_phase(LAS unsigned char* L, gcb IQ, gcf IW, gcb IKP, gcb IKS, gf SCP, gf SCS,
                                              gcf Kc, gcf Vc, GAS unsigned char* KS8, GAS unsigned char* VS8, int vcu, int G, int tid, int lane, int wave) {
    typedef unsigned u32x2t_ __attribute__((ext_vector_type(2)));
    constexpr int CV_N = 32 * PAST * KVW / 8;
#define CV_REQ(a_, b_, ok_, idx_) do { const int ix_ = (idx_); ok_ = ix_ < 2 * CV_N; if (ok_) { gcf sp_ = ix_ < CV_N ? Kc + (size_t)ix_ * 8 : Vc + (size_t)(ix_ - CV_N) * 8; a_ = *(const GAS f32x4*)sp_; b_ = *(const GAS f32x4*)(sp_ + 4); } } while (0)
#define CV_USE(a_, b_, ok_, idx_) do { if (ok_) { const int ix_ = (idx_); const bool isk_ = ix_ < CV_N; const int e_ = isk_ ? ix_ : ix_ - CV_N; const int sb_ = e_ / (PAST * KVW / 8), rem_ = e_ - sb_ * (PAST * KVW / 8), row_ = rem_ >> 6, c_ = rem_ & 63; \
        GAS unsigned char* d_ = (isk_ ? KS8 : VS8) + (size_t)sb_ * LSK * KVW + ((size_t)(c_ >> 4) * LSK + row_) * 128 + (isk_ ? kperm((c_ & 15) * 8) : (c_ & 15) * 8); \
        *(GAS u32x2t_*)d_ = (u32x2t_){pk4_fp8(a_[0] * 16.f, a_[1] * 16.f, a_[2] * 16.f, a_[3] * 16.f), pk4_fp8(b_[0] * 16.f, b_[1] * 16.f, b_[2] * 16.f, b_[3] * 16.f)}; } } while (0)
    f32x4 ce0, ce1, co0, co1; bool cve = false, cvo = false;
    const int r32 = lane & 31, hi = lane >> 5;
    for (int u = vcu; u < 1376; u += G) {
        int qrow0, kt, scld; gcb IKb; gf scb;
        if (u < 1088) { const int b = u / 544; int r = u - b * 544; int gq = 0; while (r >= 4 * (gq + 1)) { r -= 4 * (gq + 1); ++gq; }
            const int c = 4 * gq + r / (gq + 1); kt = r % (gq + 1); qrow0 = b * SEQ + 64 * c; IKb = IKP + (size_t)b * SEQ * IDXD; scb = SCP + (size_t)qrow0 * SEQ; scld = SEQ; }
        else { const int us = u - 1088; const int sb = us / 9; kt = us - sb * 9; qrow0 = NPROW + 64 * sb; IKb = IKS + (size_t)sb * LSK * IDXD; scb = SCS + (size_t)(64 * sb) * SCS_LD; scld = SCS_LD; }
        const int key0 = kt * 256 + 32 * wave;
        pg8::bf16x8 a[8];
#pragma unroll
        for (int ks = 0; ks < 8; ++ks) a[ks] = *(const GAS pg8::bf16x8*)(IKb + (size_t)(key0 + r32) * IDXD + 16 * ks + 8 * hi);
        f32x16 I0, I1;
#pragma unroll
        for (int r = 0; r < 16; ++r) { I0[r] = 0.f; I1[r] = 0.f; }
        const int sq = tid >> 3, sc0 = tid & 7;
        gcb iqsrc = IQ + (size_t)(qrow0 + sq) * DM + sc0 * 8;
        const unsigned wofs0 = (unsigned)(sq * 256 + ((sc0 ^ (sq & 15)) * 16)), wofs1 = (unsigned)(sq * 256 + (((sc0 + 8) ^ (sq & 15)) * 16));
        gcf iw0 = IW + (size_t)(qrow0 + r32) * 16; gcf iw1 = iw0 + 32 * 16;
        v4u se0 = *(const GAS v4u*)iqsrc, se1 = *(const GAS v4u*)(iqsrc + 64), so0 = *(const GAS v4u*)(iqsrc + 128), so1 = *(const GAS v4u*)(iqsrc + 128 + 64);
        float wn0 = iw0[0], wn1 = iw1[0];
        *(LAS v4u*)(L + wofs0) = se0; *(LAS v4u*)(L + wofs1) = se1;
        const unsigned rofs = (unsigned)(r32 * 256), rx = (unsigned)(r32 & 15);
#define IDX_HEAD(h_, LDNEXT, STNEXT) do { __syncthreads(); const float wc0_ = wn0, wc1_ = wn1; LDNEXT; if ((h_) < 15) { wn0 = iw0[(h_) + 1]; wn1 = iw1[(h_) + 1]; } \
            LAS unsigned char* buf_ = L + ((h_) & 1) * 16384; f32x16 S0_, S1_; _Pragma("unroll") for (int r_ = 0; r_ < 16; ++r_) { S0_[r_] = 0.f; S1_[r_] = 0.f; } \
            _Pragma("unroll") for (int ks_ = 0; ks_ < 8; ++ks_) { const unsigned co_ = (((unsigned)(2 * ks_ + hi)) ^ rx) * 16u; \
                const pg8::bf16x8 b0_ = *(const LAS pg8::bf16x8*)(buf_ + rofs + co_), b1_ = *(const LAS pg8::bf16x8*)(buf_ + 8192 + rofs + co_); \
                S0_ = __builtin_amdgcn_mfma_f32_32x32x16_bf16(a[ks_], b0_, S0_, 0, 0, 0); S1_ = __builtin_amdgcn_mfma_f32_32x32x16_bf16(a[ks_], b1_, S1_, 0, 0, 0); } \
            _Pragma("unroll") for (int r_ = 0; r_ < 16; ++r_) { I0[r_] += wc0_ * fmaxf(S0_[r_], 0.f); I1[r_] += wc1_ * fmaxf(S1_[r_], 0.f); } \
            STNEXT; } while (0)
#pragma unroll 1
        for (int h = 0; h < 16; h += 2) {
            IDX_HEAD(h, { if (h + 2 < 16) { se0 = *(const GAS v4u*)(iqsrc + (h + 2) * 128); se1 = *(const GAS v4u*)(iqsrc + (h + 2) * 128 + 64); } CV_REQ(ce0, ce1, cve, (u * 16 + h) * NTHR + tid); },
                     { LAS unsigned char* nb_ = L + 16384; *(LAS v4u*)(nb_ + wofs0) = so0; *(LAS v4u*)(nb_ + wofs1) = so1; if (h > 0) CV_USE(co0, co1, cvo, (u * 16 + h - 1) * NTHR + tid); });
            IDX_HEAD(h + 1, { if (h + 3 < 16) { so0 = *(const GAS v4u*)(iqsrc + (h + 3) * 128); so1 = *(const GAS v4u*)(iqsrc + (h + 3) * 128 + 64); } CV_REQ(co0, co1, cvo, (u * 16 + h + 1) * NTHR + tid); },
                     { if (h + 2 < 16) { *(LAS v4u*)(L + wofs0) = se0; *(LAS v4u*)(L + wofs1) = se1; } CV_USE(ce0, ce1, cve, (u * 16 + h) * NTHR + tid); });
        }
#undef IDX_HEAD
        CV_USE(co0, co1, cvo, (u * 16 + 15) * NTHR + tid);
#pragma unroll
        for (int j = 0; j < 4; ++j) {
            *(GAS f32x4*)(scb + (size_t)r32 * scld + key0 + 8 * j + 4 * hi) = (f32x4){I0[4 * j], I0[4 * j + 1], I0[4 * j + 2], I0[4 * j + 3]};
            *(GAS f32x4*)(scb + (size_t)(32 + r32) * scld + key0 + 8 * j + 4 * hi) = (f32x4){I1[4 * j], I1[4 * j + 1], I1[4 * j + 2], I1[4 * j + 3]};
        }
        __syncthreads();
    }
}

#undef CV_REQ
#undef CV_USE
__device__ __forceinline__ void topk_phase(LAS unsigned char* L, gcf SCP, gcf SCS, gi SEL, int gw, int NGW, int lane, int wave) {
    typedef unsigned u32x4t __attribute__((ext_vector_type(4)));
    LAS unsigned* hist = (LAS unsigned*)(L + wave * 17408);
#define TK_ROW(q0_, q_, Lk_, src_) do { q_ = ((q0_) < NPROW && ((q0_) & 2048)) ? (((q0_) & ~4095) | (4095 - ((q0_) & 2047))) : (q0_); \
        if (q_ < NPROW) { const int t_ = q_ & 4095; Lk_ = ((t_ >> 6) + 1) * 64; src_ = SCP + (size_t)q_ * SEQ; } else { Lk_ = LSK; src_ = SCS + (size_t)(q_ - NPROW) * SCS_LD; } } while (0)
#define TK_LOAD(Lk_, src_) do { const int nv_ = (Lk_) >> 6; _Pragma("unroll") for (int gI_ = 0; gI_ < 8; ++gI_) if (nv_ > gI_ * 8) { \
        _Pragma("unroll") for (int i_ = gI_ * 8; i_ < gI_ * 8 + 8; ++i_) raw[i_] = __float_as_uint((src_)[i_ < nv_ ? i_ * 64 + lane : 0]); } } while (0)
    unsigned raw[64];
    if (gw < MROWS) { int q_, Lk_; gcf src_; TK_ROW(gw, q_, Lk_, src_); if (Lk_ > 256) TK_LOAD(Lk_, src_); }
    for (int q0 = gw; q0 < MROWS; q0 += NGW) {
        int q, Lk; gcf src; TK_ROW(q0, q, Lk, src);
        gi selq = SEL + (size_t)q * 256;
        const int nv = Lk >> 6;
        unsigned key[64];
        if (Lk > 256) {
#pragma unroll
            for (int i = 0; i < 64; ++i) { const unsigned ub = raw[i]; key[i] = i < nv ? ((ub & 0x80000000u) ? ~ub : (ub | 0x80000000u)) : 0u; }
        }
        if (q0 + NGW < MROWS) { int qn_, Lkn_; gcf srcn_; TK_ROW(q0 + NGW, qn_, Lkn_, srcn_); if (Lkn_ > 256) TK_LOAD(Lkn_, srcn_); }
        if (Lk <= 256) { for (int i = lane; i < Lk; i += 64) selq[i] = i; continue; }
        unsigned prefix = 0u; int need = 256;
#pragma unroll 1
        for (int pass = 0; pass < 4; ++pass) {
            const int sh = 24 - 8 * pass; const unsigned himask = pass == 0 ? 0u : (0xffffffffu << (sh + 8));
            *(LAS u32x4t*)(hist + 4 * lane) = (u32x4t){0u, 0u, 0u, 0u};
#pragma unroll
            for (int gI = 0; gI < 8; ++gI) if (nv > gI * 8) {
#pragma unroll
                for (int i = gI * 8; i < gI * 8 + 8; ++i) { const unsigned k = key[i];
                    const bool hit = k != 0u && ((k ^ prefix) & himask) == 0u;
                    if (pass < 2 || __ballot(hit) != 0ull)
                        __hip_atomic_fetch_add(hist + (hit ? ((k >> sh) & 255u) : 256u + (unsigned)lane), 1u, __ATOMIC_RELAXED, __HIP_MEMORY_SCOPE_WORKGROUP); }
            }
            const u32x4t h4 = *(const LAS u32x4t*)(hist + 4 * lane);
            const int s = (int)(h4.x + h4.y + h4.z + h4.w); int S = s;
#pragma unroll
            for (int off = 1; off < 64; off <<= 1) { const int t = __builtin_amdgcn_ds_bpermute(((lane + off) & 63) << 2, S); if (lane + off < 64) S += t; }
            const int above = S - s;
            const bool here = above < need && need <= S;
            int c = above, d = -1, nn = 0;
            { const int hb[4] = {(int)h4.x, (int)h4.y, (int)h4.z, (int)h4.w};
#pragma unroll
              for (int b = 3; b >= 0; --b) { if (d < 0) { if (c + hb[b] >= need) { d = b; nn = need - c; } else c += hb[b]; } } }
            const unsigned long long bal = __ballot(here);
            const int fl = __builtin_amdgcn_readfirstlane(bal ? __ffsll((long long)bal) - 1 : 0);
            const int digit = __builtin_amdgcn_readlane(4 * lane + d, fl);
            need = __builtin_amdgcn_readlane(nn, fl);
            prefix |= ((unsigned)digit & 255u) << sh;
        }
        int cge = 0, ceq = 0;
#pragma unroll
        for (int gI = 0; gI < 8; ++gI) if (nv > gI * 8) {
#pragma unroll
            for (int i = gI * 8; i < gI * 8 + 8; ++i) { cge += key[i] >= prefix ? 1 : 0; ceq += key[i] == prefix ? 1 : 0; }
        }
        const int eq_total = wave_sum_i(ceq, lane);
        if (eq_total == need) {
            int S = cge;
#pragma unroll
            for (int off = 1; off < 64; off <<= 1) { const int t = __builtin_amdgcn_ds_bpermute(((lane - off) & 63) << 2, S); if (lane >= off) S += t; }
            int pos = S - cge;
            LAS int* lst = (LAS int*)(hist + 512);
#pragma unroll
            for (int gI = 0; gI < 8; ++gI) if (nv > gI * 8) {
#pragma unroll
                for (int i = gI * 8; i < gI * 8 + 8; ++i) { const bool take = key[i] >= prefix; lst[take && pos < 256 ? pos : 256 + lane] = i * 64 + lane; pos += take ? 1 : 0; }
            }
#pragma unroll
            for (int i = 0; i < 4; ++i) selq[i * 64 + lane] = lst[i * 64 + lane];
        } else {
            int base = 0, eqtaken = 0;
#pragma unroll
            for (int gI = 0; gI < 8; ++gI) if (nv > gI * 8) {
#pragma unroll
                for (int i = gI * 8; i < gI * 8 + 8; ++i) {
                    const bool gtb = key[i] > prefix, eqb = key[i] == prefix;
                    const unsigned long long be = __ballot(eqb);
                    const int eqrank = eqtaken + (int)__builtin_amdgcn_mbcnt_hi((unsigned)(be >> 32), __builtin_amdgcn_mbcnt_lo((unsigned)be, 0u));
                    const bool take = gtb || (eqb && eqrank < need);
                    const unsigned long long bt = __ballot(take);
                    const int pos = base + (int)__builtin_amdgcn_mbcnt_hi((unsigned)(bt >> 32), __builtin_amdgcn_mbcnt_lo((unsigned)bt, 0u));
                    if (take && pos < 256) selq[pos] = i * 64 + lane;
                    base += __popcll(bt); eqtaken += __popcll(be);
                }
            }
        }
    }
}

#undef TK_ROW
#undef TK_LOAD
constexpr int ATT_WAVE_LDS = 17408;
__device__ __forceinline__ void attn_phase(LAS unsigned char* L, gcb QR, gb O, gci SEL, gcb KP, gcb VP, gcb KS, gcb VS, int vcu, int G, int lane, int wave) {
    const int kq = lane & 15, lg = lane >> 4;
    LAS unsigned char* Vt = L + wave * ATT_WAVE_LDS;
    LAS int* Sl = (LAS int*)(L + wave * ATT_WAVE_LDS + 16384);
    const int trrow = 8 * lg + (kq >> 1), trx = (trrow >> 1) & 7;
    const unsigned trbase_u = (unsigned)(uintptr_t)(Vt + trrow * 128 + 8 * (kq & 1)) | (unsigned)(trx << 4);
    const int drow = lane >> 3, dslot = lane & 7;
    const int cpx = G >> 3, x = cpx ? vcu / cpx : 8, li = cpx ? (vcu - x * cpx) * NWAVES + wave : 0, nwx = cpx * NWAVES;
    if (x >= 8 || li >= 5120) return;
#define TASK(tl_, q_, g_, nsel_, Kb8_, Vb8_) do { if ((tl_) < 4096) { const int b_ = x >> 2, t_ = (tl_); g_ = x & 3; q_ = b_ * SEQ + t_; const int Lk_ = ((t_ >> 6) + 1) * 64; nsel_ = Lk_ < 256 ? Lk_ : 256; \
            Kb8_ = (const GAS unsigned char*)KP + (size_t)(b_ * 4 + g_) * SEQ * 128; Vb8_ = (const GAS unsigned char*)VP + (size_t)(b_ * 4 + g_) * SEQ * 128; } \
        else { const int s_ = (tl_) - 4096, c_ = x * 16 + (s_ >> 6), sb_ = c_ >> 2; g_ = c_ & 3; q_ = NPROW + sb_ * 64 + (s_ & 63); nsel_ = 256; \
            Kb8_ = (const GAS unsigned char*)KS + (size_t)(sb_ * 4 + g_) * LSK * 128; Vb8_ = (const GAS unsigned char*)VS + (size_t)(sb_ * 4 + g_) * LSK * 128; } } while (0)
#define QCVT(dst_, raw_) do { _Pragma("unroll") for (int ks_ = 0; ks_ < 4; ++ks_) { float f_[8]; unpack8(raw_[ks_], f_); \
            const unsigned lo_ = pk4_fp8(f_[0] * 16.f, f_[1] * 16.f, f_[2] * 16.f, f_[3] * 16.f), hi_ = pk4_fp8(f_[4] * 16.f, f_[5] * 16.f, f_[6] * 16.f, f_[7] * 16.f); \
            dst_[ks_] = kq < 4 ? (long)(((unsigned long long)hi_ << 32) | lo_) : 0l; } } while (0)
    int tl = li, q, g, nsel; const GAS unsigned char* Kb8; const GAS unsigned char* Vb8;
    TASK(tl, q, g, nsel, Kb8, Vb8);
    long qf8[4];
    v4u kb[8][2];
#define KLDX(kg_, Kb8_) do { const GAS unsigned char* kr_ = Kb8_ + ((unsigned)Sl[(kg_) * 16 + kq] * 128u + 16u * (unsigned)lg);         kb[(kg_) & 7][0] = *(const GAS v4u*)kr_; kb[(kg_) & 7][1] = *(const GAS v4u*)(kr_ + 64); } while (0)
    {
        gci selq = SEL + (size_t)q * 256;
#pragma unroll
        for (int i = 0; i < 4; ++i) Sl[i * 64 + lane] = (i * 64 < nsel) ? selq[i * 64 + lane] : 0;
        v4u qraw[4];
#pragma unroll
        for (int ks = 0; ks < 4; ++ks) qraw[ks] = *(const GAS v4u*)(QR + (size_t)q * DM + (4 * g + (kq & 3)) * 128 + 32 * ks + 8 * lg);
        QCVT(qf8, qraw);
#pragma unroll
        for (int kg = 0; kg < 7; ++kg) KLDX(kg, Kb8);
    }
    for (;;) {
        const int tn = tl + nwx; const bool has_next = tn < 5120;
        int qn, gn, nseln; const GAS unsigned char* Kb8n; const GAS unsigned char* Vb8n;
        TASK(has_next ? tn : tl, qn, gn, nseln, Kb8n, Vb8n);
        const int nkg = nsel >> 4, nt = nkg >> 1;
#define VDMA(t_) do { LAS unsigned char* dst_ = Vt + ((t_) & 3) * 4096; \
            _Pragma("unroll") for (int i_ = 0; i_ < 4; ++i_) { const int sx_ = Sl[(2 * (t_) + (drow >> 2)) * 16 + 4 * i_ + (drow & 3)];     \
                const int n_ = dslot ^ ((4 * (i_ & 1) + (drow >> 1)) & 7);                                                         \
                __builtin_amdgcn_global_load_lds((const GAS unsigned*)(Vb8 + ((unsigned)sx_ * 128u + (unsigned)n_ * 16u)), (LAS unsigned*)(dst_ + i_ * 1024), 16, 0, 0); } } while (0)
        VDMA(0); VDMA(1); if (nt > 2) VDMA(2);
        f32x4 sc[16];
#pragma unroll
        for (int kg = 0; kg < 16; ++kg) {
            if (kg < nkg) {
                if (kg + 7 < nkg) { if (kg + 7 < 16) KLDX((kg + 7) & 15, Kb8); }
                f32x4 acc = {0.f, 0.f, 0.f, 0.f};
#pragma unroll
                for (int ks = 0; ks < 4; ++ks) { const v4u w = kb[kg & 7][ks >> 1]; const long a8 = (ks & 1) ? (long)(((unsigned long long)w.w << 32) | w.z) : (long)(((unsigned long long)w.y << 32) | w.x);
                    acc = __builtin_amdgcn_mfma_f32_16x16x32_fp8_fp8(a8, qf8[ks], acc, 0, 0, 0); }
                sc[kg] = acc;
            } else sc[kg] = (f32x4){-INFINITY, -INFINITY, -INFINITY, -INFINITY};
        }
        int selraw[4]; v4u qrawn[4];
        { gci selqn = SEL + (size_t)qn * 256;
#pragma unroll
          for (int i = 0; i < 4; ++i) selraw[i] = (i * 64 < nseln) ? selqn[i * 64 + lane] : 0;
#pragma unroll
          for (int ks = 0; ks < 4; ++ks) qrawn[ks] = *(const GAS v4u*)(QR + (size_t)qn * DM + (4 * gn + (kq & 3)) * 128 + 32 * ks + 8 * lg); }
        float mx = sc[0][0];
#pragma unroll
        for (int kg = 0; kg < 16; ++kg)
#pragma unroll
            for (int r = 0; r < 4; ++r) mx = fmaxf(mx, sc[kg][r]);
        mx = fmaxf(mx, shfl_f(mx, lane ^ 16)); mx = fmaxf(mx, shfl_f(mx, lane ^ 32));
        float sm = 0.f; unsigned pp[16];
        const float e_c = ATTN_SC2 * (1.f / 256.f), e_b = 8.f - mx * e_c;
#pragma unroll
        for (int kg = 0; kg < 16; ++kg) { float p[4];
#pragma unroll
            for (int r = 0; r < 4; ++r) { p[r] = __builtin_amdgcn_exp2f(__builtin_fmaf(sc[kg][r], e_c, e_b)); sm += p[r]; }
            pp[kg] = pk4_fp8_nc(p[0], p[1], p[2], p[3]); }
        sm += shfl_f(sm, lane ^ 16); sm += shfl_f(sm, lane ^ 32);
        f32x4 oacc[8];
#pragma unroll
        for (int n = 0; n < 8; ++n) oacc[n] = (f32x4){0.f, 0.f, 0.f, 0.f};
#define VMM(t_) do { unsigned ta_ = trbase_u + ((t_) & 3) * 4096; asm volatile("" : "+v"(ta_)); long va_[8];     \
            const long pb_ = (long)(((unsigned long long)pp[2 * (t_) + 1] << 32) | (unsigned long long)pp[2 * (t_)]); \
            _Pragma("unroll") for (int n_ = 0; n_ < 8; ++n_) asm volatile("ds_read_b64_tr_b8 %0, %1" : "=&v"(va_[n_]) : "v"(ta_ ^ (unsigned)(n_ << 4)) : "memory"); \
            asm volatile("s_waitcnt lgkmcnt(0)" ::: "memory"); __builtin_amdgcn_sched_barrier(0); \
            _Pragma("unroll") for (int n_ = 0; n_ < 8; ++n_) oacc[n_] = __builtin_amdgcn_mfma_f32_16x16x32_fp8_fp8(va_[n_], pb_, oacc[n_], 0, 0, 0); } while (0)
#define KNEXT do { _Pragma("unroll") for (int i_ = 0; i_ < 4; ++i_) Sl[i_ * 64 + lane] = selraw[i_]; QCVT(qf8, qrawn); \
            _Pragma("unroll") for (int kg_ = 0; kg_ < 7; ++kg_) KLDX(kg_, Kb8n); } while (0)
        if (nt == 2) { asm volatile("s_waitcnt vmcnt(0)" ::: "memory"); KNEXT; }
#pragma unroll
        for (int t = 0; t < 8; ++t) {
            if (t < nt) {
                if (t + 3 < nt) { VDMA(t + 3); if (t >= 3) asm volatile("s_waitcnt vmcnt(12)" ::: "memory"); }
                else if (t >= 3) {
                    if (t + 2 < nt) asm volatile("s_waitcnt vmcnt(22)" ::: "memory");
                    else if (t + 1 < nt) asm volatile("s_waitcnt vmcnt(18)" ::: "memory");
                    else asm volatile("s_waitcnt vmcnt(14)" ::: "memory");
                }
                VMM(t);
                if (t + 4 == nt) KNEXT;
            }
        }
#undef VDMA
#undef VMM
#undef KNEXT
        const float inv = 4.f / sm;
        if (kq < 4) {
#pragma unroll
            for (int n = 0; n < 8; ++n) { const f32x4 v = oacc[n] * inv;
                *(GAS unsigned*)((GAS unsigned char*)O + (size_t)q * DM + (4 * g + kq) * 128 + 16 * n + 4 * lg) = pk4_fp8(v[0], v[1], v[2], v[3]); }
        }
        if (!has_next) break;
        tl = tn; q = qn; g = gn; nsel = nseln; Kb8 = Kb8n; Vb8 = Vb8n;
    }
#undef KLDX
#undef TASK
#undef QCVT
}

constexpr int RING_BYTES = 131072, LDSCTL_OFF = 139264  , MISC_OFF = LDSCTL_OFF + 320, LDS_BYTES = 147456;
struct Args { const float* in[22]; float* out; unsigned char* ws; float inv_freq[64]; };
constexpr int NSTEP = 25;
#ifndef PH_MASK
#define PH_MASK 0x3ff
#endif
#define PHM(k) (((PH_MASK) >> (k)) & 1)
#ifndef REP_MASK
#define REP_MASK 0
#endif

#define PH_ENV \
        int tid; asm volatile("v_mbcnt_lo_u32_b32 %0, -1, 0\n\tv_mbcnt_hi_u32_b32 %0, -1, %0" : "=v"(tid)); tid += wave_s * 64; \
        const __attribute__((address_space(4))) Args* ap = (const __attribute__((address_space(4))) Args*)__builtin_amdgcn_kernarg_segment_ptr(); asm volatile("" : "+s"(ap)); \
        const int lane = tid & 63, wave = wave_s; \
        const int G = gridDim.x, bx = blockIdx.x; const int vcu = (G % 8 == 0) ? (bx % 8) * (G / 8) + bx / 8 : bx; \
        const int gt = vcu * NTHR + tid, GT = G * NTHR, gw = vcu * NWAVES + wave, NGW = G * NWAVES; \
        GAS unsigned char* ws = (GAS unsigned char*)ap->ws; gf out = (gf)ap->out; \
        gcf xp = (gcf)ap->in[0]; gcf xs = (gcf)ap->in[1]; \
        gb WMI = (gb)(ws + WS_WMI); gb WMO = (gb)(ws + WS_WMO); gb WAI = (gb)(ws + WS_WAI); gb WAO = (gb)(ws + WS_WAO); \
        gb WF1 = (gb)(ws + WS_WF1); gb WF2 = (gb)(ws + WS_WF2); \
        gb XB = (gb)(ws + WS_XB); gf XF = (gf)(ws + WS_XF); gb Y = (gb)(ws + WS_Y); gb BIG = (gb)(ws + WS_BIG); gb HB = (gb)(ws + WS_H); \
        gb KP = (gb)(ws + WS_KP); gb VP = (gb)(ws + WS_VP); gb IKP = (gb)(ws + WS_IKP); gf IW = (gf)(ws + WS_IW); gi SEL = (gi)(ws + WS_SEL); \
        gb IKS = (gb)(ws + WS_IKS); gb KS = (gb)(ws + WS_KS); gb VS = (gb)(ws + WS_VS); \
        gf SCP = (gf)(ws + WS_SCP); gf SCS = (gf)(ws + WS_SCS); gb QR = (gb)(ws + WS_QR); gb IQ = (gb)(ws + WS_IQ);
__global__ void __launch_bounds__(NTHR, 2) mega_fwd(Args args) {
    extern __shared__ __attribute__((aligned(16))) unsigned char lds[];
    LAS unsigned char* L = (LAS unsigned char*)lds;
    volatile LAS unsigned* MISC = (volatile LAS unsigned*)(L + MISC_OFF);
    for (int u = threadIdx.x; u < (LDS_BYTES - LDSCTL_OFF) / 4; u += NTHR) ((LAS unsigned*)(L + LDSCTL_OFF))[u] = 0u;
    __syncthreads();
    const int wave_s = __builtin_amdgcn_readfirstlane(threadIdx.x >> 6);
    XcdBarrier bar = xcd_barrier_post((unsigned*)((gu32*)(args.ws + WS_CTL) + CW_BAR), MISC + 8);

#pragma unroll 1
    for (int sidx = 0; sidx < NSTEP * 2; ++sidx) {
        const int pos = sidx >> 1, step = pos == 0 ? 0 : pos == 1 ? 21 : pos == 2 ? 1 : pos == 3 ? 24 : pos <= 7 ? pos - 2 : pos == 8 ? 22 : pos <= 11 ? pos - 3 : pos == 12 ? 20 : pos <= 20 ? pos - 4 : pos == 21 ? 23 : pos - 5;
        if (sidx & 1) { const int kind = (step == 0 || step == 21) ? 0 : (step == 1 || step == 3 || step == 5 || step == 9 || step == 16 || step == 22 || step == 23 || step == 24) ? 1 : (step == 7 || step == 14 || step == 18 || step == 20) ? 2 : step == 2 ? 3 : (step == 6 || step == 17) ? 4
                : (step == 4 || step == 8 || step == 15 || step == 19) ? 5 : step == 10 ? 6 : step == 11 ? 7 : step == 12 ? 8 : 9;
            if (!((REP_MASK >> kind) & 1)) continue;
#ifdef REP_STEP
            if (step != REP_STEP) continue;
#endif
        }
        if (PHM(0) && step == 0) {
            PH_ENV
            constexpr int I_MI = 32 * 96, I_MO = 32 * 32, I_AI = 32 * 84, I_AO = 32 * 32, I_F1 = 32 * 176, I_F2 = 88 * 32;
            constexpr int NITEMS = I_MI + I_MO + I_AI + I_AO + 2 * I_F1 + 2 * I_F2;
            for (int it = gw; it < NITEMS; it += NGW) {
                int r = it;
                if (r < I_MI) { absmax_item((gcf)ap->in[7], NBCV, r, lane, (GAS unsigned*)(ws + WS_CTL + 131072) + 2 * NGU, 0); continue; } r -= I_MI;
                if (r < I_MO) { transpose_item((gcf)ap->in[9], DM, DM, DM, WMO, r, lane); continue; } r -= I_MO;
                if (r < I_AI) { const int kb = r / 84, nb = r - kb * 84, k0 = 64 * kb; gcf Wa = (gcf)ap->in[10];
                    if (nb < 64) { const int n_src = (nb < 32 ? 64 * nb : 3072 + 64 * (nb - 32)) + lane; tr_col_fp8(Wa, NATT, k0, n_src, (GAS v4u*)((GAS unsigned char*)WAI + (size_t)(64 * nb + lane) * DM + k0)); }
                    else { const int nbb = nb - 64; const int n_src = (nbb < 16 ? 2048 + 64 * nbb : nbb < 18 ? 5120 + 64 * (nbb - 16) : 5248) + lane; const bool ok = nbb < 18 || (nbb == 18 && lane < 16);
                        tr_col_bf16(Wa, NATT, k0, n_src, ok, (GAS v4u*)((gb)((GAS unsigned char*)WAI + 8 * MiB) + (size_t)(64 * nbb + lane) * DM + k0)); }
                    continue; } r -= I_AI;
                if (r < I_AO) { transpose_item8((gcf)ap->in[13], DM, DM, (GAS unsigned char*)WAO, r, lane); continue; } r -= I_AO;
                if (r < 2 * I_F1) { const int l = r / I_F1; absmax_item((gcf)ap->in[14] + (size_t)l * DM * NGU, NGU, r - l * I_F1, lane, (GAS unsigned*)(ws + WS_CTL + 131072) + l * NGU, 1); continue; } r -= 2 * I_F1;
                { const int l = r / I_F2; transpose_item8((gcf)ap->in[17] + (size_t)l * DFF * DM, DFF, DM, (GAS unsigned char*)WF2 + (size_t)l * DM * DFF, r - l * I_F2, lane); }
            }
            xrows_phase(xp, xs, XB, (GAS unsigned char*)(ws + WS_XF + 20 * MiB), (gf)(ws + WS_XF + 40 * MiB), (gb)(ws + WS_XF + 41 * MiB), gw, NGW, lane);
            for (int e = gt; e < 188 * DM / 8; e += GT) *(GAS v4u*)((gb)(ws + WS_XF + 41 * MiB) + (size_t)68 * DM + (size_t)e * 8) = (v4u){0u, 0u, 0u, 0u};
        } else if (PHM(0) && step == 21) {
            PH_ENV
            constexpr int I_F1 = 32 * 176, I_MI = 32 * 96;
            for (int it = gw; it < I_MI; it += NGW) quant_item((gcf)ap->in[7], DM, NBCV, (GAS unsigned char*)WMI, (gb)(ws + WS_WF2 + 22 * MiB), (gcf)(ws + WS_CTL + 131072) + 2 * NGU, it, lane, 0);
            for (int it = gw; it < 2 * I_F1; it += NGW) { const int l = it / I_F1;
                quant_item((gcf)ap->in[14] + (size_t)l * DM * NGU, DM, NGU, (GAS unsigned char*)WF1 + (size_t)l * 44 * MiB, (gb)((GAS unsigned char*)WF1 + (size_t)l * 44 * MiB + 22 * MiB), (gcf)(ws + WS_CTL + 131072) + l * NGU, it - l * I_F1, lane, 1); }
        } else if (PHM(1) && step == 1) {
            PH_ENV
            pg8::Gemm g{(gcb)(ws + WS_XF + 20 * MiB), (gcb)WMI, MROWS, NBCV, DM / 2, 127, 127, 1}; pg8::DualOrder S; S.init(MROWS, NBCV, DM / 2, G, bx, 0);
            pg8::EpiBf16P E{BIG, NBCV, 0, (gcf)(ws + WS_XF + 40 * MiB), (gcf)(ws + WS_CTL + 131072) + 2 * NGU};
            pg8::gemm_phase<pg8::EpiBf16P, pg8::DualOrder, true, true, false, true>(L, g, S, E, tid);
        } else if (PHM(1) && (step == 5 || step == 16)) {
            PH_ENV
            const int fl = step == 16 ? 1 : 0;
            pg8::Gemm g{(gcb)(ws + WS_XF + 20 * MiB), (gcb)((const GAS unsigned char*)WF1 + (size_t)fl * 44 * MiB), MROWS, NGU, DM / 2, 127, 127, 1}; pg8::DualOrder S; S.init(MROWS, NGU, DM / 2, G, bx, 0);
#ifdef REP_KFIX
            if (step == REP_STEP && !(sidx & 1)) g.kfix = 1;
#endif

            gf FIX = (gf)((GAS unsigned char*)BIG + 64 * MiB);
            pg8::EpiConvGlu E{(GAS unsigned char*)HB, (gcf)ap->in[15] + (size_t)fl * 3 * DFF, (gcf)ap->in[16] + (size_t)fl * DFF, FIX, FIX + (size_t)320 * DFF, FIX + (size_t)640 * DFF, DFF, (gcf)(ws + WS_XF + 40 * MiB), (gcf)(ws + WS_CTL + 131072) + fl * NGU};
            pg8::gemm_phase<pg8::EpiConvGlu, pg8::DualOrder, true, true, false, true>(L, g, S, E, tid);
        } else if (PHM(1) && (step == 3 || step == 9 || step == 22 || step == 23 || step == 24)) {
            PH_ENV
            gcb A = XB; gcb Bt; int N, M = MROWS, tail = 0, c = bx, mode = 0; gb O = BIG; size_t kslab = 0;
            if (step == 3) { A = HB; Bt = WMO; N = DM; tail = 1; mode = 1; }
            else if (step == 9) { Bt = (gcb)((const GAS unsigned char*)WAI + 8 * MiB); N = 1280; c = G - 1 - bx; O = (gb)((GAS unsigned char*)BIG + 96 * MiB); }
            else if (step == 24) { A = (gcb)(ws + WS_XF + 41 * MiB); Bt = (gcb)(ws + WS_WF2 + 22 * MiB); N = 4096; M = 256; tail = 2; c = G - 1 - bx; O = (gb)(ws + WS_XF + 42 * MiB); kslab = (size_t)256 * 4096; }
            else { const int fl = step == 23 ? 1 : 0;
                A = (gcb)(ws + WS_XF + 41 * MiB); Bt = (gcb)((const GAS unsigned char*)WF1 + (size_t)fl * 44 * MiB + 22 * MiB); N = DFF; M = 256; tail = 2; c = G - 1 - bx; O = (gb)(ws + WS_XF + 42 * MiB); kslab = (size_t)256 * DFF; }
            pg8::Gemm g{A, Bt, M, N, DM, 127, 127, 0}; pg8::DualOrder S; S.init(M, N, DM, G, c, tail);
            pg8::EpiDual E{mode, O, N, Y, XB, NPROW, DM, DN_ALPHA, (gf)BIG, nullptr, nullptr, nullptr, nullptr, nullptr, nullptr, 0, nullptr, nullptr, kslab};
            pg8::gemm_phase<pg8::EpiDual, pg8::DualOrder, true, true, false, false>(L, g, S, E, tid);
            if (step == 9 && (bx < 56 || bx >= 128) && G == 256) {
                const int gt2 = (bx < 56 ? bx : bx - 72) * NTHR + tid, GT2 = 184 * NTHR;
                cvt_rows((gcf)ap->in[5], IKS, PAST * IDXD / 8, (size_t)LSK * IDXD, 32 * PAST * IDXD / 8, gt2, GT2);
                  }
        } else if (PHM(2) && (step == 7 || step == 14 || step == 18 || step == 20)) {
            PH_ENV
            gcb A = HB; gcb Bt; int K8 = DM, sa = 123;
            if (step == 7) { Bt = WF2; K8 = DFF; } else if (step == 14) { A = IQ; Bt = WAO; sa = 121; } else { Bt = (gcb)((const GAS unsigned char*)WF2 + (size_t)DM * DFF); K8 = DFF; }
            int N = DM, mode = 1;
            if (step == 20) { A = (gcb)(ws + WS_XF); Bt = WAI; N = 4096; mode = 0; K8 = DM; sa = 123; }
            pg8::Gemm g{A, Bt, MROWS, N, K8 / 2, 119, sa, 0}; pg8::DualOrder S; S.init(MROWS, N, K8 / 2, G, bx, mode);
#ifdef REP_KFIX
            if (step == REP_STEP && !(sidx & 1)) g.kfix = 1;
#endif

            pg8::EpiDual E{mode, BIG, N, Y, XB, NPROW, DM, DN_ALPHA, (gf)BIG, nullptr, nullptr, nullptr, nullptr, nullptr, nullptr, 0, nullptr, nullptr, 0};
#ifdef REP_PV
            if (step == REP_STEP && !(sidx & 1)) pg8::gemm_phase<pg8::EpiDual, pg8::DualOrder, true, true, true, false, REP_PV>(L, g, S, E, tid); else
#endif
            pg8::gemm_phase<pg8::EpiDual, pg8::DualOrder, true, true, true>(L, g, S, E, tid);
        } else if (PHM(3) && step == 2) {
            PH_ENV
            conv_mix_phase(BIG, HB, (gcf)ap->in[8], (gcf)ap->in[2], out, (gcb)(ws + WS_XF + 42 * MiB), gt, GT);
        } else if (PHM(4) && (step == 6 || step == 17)) {
            PH_ENV
            const int l = step == 6 ? 0 : 1;
            gcf FIX = (gcf)((GAS unsigned char*)BIG + 64 * MiB);
            glu_fixup_phase(FIX, FIX + (size_t)320 * DFF, FIX + (size_t)640 * DFF, (GAS unsigned char*)HB, (gcf)ap->in[15] + (size_t)l * 3 * DFF, (gcf)ap->in[16] + (size_t)l * DFF, (gcf)ap->in[6] + (size_t)l * 32 * 2 * DFF, out, (gcb)(ws + WS_XF + 42 * MiB), l, gt, GT);
        } else if (PHM(5) && (step == 4 || step == 8 || step == 15 || step == 19)) {
            PH_ENV
            gcf g_; gcf b_; gf xo = nullptr; gb xb = XB;
            if (step == 4) { g_ = (gcf)ap->in[18]; b_ = (gcf)ap->in[19]; } else if (step == 8) { g_ = (gcf)ap->in[20]; b_ = (gcf)ap->in[21]; } else if (step == 15) { g_ = (gcf)ap->in[18] + DM; b_ = (gcf)ap->in[19] + DM; }
            else { g_ = (gcf)ap->in[20] + DM; b_ = (gcf)ap->in[21] + DM; xo = out; xb = nullptr; }
            const bool ffn_next = step == 4 || step == 15;
            ln_phase(Y, (gcf)BIG, g_, b_, xo, xb, step == 8 ? (GAS unsigned char*)(ws + WS_XF) : (GAS unsigned char*)nullptr, ffn_next ? (GAS unsigned char*)(ws + WS_XF + 20 * MiB) : (GAS unsigned char*)nullptr, (gf)(ws + WS_XF + 40 * MiB), (gb)(ws + WS_XF + 41 * MiB), gw, NGW, lane);
        } else if (PHM(6) && step == 10) {
            PH_ENV
            postproj_phase(BIG, (gcb)((GAS unsigned char*)BIG + 96 * MiB), ap->inv_freq, (gcf)ap->in[11], (gcf)ap->in[12], out, QR, IQ, KP, VP, IKP, KS, VS, IKS, IW, gw, NGW, lane);
            if (G != 256) {
                cvt_rows((gcf)ap->in[5], IKS, PAST * IDXD / 8, (size_t)LSK * IDXD, 32 * PAST * IDXD / 8, gt, GT);
                }
        } else if (PHM(7) && step == 11) {
            PH_ENV
            indexer_phase(L, IQ, IW, IKP, IKS, SCP, SCS, (gcf)ap->in[3], (gcf)ap->in[4], (GAS unsigned char*)KS, (GAS unsigned char*)VS, vcu, G, tid, lane, wave);
        } else if (PHM(8) && step == 12) {
            PH_ENV
            topk_phase(L, SCP, SCS, SEL, gw, NGW, lane, wave);
        } else if (PHM(9) && step == 13) {
            PH_ENV
            attn_phase(L, QR, IQ, SEL, KP, VP, KS, VS, vcu, G, lane, wave);
        }
        if ((sidx + 1 < NSTEP * 2 - 1 || REP_MASK) && step != 20 && step != 1 && step != 5 && step != 16) {   int tb; asm volatile("v_mbcnt_lo_u32_b32 %0, -1, 0\n\tv_mbcnt_hi_u32_b32 %0, -1, %0" : "=v"(tb)); xcd_barrier(bar, tb + wave_s * 64); }
    }
}

extern "C" void kernel_launch(void* const* d_in, const int* in_sizes, int n_in, void* d_out, int out_size, void* d_ws, size_t ws_size, hipStream_t stream) {
    static int grid = 0;
    if (grid == 0) {
        if (n_in != 22 || out_size != (int)O_END || ws_size < WS_END) { fprintf(stderr, "kernel_launch: built for 22 inputs, %zu outputs, >= %zu bytes of workspace; got n_in %d, out %d, ws %zu; nothing launched\n", (size_t)O_END, (size_t)WS_END, n_in, out_size, ws_size); grid = -1; return; }
        int dev = 0, cus = 0;
        if (hipGetDevice(&dev) != hipSuccess || hipDeviceGetAttribute(&cus, hipDeviceAttributeMultiprocessorCount, dev) != hipSuccess) { fprintf(stderr, "kernel_launch: device query failed\n"); grid = -1; return; }
        if (hipFuncSetAttribute((const void*)mega_fwd, hipFuncAttributeMaxDynamicSharedMemorySize, LDS_BYTES) != hipSuccess) { fprintf(stderr, "kernel_launch: hipFuncSetAttribute failed\n"); grid = -1; return; }
        (void)hipGetLastError();
        grid = cus;
    }
    if (grid < 0) return;
    if (hipMemsetAsync((char*)d_ws + WS_CTL, 0, CTL_ZERO_BYTES, stream) != hipSuccess) { fprintf(stderr, "kernel_launch: hipMemsetAsync failed\n"); return; }
    Args a{};
    for (int i = 0; i < 22; ++i) a.in[i] = (const float*)d_in[i];
    a.out = (float*)d_out; a.ws = (unsigned char*)d_ws;
    for (int d = 0; d < 64; ++d) a.inv_freq[d] = (float)pow(10000.0, -(double)d / 64.0);
    hipLaunchKernelGGL(mega_fwd, dim3(grid), dim3(NTHR), LDS_BYTES, stream, a);
    const hipError_t le = hipPeekAtLastError();
    if (le != hipSuccess) fprintf(stderr, "kernel_launch: launch failed: %s\n", hipGetErrorName(le));
}
```

```cpp
#include <hip/hip_runtime.h>
#include <cstdio>
#include <cstdint>
#include <cmath>
namespace pg8 {
#define PG8_LAS __attribute__((address_space(3)))
typedef unsigned short bf16_t;
typedef short bf16x8 __attribute__((ext_vector_type(8)));
typedef float f32x4 __attribute__((ext_vector_type(4)));
typedef unsigned u32x4 __attribute__((ext_vector_type(4)));
constexpr int BM = 256, BK = 64, HALF = 128, HTB = HALF * BK * 2  , STAGE_BYTES = 8 * HTB, NXCD = 8, WGM = 8;

__host__ __device__ __forceinline__ int lds_byte(int r, int c) { const int st = (r >> 4) * 2 + (c >> 5), rr = r & 15, cc = c & 31, ob = rr * 64 + cc * 2; return st * 1024 + (ob ^ (((ob >> 9) & 1) << 5)); }
__host__ __device__ __forceinline__ void stage_rc(int b, int& R, int& C) { const int st = b / 1024, sb = b % 1024, swz = sb ^ (((sb >> 9) & 1) << 5); R = (st >> 1) * 16 + swz / 64; C = (st & 1) * 32 + (swz % 64) / 2; }
__host__ __device__ __forceinline__ int perm32(int rho) { const int n = rho >> 4, i = rho & 15; return 8 * (i >> 2) + 4 * n + (i & 3); }

struct Unit { int pm, pn, k0, ntk, kq; };
struct Gemm { const __attribute__((address_space(1))) bf16_t* A; const __attribute__((address_space(1))) bf16_t* Bt; int M, N, K; int sw, sa; int i8; int kfix; };

struct StaticOrder {
    int nM, nN, nwg, G, c;
    __host__ __device__ void init(int M, int N, int G_, int c_) { nM = M / BM; nN = N / BM; nwg = nM * nN; G = G_; c = c_; }
    __host__ __device__ bool next(int i, Unit& u) const {
        const long L = (long)i * G + c; if (L >= nwg) return false;
        int wgid = (int)L; { const int q = nwg / NXCD, r = nwg % NXCD, xcd = wgid % NXCD, off = wgid / NXCD; wgid = (xcd < r ? xcd * (q + 1) : r * (q + 1) + (xcd - r) * q) + off; }
        const int nig = WGM * nN, gid = wgid / nig, fm = gid * WGM, gsz = (nM - fm) < WGM ? (nM - fm) : WGM;
        u.pm = fm + ((wgid % nig) % gsz); u.pn = (wgid % nig) / gsz; u.k0 = 0; u.ntk = 0; u.kq = 0; return true;
    }
    __device__ __forceinline__ void a_ready(const Unit&) const {}
    __device__ __forceinline__ void done(const Unit&) const {}
};

struct DualOrder {
    int nM, nN, nwg, tail, G, c, qhi, qlo;
    __device__ __forceinline__ void init(int M, int N, int K, int G_, int c_, int tail_) { tail = tail_; G = G_; c = c_; { const int nt = K / BK; qhi = 2 * ((nt + 7) / 8); qlo = (nt - 2 * qhi) / 2; } nM = (tail_ == 1 ? 8192 : M) / BM; nN = N / BM; nwg = tail_ == 2 ? 0 : nM * nN; }
    __device__ __forceinline__ bool next(int i, Unit& u) const {
        const long L = (long)i * G + c; int pm = 0, pn = 0, k0 = 0, ntk = 0, kq = 0; bool ok = true;
        if (L < nwg) {
            int wgid = (int)L; { const int q = nwg / NXCD, r = nwg % NXCD, xcd = wgid % NXCD, off = wgid / NXCD; wgid = (xcd < r ? xcd * (q + 1) : r * (q + 1) + (xcd - r) * q) + off; }
            const int nig = WGM * nN, gid = wgid / nig, fm = gid * WGM, gsz = (nM - fm) < WGM ? (nM - fm) : WGM;
            pm = fm + ((wgid % nig) % gsz); pn = (wgid % nig) / gsz;
        } else if (tail == 2) {
            if (L < 2 * nN) { pn = (int)(L % nN); kq = (int)(L / nN); ntk = 16; k0 = kq * 16; } else ok = false;
        } else if (tail == 1 && L < nwg + 256) {
            const int t = (int)(L - nwg), x = t & 7, j = t >> 3; pm = 32 + (j & 7); pn = x; kq = j >> 3; ntk = kq < 2 ? qhi : qlo; k0 = kq < 2 ? kq * qhi : 2 * qhi + (kq - 2) * qlo;
        } else ok = false;
        u.pm = pm; u.pn = pn; u.k0 = k0; u.ntk = ntk; u.kq = kq; return ok;
    }
    __device__ __forceinline__ void a_ready(const Unit&) const {}
    __device__ __forceinline__ void done(const Unit&) const {}
};
}
namespace pg8 {
#define PG8_GAS __attribute__((address_space(1)))
__device__ __forceinline__ unsigned cvt_pk_bf16(float lo, float hi) { unsigned r; asm volatile("v_cvt_pk_bf16_f32 %0, %1, %2" : "=v"(r) : "v"(lo), "v"(hi)); return r; }
struct EpiBf16P {
    static constexpr bool AFTER_DRAIN = false; __device__ __forceinline__ bool perm() const { return true; }
    PG8_GAS bf16_t* O; int ldc; size_t kslab;
    const PG8_GAS float* SA; const PG8_GAS float* SWM;
    __device__ __forceinline__ void operator()(const f32x4 (&acc)[2][2][4][2], const Unit& u, int wr, int wc, int fr, int fq) const {
        const int row0 = u.pm * BM + wr * 64 + fr, col0 = u.pn * BM + wc * 32 + 8 * fq;
        f32x4 sw[2][2];
#pragma unroll
        for (int bj = 0; bj < 2; ++bj)
#pragma unroll
            for (int n = 0; n < 2; ++n) sw[bj][n] = SA ? *(const PG8_GAS f32x4*)(SWM + col0 + bj * HALF + 4 * n) * (1.f / 127.f) : (f32x4){0.f, 0.f, 0.f, 0.f};
#pragma unroll
        for (int ai = 0; ai < 2; ++ai)
#pragma unroll
            for (int m = 0; m < 4; ++m) { PG8_GAS bf16_t* rowp = O + (size_t)u.kq * kslab + (size_t)(row0 + ai * HALF + m * 16) * ldc + col0;
                const float sar = SA ? SA[row0 + ai * HALF + m * 16] : 0.f;
#pragma unroll
                for (int bj = 0; bj < 2; ++bj) { f32x4 v0 = acc[ai][bj][m][0], v1 = acc[ai][bj][m][1];
                    if (SA) {
#pragma unroll
                        for (int i = 0; i < 4; ++i) { v0[i] = (float)__float_as_int(v0[i]) * (sw[bj][0][i] * sar); v1[i] = (float)__float_as_int(v1[i]) * (sw[bj][1][i] * sar); } }
                    u32x4 w; w.x = cvt_pk_bf16(v0[0], v0[1]); w.y = cvt_pk_bf16(v0[2], v0[3]); w.z = cvt_pk_bf16(v1[0], v1[1]); w.w = cvt_pk_bf16(v1[2], v1[3]);
                    *(PG8_GAS u32x4*)(rowp + bj * HALF) = w; } }
    }
};
struct EpiF32R {
    static constexpr bool AFTER_DRAIN = false; __device__ __forceinline__ bool perm() const { return true; }
    PG8_GAS bf16_t* Y; const PG8_GAS bf16_t* X; int split; int ldc; float alpha; PG8_GAS float* P;
    __device__ __forceinline__ void operator()(const f32x4 (&acc)[2][2][4][2], const Unit& u, int wr, int wc, int fr, int fq) const {
        const int row0 = u.pm * BM + wr * 64 + fr, col0 = u.pn * BM + wc * 32 + 8 * fq;
        if (u.kq > 0) {
#pragma unroll
            for (int ai = 0; ai < 2; ++ai)
#pragma unroll
                for (int m = 0; m < 4; ++m) { PG8_GAS float* pr = P + ((size_t)(u.kq - 1) * 2048 + (size_t)(row0 + ai * HALF + m * 16 - split)) * ldc + col0;
#pragma unroll
                    for (int bj = 0; bj < 2; ++bj)
#pragma unroll
                        for (int n = 0; n < 2; ++n) *(PG8_GAS f32x4*)(pr + bj * HALF + n * 4) = acc[ai][bj][m][n]; }
            return;
        }
#pragma unroll
        for (int ai = 0; ai < 2; ++ai) {
            u32x4 xv[4][2];
#pragma unroll
            for (int m = 0; m < 4; ++m)
#pragma unroll
                for (int bj = 0; bj < 2; ++bj) xv[m][bj] = *(const PG8_GAS u32x4*)(X + (size_t)(row0 + ai * HALF + m * 16) * ldc + col0 + bj * HALF);
#pragma unroll
            for (int m = 0; m < 4; ++m)
#pragma unroll
                for (int bj = 0; bj < 2; ++bj) { const u32x4 w = xv[m][bj]; const f32x4 a0 = acc[ai][bj][m][0], a1 = acc[ai][bj][m][1];
                    u32x4 o; o.x = cvt_pk_bf16(__uint_as_float(w.x << 16) * alpha + a0[0], __uint_as_float(w.x & 0xffff0000u) * alpha + a0[1]); o.y = cvt_pk_bf16(__uint_as_float(w.y << 16) * alpha + a0[2], __uint_as_float(w.y & 0xffff0000u) * alpha + a0[3]);
                    o.z = cvt_pk_bf16(__uint_as_float(w.z << 16) * alpha + a1[0], __uint_as_float(w.z & 0xffff0000u) * alpha + a1[1]); o.w = cvt_pk_bf16(__uint_as_float(w.w << 16) * alpha + a1[2], __uint_as_float(w.w & 0xffff0000u) * alpha + a1[3]);
                    *(PG8_GAS u32x4*)(Y + (size_t)(row0 + ai * HALF + m * 16) * ldc + col0 + bj * HALF) = o; }
            asm volatile("" ::: "memory");
        }
    }
};

struct EpiConvGlu {
    static constexpr bool AFTER_DRAIN = false; __device__ __forceinline__ bool perm() const { return true; }
    PG8_GAS unsigned char* H; const PG8_GAS float* cw; const PG8_GAS float* cb; PG8_GAS float* FIXG; PG8_GAS float* FIXU; PG8_GAS float* HALO; int ldh;
    const PG8_GAS float* SA; const PG8_GAS float* SWM;
    __device__ __forceinline__ void operator()(const f32x4 (&acc)[2][2][4][2], const Unit& u, int wr, int wc, int fr, int fq) const {
        typedef unsigned u32x2 __attribute__((ext_vector_type(2)));
        const int ch0 = u.pn * 128 + wc * 32 + 8 * fq;
        float w0[8], w1[8], w2[8], bb[8];
#pragma unroll
        for (int h4 = 0; h4 < 2; ++h4) { const f32x4 a = *(const PG8_GAS f32x4*)(cw + ch0 + 4 * h4), b = *(const PG8_GAS f32x4*)(cw + ldh + ch0 + 4 * h4), c = *(const PG8_GAS f32x4*)(cw + 2 * ldh + ch0 + 4 * h4), d = *(const PG8_GAS f32x4*)(cb + ch0 + 4 * h4);
#pragma unroll
            for (int i = 0; i < 4; ++i) { w0[4 * h4 + i] = a[i]; w1[4 * h4 + i] = b[i]; w2[4 * h4 + i] = c[i]; bb[4 * h4 + i] = d[i]; } }
        float sg8[8], su8[8];
#pragma unroll
        for (int h4 = 0; h4 < 2; ++h4) { const f32x4 a = *(const PG8_GAS f32x4*)(SWM + u.pn * BM + wc * 32 + 8 * fq + 4 * h4), b = *(const PG8_GAS f32x4*)(SWM + u.pn * BM + HALF + wc * 32 + 8 * fq + 4 * h4);
#pragma unroll
            for (int i = 0; i < 4; ++i) { sg8[4 * h4 + i] = a[i] * (1.f / 127.f); su8[4 * h4 + i] = b[i] * (1.f / 127.f); } }
        const int src1 = ((fq << 4) | ((fr + 15) & 15)) << 2, src2 = ((fq << 4) | ((fr + 14) & 15)) << 2;
#pragma unroll
        for (int ai = 0; ai < 2; ++ai)
#pragma unroll
            for (int m = 0; m < 4; ++m) {
                const int row = u.pm * BM + ai * HALF + wr * 64 + m * 16 + fr; float hv[8], gvv[8], uvv[8];
                const float sar = SA[row], sam1 = m > 0 ? SA[row - 16] : 0.f;
#pragma unroll
                for (int e8 = 0; e8 < 8; ++e8) { const int n = e8 >> 2, i = e8 & 3;
                    const float gv = (float)__float_as_int(acc[ai][0][m][n][i]) * sar * sg8[e8], gp = m > 0 ? (float)__float_as_int(acc[ai][0][m > 0 ? m - 1 : 0][n][i]) * sam1 * sg8[e8] : 0.f, uv = (float)__float_as_int(acc[ai][1][m][n][i]) * sar * su8[e8];
                    const float g1 = __int_as_float(__builtin_amdgcn_update_dpp(0, __float_as_int(fr == 15 ? gp : gv), 0x121, 0xf, 0xf, false));
                    const float g2 = __int_as_float(__builtin_amdgcn_update_dpp(0, __float_as_int(fr >= 14 ? gp : gv), 0x122, 0xf, 0xf, false));
                    const float a = w0[e8] * g2 + w1[e8] * g1 + w2[e8] * gv + bb[e8];
                    const float sg = __builtin_amdgcn_rcpf(1.f + __builtin_amdgcn_exp2f(-a * 1.4426950408889634f));
                    hv[e8] = fminf(fmaxf(a * sg * uv * 16.f, -448.f), 448.f); gvv[e8] = gv; uvv[e8] = uv; }
                if (m == 0 && fr < 2) { const size_t fo = (size_t)((row >> 6) * 2 + fr) * ldh + ch0;
                    *(PG8_GAS f32x4*)(FIXG + fo) = (f32x4){gvv[0], gvv[1], gvv[2], gvv[3]}; *(PG8_GAS f32x4*)(FIXG + fo + 4) = (f32x4){gvv[4], gvv[5], gvv[6], gvv[7]};
                    *(PG8_GAS f32x4*)(FIXU + fo) = (f32x4){uvv[0], uvv[1], uvv[2], uvv[3]}; *(PG8_GAS f32x4*)(FIXU + fo + 4) = (f32x4){uvv[4], uvv[5], uvv[6], uvv[7]}; }
                else { int p0 = __builtin_amdgcn_cvt_pk_fp8_f32(hv[0], hv[1], 0, false); p0 = __builtin_amdgcn_cvt_pk_fp8_f32(hv[2], hv[3], p0, true);
                    int p1 = __builtin_amdgcn_cvt_pk_fp8_f32(hv[4], hv[5], 0, false); p1 = __builtin_amdgcn_cvt_pk_fp8_f32(hv[6], hv[7], p1, true);
                    *(PG8_GAS u32x2*)(H + (size_t)row * ldh + ch0) = (u32x2){(unsigned)p0, (unsigned)p1}; }
                if (m == 3 && fr >= 14) { const size_t ho = (size_t)((row >> 6) * 2 + fr - 14) * ldh + ch0;
                    *(PG8_GAS f32x4*)(HALO + ho) = (f32x4){gvv[0], gvv[1], gvv[2], gvv[3]}; *(PG8_GAS f32x4*)(HALO + ho + 4) = (f32x4){gvv[4], gvv[5], gvv[6], gvv[7]}; }
            }
    }
};

struct EpiDual {
    static constexpr bool AFTER_DRAIN = false;
    int mode; PG8_GAS bf16_t* O; int ldo; PG8_GAS bf16_t* Y; const PG8_GAS bf16_t* X; int split; int ldc; float alpha; PG8_GAS float* P;
    PG8_GAS unsigned char* H; const PG8_GAS float* cw; const PG8_GAS float* cb; PG8_GAS float* FIXG; PG8_GAS float* FIXU; PG8_GAS float* HALO; int ldh; const PG8_GAS float* SA; const PG8_GAS float* SWM;
    size_t kslab;
    __device__ __forceinline__ bool perm() const { return true; }
    __device__ __forceinline__ void operator()(const f32x4 (&acc)[2][2][4][2], const Unit& u, int wr, int wc, int fr, int fq) const {
        if (mode == 0) { EpiBf16P e{O, ldo, kslab, SA, SWM}; e(acc, u, wr, wc, fr, fq); } else if (mode == 1) { EpiF32R e{Y, X, split, ldc, alpha, P}; e(acc, u, wr, wc, fr, fq); }
        else { EpiConvGlu e{H, cw, cb, FIXG, FIXU, HALO, ldh, SA, SWM}; e(acc, u, wr, wc, fr, fq); }
    }
};
}
namespace pg8 {
template <class Epi, class Sched, bool ALIGN_EPI = false, bool SP2 = false, bool FP8 = false, bool I8 = false, int PV = 0>
__device__ __forceinline__ void gemm_phase(PG8_LAS unsigned char* lds, const Gemm g, const Sched& S, const Epi& E, const int tid) {
    const int wid = __builtin_amdgcn_readfirstlane(tid >> 6), lane = tid & 63, wr = wid >> 2, wc = wid & 3, fr = lane & 15, fq = lane >> 4;
    const int K = g.K, nt = K / BK;
    unsigned voffA[2], voffB[2];
#pragma unroll
    for (int i = 0; i < 2; ++i) { int R, C; stage_rc(tid * 16 + i * 8192, R, C); const int Rb = E.perm() ? ((R & ~31) + perm32(R & 31)) : R;
        voffA[i] = (unsigned)(R * K + C) * 2u; voffB[i] = (unsigned)(Rb * K + C) * 2u; }

#ifdef REP_KFIX
    const size_t kstep = g.kfix ? (size_t)0 : (size_t)(BK * 2);
#else
    const size_t kstep = (size_t)(BK * 2);
#endif
    const size_t hstep = (size_t)HALF * K * 2;
    const size_t tstep = 2 * hstep;
    const unsigned ldsw = (unsigned)wid * 1024u;
    const int aoff = lds_byte(wr * 64 + fr, fq * 8), boff = lds_byte(wc * 32 + fr, fq * 8);
#define PG8_SA(b, h) (((b) * 2 + (h)) * HTB)
#define PG8_SB(b, h) ((4 + (b) * 2 + (h)) * HTB)
#define PG8_STAGE(bufoff, gbase, voff) do { if constexpr (PV != 2) _Pragma("unroll") for (int _i = 0; _i < 2; ++_i) \
        __builtin_amdgcn_global_load_lds((const unsigned*)((const char*)(gbase) + (voff)[_i]), (PG8_LAS unsigned*)(lds + (bufoff) + ldsw + _i * 8192), 16, 0, 0); } while (0)
#define PG8_LDA(dst, b, h) do { _Pragma("unroll") for (int m = 0; m < 4; ++m) { if constexpr (FP8) { const bf16x8 lo_ = *(const PG8_LAS bf16x8*)(lds + PG8_SA(b, h) + aoff + m * 2048), hi_ = *(const PG8_LAS bf16x8*)(lds + PG8_SA(b, h) + aoff + m * 2048 + 1024); \
        dst##8[m] = __builtin_shufflevector(lo_, hi_, 0, 1, 2, 3, 4, 5, 6, 7, 8, 9, 10, 11, 12, 13, 14, 15); } else { _Pragma("unroll") for (int k = 0; k < 2; ++k) dst[m][k] = *(const PG8_LAS bf16x8*)(lds + PG8_SA(b, h) + aoff + m * 2048 + k * 1024); } } } while (0)
#define PG8_LDB(dst, b, h) do { _Pragma("unroll") for (int n = 0; n < 2; ++n) { if constexpr (FP8) { const bf16x8 lo_ = *(const PG8_LAS bf16x8*)(lds + PG8_SB(b, h) + boff + n * 2048), hi_ = *(const PG8_LAS bf16x8*)(lds + PG8_SB(b, h) + boff + n * 2048 + 1024); \
        dst##8[n] = __builtin_shufflevector(lo_, hi_, 0, 1, 2, 3, 4, 5, 6, 7, 8, 9, 10, 11, 12, 13, 14, 15); } else { _Pragma("unroll") for (int k = 0; k < 2; ++k) dst[n][k] = *(const PG8_LAS bf16x8*)(lds + PG8_SB(b, h) + boff + n * 2048 + k * 1024); } } } while (0)
#define PG8_MMA(ai, bj, At, Bt) do { __builtin_amdgcn_s_setprio(1); _Pragma("unroll") for (int m = 0; m < 4; ++m) _Pragma("unroll") for (int n = 0; n < 2; ++n) { \
        if constexpr (PV == 1) { if constexpr (FP8) asm volatile("" :: "v"(Bt##8[n]), "v"(At##8[m])); else asm volatile("" :: "v"(Bt[n][0]), "v"(At[m][0]), "v"(Bt[n][1]), "v"(At[m][1])); } else \
        if constexpr (FP8) asm volatile("v_mfma_scale_f32_16x16x128_f8f6f4 %0, %1, %2, %0, %3, %4 op_sel_hi:[0,0,0]" : "+v"(acc[ai][bj][m][n]) : "v"(__builtin_bit_cast(pg8_i32x8, Bt##8[n])), "v"(__builtin_bit_cast(pg8_i32x8, At##8[m])), "v"(swv), "v"(sav)); \
        else if constexpr (I8) { _Pragma("unroll") for (int k = 0; k < 2; ++k) asm volatile("v_mfma_i32_16x16x64_i8 %0, %1, %2, %0" : "+v"(acc[ai][bj][m][n]) : "v"(Bt[n][k]), "v"(At[m][k])); }     \
        else { _Pragma("unroll") for (int k = 0; k < 2; ++k) acc[ai][bj][m][n] = __builtin_amdgcn_mfma_f32_16x16x32_bf16(Bt[n][k], At[m][k], acc[ai][bj][m][n], 0, 0, 0); } } \
        __builtin_amdgcn_s_setprio(0); } while (0)
#define PG8_WAIT_V(n) asm volatile("s_waitcnt vmcnt(" #n ")" ::: "memory")
#define PG8_WAIT_L(n) asm volatile("s_waitcnt lgkmcnt(" #n ")" ::: "memory")
#define PG8_BAR __builtin_amdgcn_s_barrier()
#define PG8_SCHED __builtin_amdgcn_sched_barrier(0)
    Unit cur, nxt; int ui = 0;
    if (!S.next(0, cur)) return;
    int swv = g.sw, sav = g.sa; asm volatile("" : "+v"(swv), "+v"(sav));
    f32x4 acc[2][2][4][2];
#pragma unroll
    for (int a = 0; a < 2; ++a)
#pragma unroll
        for (int b = 0; b < 2; ++b)
#pragma unroll
            for (int m = 0; m < 4; ++m)
#pragma unroll
                for (int n = 0; n < 2; ++n) acc[a][b][m][n] = (f32x4){0.f, 0.f, 0.f, 0.f};
    typedef short pg8_s16x16 __attribute__((ext_vector_type(16))); typedef int pg8_i32x8 __attribute__((ext_vector_type(8)));
    bf16x8 At[4][2], B0[2][2], B1[2][2];
    pg8_s16x16 At8[4], B08[2], B18[2];
    const char* cA = (const char*)g.A + (size_t)cur.pm * tstep + (size_t)cur.k0 * kstep; const char* cB = (const char*)g.Bt + (size_t)cur.pn * tstep + (size_t)cur.k0 * kstep;
    int cnt = cur.ntk ? cur.ntk : nt;
    S.a_ready(cur);
    if constexpr (SP2) {
        PG8_STAGE(PG8_SB(0, 0), cB, voffB); PG8_STAGE(PG8_SB(0, 1), cB + hstep, voffB); PG8_STAGE(PG8_SA(0, 0), cA, voffA); PG8_STAGE(PG8_SA(0, 1), cA + hstep, voffA);
        if (wr == 1) PG8_BAR;
        PG8_WAIT_V(2); PG8_BAR;
        PG8_STAGE(PG8_SB(1, 0), cB + kstep, voffB); PG8_STAGE(PG8_SA(1, 0), cA + kstep, voffA); PG8_STAGE(PG8_SB(1, 1), cB + hstep + kstep, voffB);
        PG8_WAIT_V(6); PG8_BAR;
    } else {
        PG8_STAGE(PG8_SB(0, 0), cB, voffB); PG8_STAGE(PG8_SA(0, 0), cA, voffA); PG8_STAGE(PG8_SB(0, 1), cB + hstep, voffB); PG8_STAGE(PG8_SA(0, 1), cA + hstep, voffA);
        if (wr == 1) PG8_BAR;
        PG8_WAIT_V(4); PG8_BAR;
        PG8_STAGE(PG8_SB(1, 0), cB + kstep, voffB); PG8_STAGE(PG8_SA(1, 0), cA + kstep, voffA); PG8_STAGE(PG8_SB(1, 1), cB + hstep + kstep, voffB);
        PG8_WAIT_V(6); PG8_BAR;
    }
    for (;;) {
        const bool has_next = S.next(ui + 1, nxt);
        const char* nA = has_next ? (const char*)g.A + (size_t)nxt.pm * tstep + (size_t)nxt.k0 * kstep : cA; const char* nB = has_next ? (const char*)g.Bt + (size_t)nxt.pn * tstep + (size_t)nxt.k0 * kstep : cB;
        for (int t = 0; t < cnt; t += 2) {
            const bool last = (t == cnt - 2);
            const char* a1 = cA + (size_t)(t + 1) * kstep;
            const char* a2 = last ? nA : cA + (size_t)(t + 2) * kstep; const char* b2 = last ? nB : cB + (size_t)(t + 2) * kstep;
            const char* a3 = a2 + kstep; const char* b3 = b2 + kstep;
            if (last && has_next) S.a_ready(nxt);
            if constexpr (SP2) {
            PG8_LDB(B0, 0, 0); PG8_LDB(B1, 0, 1); PG8_SCHED; PG8_LDA(At, 0, 0); PG8_STAGE(PG8_SA(1, 1), a1 + hstep, voffA);
            PG8_WAIT_V(8); PG8_WAIT_L(0); PG8_BAR; PG8_MMA(0, 0, At, B0); PG8_MMA(0, 1, At, B1); PG8_BAR; PG8_SCHED;
            PG8_LDA(At, 0, 1); PG8_STAGE(PG8_SB(0, 0), b2, voffB); PG8_STAGE(PG8_SB(0, 1), b2 + hstep, voffB); PG8_STAGE(PG8_SA(0, 0), a2, voffA);
            PG8_WAIT_V(8); PG8_WAIT_L(0); PG8_BAR; PG8_MMA(1, 0, At, B0); PG8_MMA(1, 1, At, B1); PG8_BAR; PG8_SCHED;
            PG8_LDB(B0, 1, 0); PG8_LDB(B1, 1, 1); PG8_SCHED; PG8_LDA(At, 1, 0); PG8_STAGE(PG8_SA(0, 1), a2 + hstep, voffA);
            PG8_WAIT_V(8); PG8_WAIT_L(0); PG8_BAR; PG8_MMA(0, 0, At, B0); PG8_MMA(0, 1, At, B1); PG8_BAR; PG8_SCHED;
            PG8_LDA(At, 1, 1); PG8_STAGE(PG8_SB(1, 0), b3, voffB); PG8_STAGE(PG8_SB(1, 1), b3 + hstep, voffB); PG8_STAGE(PG8_SA(1, 0), a3, voffA);
            PG8_WAIT_V(8); PG8_WAIT_L(0); PG8_BAR; PG8_MMA(1, 0, At, B0); PG8_MMA(1, 1, At, B1); PG8_BAR; PG8_SCHED;
            } else {
            PG8_LDB(B0, 0, 0); PG8_SCHED; PG8_LDA(At, 0, 0); PG8_STAGE(PG8_SA(1, 1), a1 + hstep, voffA);
            PG8_WAIT_L(8); PG8_BAR; PG8_WAIT_L(0); PG8_MMA(0, 0, At, B0); PG8_BAR; PG8_SCHED;
            PG8_LDB(B1, 0, 1); PG8_STAGE(PG8_SB(0, 0), b2, voffB);
            PG8_BAR; PG8_WAIT_L(0); PG8_MMA(0, 1, At, B1); PG8_BAR;
            PG8_LDA(At, 0, 1); PG8_STAGE(PG8_SA(0, 0), a2, voffA);
            PG8_BAR; PG8_WAIT_L(0); PG8_MMA(1, 0, At, B0); PG8_BAR; PG8_SCHED;
            PG8_STAGE(PG8_SB(0, 1), b2 + hstep, voffB);
            PG8_WAIT_V(6); PG8_BAR; PG8_MMA(1, 1, At, B1); PG8_BAR;
            PG8_LDB(B0, 1, 0); PG8_SCHED; PG8_LDA(At, 1, 0); PG8_STAGE(PG8_SA(0, 1), a2 + hstep, voffA);
            PG8_WAIT_L(8); PG8_BAR; PG8_WAIT_L(0); PG8_MMA(0, 0, At, B0); PG8_BAR; PG8_SCHED;
            PG8_LDB(B1, 1, 1); PG8_STAGE(PG8_SB(1, 0), b3, voffB);
            PG8_BAR; PG8_WAIT_L(0); PG8_MMA(0, 1, At, B1); PG8_BAR;
            PG8_LDA(At, 1, 1); PG8_STAGE(PG8_SA(1, 0), a3, voffA);
            PG8_BAR; PG8_WAIT_L(0); PG8_MMA(1, 0, At, B0); PG8_BAR; PG8_SCHED;
            PG8_STAGE(PG8_SB(1, 1), b3 + hstep, voffB);
            PG8_WAIT_V(6); PG8_BAR; PG8_MMA(1, 1, At, B1); PG8_BAR;
            }
        }
        if constexpr (ALIGN_EPI) { if (wr == 0) PG8_BAR; }
        if constexpr (FP8 || I8) asm volatile("s_nop 15\n\ts_nop 15" ::: "memory");
        if constexpr (!Epi::AFTER_DRAIN) { int l2_; asm volatile("v_mbcnt_lo_u32_b32 %0, -1, 0\n\tv_mbcnt_hi_u32_b32 %0, -1, %0" : "=v"(l2_));
            E(acc, cur, wr, wc, l2_ & 15, l2_ >> 4); S.done(cur); }
        if (!has_next) break;
#pragma unroll
        for (int a = 0; a < 2; ++a)
#pragma unroll
            for (int b = 0; b < 2; ++b)
#pragma unroll
                for (int m = 0; m < 4; ++m)
#pragma unroll
                    for (int n = 0; n < 2; ++n) acc[a][b][m][n] = (f32x4){0.f, 0.f, 0.f, 0.f};
        cur = nxt; cA = nA; cB = nB; ++ui; cnt = cur.ntk ? cur.ntk : nt;
        if constexpr (ALIGN_EPI) { if (wr == 1) PG8_BAR; }
    }
    PG8_WAIT_V(0);
    if constexpr (!ALIGN_EPI) { if (wr == 0) PG8_BAR; }
    PG8_BAR;
    if constexpr (Epi::AFTER_DRAIN) { E.fused(acc, cur, wr, wc, fr, fq, lds, wid, lane); S.done(cur); }
#undef PG8_SA
#undef PG8_SB
#undef PG8_STAGE
#undef PG8_LDA
#undef PG8_LDB
#undef PG8_MMA
#undef PG8_WAIT_V
#undef PG8_WAIT_L
#undef PG8_BAR
#undef PG8_SCHED
}
}
#define GAS __attribute__((address_space(1)))
#define LAS __attribute__((address_space(3)))
typedef unsigned short bf16;
typedef unsigned v4u __attribute__((ext_vector_type(4)));
typedef float f32x4 __attribute__((ext_vector_type(4)));
typedef short bf16x8 __attribute__((ext_vector_type(8)));
typedef GAS unsigned gu32;
typedef GAS unsigned long long gu64;
#define RLX_AGENT __ATOMIC_RELAXED, __HIP_MEMORY_SCOPE_AGENT
#define LDS_WAIT() asm volatile("s_waitcnt lgkmcnt(0)" ::: "memory")
#define VM_WAIT() asm volatile("s_waitcnt vmcnt(0)" ::: "memory")
__device__ __forceinline__ unsigned long long rt() { return __builtin_amdgcn_s_memrealtime(); }
__device__ __forceinline__ unsigned f2bf(float f) { unsigned u = __builtin_bit_cast(unsigned, f); return (u + 0x7fffu + ((u >> 16) & 1u)) >> 16; }
__device__ __forceinline__ unsigned pk2(float lo, float hi) { return f2bf(lo) | (f2bf(hi) << 16); }
#define XB_TMO      128
#define XB_XCNT(j)  (256  + 64 * (j))
#define XB_XSUB(j)  (1280 + 64 * (j))
#define XB_XGEN(j)  (2304 + 64 * (j))
#define XB_TOP      3328
#define XB_TOPGEN   3392
#define XCD_BAR_WORDS 3456
#define XB_SPIN_CAP (1u << 18)

__device__ __forceinline__ unsigned xb_ld(unsigned* p)              { return __hip_atomic_load(p, __ATOMIC_RELAXED, __HIP_MEMORY_SCOPE_AGENT); }
__device__ __forceinline__ unsigned xb_add(unsigned* p, unsigned v) { return __hip_atomic_fetch_add(p, v, __ATOMIC_RELAXED, __HIP_MEMORY_SCOPE_AGENT); }
__device__ __forceinline__ unsigned xb_xcc_id() { return (unsigned)__builtin_amdgcn_s_getreg((3 << 11) | 20) & 0xFu; }
#define XB_SPIN(cond, bar) do { unsigned _sp = 0; while (cond) { __builtin_amdgcn_s_sleep(1); \
    if ((++_sp & 255u) == 0u) { if (xb_ld(&(bar)[XB_TMO])) break; if (_sp > XB_SPIN_CAP) { atomicAdd(&(bar)[XB_TMO], 1u); break; } } } } while (0)

struct XcdBarrier {
    unsigned* bar; unsigned x;
    volatile LAS unsigned* st;
};

__device__ __forceinline__ XcdBarrier xcd_barrier_post(unsigned* bar, volatile LAS unsigned* st) {
    XcdBarrier b; b.bar = bar; b.x = xb_xcc_id(); b.st = st;
    if (threadIdx.x == 0) (void)xb_add(&bar[XB_XCNT(b.x)], 1u);
    return b;
}
__device__ __forceinline__ void xcd_barrier_complete(unsigned* bar, unsigned x, unsigned& nloc, unsigned& nx) {
    const unsigned G = gridDim.x * gridDim.y * gridDim.z;
    unsigned sum, cnt, mine, sp = 0u;
    for (;;) {
        sum = 0u; cnt = 0u; mine = 0u;
#pragma unroll
        for (unsigned j = 0; j < 16; ++j) { const unsigned c = xb_ld(&bar[XB_XCNT(j)]); sum += c; cnt += (c > 0u) ? 1u : 0u; mine = (j == x) ? c : mine; }
        if (sum == G) break;
        __builtin_amdgcn_s_sleep(1);
        if ((++sp & 255u) == 0u) { if (xb_ld(&bar[XB_TMO])) break; if (sp > XB_SPIN_CAP) { atomicAdd(&bar[XB_TMO], 1u); break; } }
    }
    nloc = mine > 0u ? mine : 1u; nx = cnt > 0u ? cnt : 1u;
}

__device__ __forceinline__ void xcd_barrier(const XcdBarrier& b, const int tid_) {
    asm volatile("s_waitcnt vmcnt(0)" ::: "memory");
    __syncthreads();
    if (tid_ == 0) {
        unsigned* bar = b.bar;
        __builtin_amdgcn_s_waitcnt(0);
        unsigned nloc = b.st[0], nx = b.st[1];
        if (nloc == 0u) { xcd_barrier_complete(bar, b.x, nloc, nx); b.st[0] = nloc; b.st[1] = nx; }
        const unsigned old = xb_add(&bar[XB_XSUB(b.x)], 1u);
        const unsigned gen = old / nloc;
        if (old + 1u == (gen + 1u) * nloc) {
            __builtin_amdgcn_fence(__ATOMIC_RELEASE, "agent");
            asm volatile("s_waitcnt vmcnt(0)" ::: "memory");
            const unsigned og = xb_add(&bar[XB_TOP], 1u);
            const unsigned tg = og / nx;
            if (og + 1u == (tg + 1u) * nx) xb_add(&bar[XB_TOPGEN], 1u);
            else XB_SPIN(xb_ld(&bar[XB_TOPGEN]) == tg, bar);
            __builtin_amdgcn_fence(__ATOMIC_ACQUIRE, "agent");
            xb_add(&bar[XB_XGEN(b.x)], 1u);
            asm volatile("s_waitcnt vmcnt(0)" ::: "memory");
        } else {
            XB_SPIN(xb_ld(&bar[XB_XGEN(b.x)]) == gen, bar);
            __builtin_amdgcn_fence(__ATOMIC_ACQUIRE, "agent");
            asm volatile("s_waitcnt vmcnt(0)" ::: "memory");
        }
    }
    __syncthreads();
}

constexpr int NWAVES = 8, NTHR = 512;
constexpr int DM = 2048, NPROW = 8192, MROWS = 10240, SEQ = 4096, DSEQ = 64, PAST = 2048, LSK = 2112, DFF = 5632;
constexpr int NBCV = 6144, NGU = 11264, NPROJ = 5376, NATT = 5264, KVW = 512, IDXD = 128;
constexpr int SCS_LD = 2304;
constexpr float LN_EPS = 1e-5f, DN_ALPHA = 1.4142135623730951f, ATTN_SC2 = 0.08838834764831845f * 1.4426950408889634f, IDX_W_SCALE = 0.022097086912079608f;
constexpr size_t O_YP = 0, O_YS = 16777216, O_CMP = 20971520, O_KP = 20979712, O_VP = 25174016, O_IKP = 29368320, O_FCP = 30416896,
                 O_CMS = 30461952, O_KS = 30593024, O_VS = 31641600, O_IKS = 32690176, O_FCS = 32952320, O_END = 33673216;
constexpr size_t MiB = 1u << 20;
constexpr size_t WS_CTL = 0, CTL_ZERO_BYTES = 1 * MiB;
constexpr size_t WS_WMI = 1 * MiB, WS_WMO = 25 * MiB, WS_WAI = 33 * MiB, WS_WAO = 54 * MiB, WS_WF1 = 62 * MiB, WS_WF2 = 150 * MiB;
constexpr size_t WF1_STRIDE = 44 * MiB, WF2_STRIDE = 22 * MiB;
constexpr size_t WS_XB = 194 * MiB, WS_XF = 234 * MiB  , WS_Y = 314 * MiB, WS_BIG = 394 * MiB, WS_H = 614 * MiB, WS_END = 724 * MiB;
constexpr size_t WS_KP = 1 * MiB, WS_VP = 9 * MiB, WS_IKP = 17 * MiB, WS_IW = 19 * MiB, WS_SEL = 20 * MiB;
constexpr size_t WS_IKS = 62 * MiB;
constexpr size_t WS_KS = 314 * MiB;
constexpr size_t WS_PROJ = 394 * MiB, WS_SCP = 394 * MiB, WS_SCS = 522 * MiB, WS_VS = 548 * MiB;
constexpr size_t WS_QR = 614 * MiB, WS_IQ = 654 * MiB;
constexpr int CW_BAR = 4096;

typedef const GAS float* gcf; typedef GAS float* gf; typedef const GAS bf16* gcb; typedef GAS bf16* gb; typedef const GAS int* gci; typedef GAS int* gi;
typedef float f32x16 __attribute__((ext_vector_type(16)));
typedef float f32x2 __attribute__((ext_vector_type(2)));
__device__ __forceinline__ float bflo(unsigned w) { return __uint_as_float(w << 16); }
__device__ __forceinline__ float bfhi(unsigned w) { return __uint_as_float(w & 0xffff0000u); }
__device__ __forceinline__ float bf1(bf16 h) { return __uint_as_float((unsigned)h << 16); }
__device__ __forceinline__ void unpack8(const v4u w, float (&f)[8]) { f[0] = bflo(w.x); f[1] = bfhi(w.x); f[2] = bflo(w.y); f[3] = bfhi(w.y); f[4] = bflo(w.z); f[5] = bfhi(w.z); f[6] = bflo(w.w); f[7] = bfhi(w.w); }
__device__ __forceinline__ v4u pack8(const float (&f)[8]) { v4u o; o.x = pk2(f[0], f[1]); o.y = pk2(f[2], f[3]); o.z = pk2(f[4], f[5]); o.w = pk2(f[6], f[7]); return o; }
__device__ __forceinline__ void ldf8(gcf p, float (&f)[8]) { const f32x4 a = *(const GAS f32x4*)p, b = *(const GAS f32x4*)(p + 4); f[0] = a.x; f[1] = a.y; f[2] = a.z; f[3] = a.w; f[4] = b.x; f[5] = b.y; f[6] = b.z; f[7] = b.w; }
__device__ __forceinline__ void stf8(gf p, const float (&f)[8]) { *(GAS f32x4*)p = (f32x4){f[0], f[1], f[2], f[3]}; *(GAS f32x4*)(p + 4) = (f32x4){f[4], f[5], f[6], f[7]}; }
__device__ __forceinline__ unsigned pk4_fp8(float a, float b, float c, float d) {
    a = fminf(fmaxf(a, -448.f), 448.f); b = fminf(fmaxf(b, -448.f), 448.f); c = fminf(fmaxf(c, -448.f), 448.f); d = fminf(fmaxf(d, -448.f), 448.f);
    int w = __builtin_amdgcn_cvt_pk_fp8_f32(a, b, 0, false); w = __builtin_amdgcn_cvt_pk_fp8_f32(c, d, w, true); return (unsigned)w; }
__device__ __forceinline__ unsigned pk4_fp8_nc(float a, float b, float c, float d) {
    int w = __builtin_amdgcn_cvt_pk_fp8_f32(a, b, 0, false); w = __builtin_amdgcn_cvt_pk_fp8_f32(c, d, w, true); return (unsigned)w; }
__device__ __forceinline__ unsigned pk4_i8(float a, float b, float c, float d) {
    const int ia = (int)__builtin_rintf(a), ib = (int)__builtin_rintf(b), ic = (int)__builtin_rintf(c), id = (int)__builtin_rintf(d);
    return (unsigned)(ia & 0xff) | ((unsigned)(ib & 0xff) << 8) | ((unsigned)(ic & 0xff) << 16) | ((unsigned)id << 24); }
__device__ __forceinline__ float shfl_f(float v, int src) { return __int_as_float(__builtin_amdgcn_ds_bpermute(src << 2, __float_as_int(v))); }
__device__ __forceinline__ float wave_sum(float v, int lane) {
#pragma unroll
    for (int o = 1; o < 64; o <<= 1) v += shfl_f(v, lane ^ o);
    return v;
}
__device__ __forceinline__ int wave_sum_i(int v, int lane) {
#pragma unroll
    for (int o = 1; o < 64; o <<= 1) v += __builtin_amdgcn_ds_bpermute((lane ^ o) << 2, v);
    return v;
}

__device__ __forceinline__ void tr_col_bf16(gcf W, int N, int k0, int n_src, bool ok, GAS v4u* dst) {
    float v[64]; const int nc = ok ? n_src : 0;
#pragma unroll
    for (int j = 0; j < 64; ++j) v[j] = (W + (size_t)(k0 + j) * N)[nc];
#pragma unroll
    for (int c = 0; c < 8; ++c) { v4u o; o.x = pk2(v[8 * c], v[8 * c + 1]); o.y = pk2(v[8 * c + 2], v[8 * c + 3]); o.z = pk2(v[8 * c + 4], v[8 * c + 5]); o.w = pk2(v[8 * c + 6], v[8 * c + 7]);
        if (!ok) o = (v4u){0u, 0u, 0u, 0u}; dst[c] = o; }
}
__device__ __forceinline__ void tr_col_fp8(gcf W, int N, int k0, int n_src, GAS v4u* dst) {
    float v[64];
#pragma unroll
    for (int j = 0; j < 64; ++j) v[j] = (W + (size_t)(k0 + j) * N)[n_src] * 256.f;
#pragma unroll
    for (int c = 0; c < 4; ++c) { v4u o; o.x = pk4_fp8(v[16 * c], v[16 * c + 1], v[16 * c + 2], v[16 * c + 3]); o.y = pk4_fp8(v[16 * c + 4], v[16 * c + 5], v[16 * c + 6], v[16 * c + 7]);
        o.z = pk4_fp8(v[16 * c + 8], v[16 * c + 9], v[16 * c + 10], v[16 * c + 11]); o.w = pk4_fp8(v[16 * c + 12], v[16 * c + 13], v[16 * c + 14], v[16 * c + 15]); dst[c] = o; }
}
__device__ __forceinline__ void absmax_item(gcf W, int N, int item, int lane, GAS unsigned* SWMbits, int glu) {
    const int nblk = N / 64, kb = item / nblk, nb = item - kb * nblk, k0 = 64 * kb, n = 64 * nb + lane;
    float v[64]; float mx = 0.f;
#pragma unroll
    for (int j = 0; j < 64; ++j) v[j] = (W + (size_t)(k0 + j) * N)[n];
#pragma unroll
    for (int j = 0; j < 64; ++j) mx = fmaxf(mx, fabsf(v[j]));
    int no = n; if (glu) { const int up = n >= N / 2, c = up ? n - N / 2 : n; no = 256 * (c >> 7) + (c & 127) + (up ? 128 : 0); }
    __hip_atomic_fetch_max(SWMbits + no, __float_as_uint(mx), __ATOMIC_RELAXED, __HIP_MEMORY_SCOPE_AGENT);
}
__device__ __forceinline__ void quant_item(gcf W, int K, int N, GAS unsigned char* WI, gb WG, gcf SWM, int item, int lane, int glu) {
    const int nblk = N / 64, kb = item / nblk, nb = item - kb * nblk, k0 = 64 * kb, n = 64 * nb + lane;
    int up, c, no; if (glu) { up = n >= N / 2; c = up ? n - N / 2 : n; no = 256 * (c >> 7) + (c & 127) + (up ? 128 : 0); } else { up = n < 2048; c = n - 2048; no = n; }
    float v[64];
#pragma unroll
    for (int j = 0; j < 64; ++j) v[j] = (W + (size_t)(k0 + j) * N)[n];
    const float mx = SWM[no], inv = mx > 0.f ? 127.f / mx : 0.f;
    GAS v4u* dst = (GAS v4u*)(WI + (size_t)no * K + k0);
#pragma unroll
    for (int q = 0; q < 4; ++q) { v4u o; o.x = pk4_i8(v[16 * q] * inv, v[16 * q + 1] * inv, v[16 * q + 2] * inv, v[16 * q + 3] * inv); o.y = pk4_i8(v[16 * q + 4] * inv, v[16 * q + 5] * inv, v[16 * q + 6] * inv, v[16 * q + 7] * inv);
        o.z = pk4_i8(v[16 * q + 8] * inv, v[16 * q + 9] * inv, v[16 * q + 10] * inv, v[16 * q + 11] * inv); o.w = pk4_i8(v[16 * q + 12] * inv, v[16 * q + 13] * inv, v[16 * q + 14] * inv, v[16 * q + 15] * inv); dst[q] = o; }
    if (!up) { GAS v4u* dg = (GAS v4u*)(WG + (size_t)c * K + k0);
#pragma unroll
        for (int q = 0; q < 8; ++q) { v4u o; o.x = pk2(v[8 * q], v[8 * q + 1]); o.y = pk2(v[8 * q + 2], v[8 * q + 3]); o.z = pk2(v[8 * q + 4], v[8 * q + 5]); o.w = pk2(v[8 * q + 6], v[8 * q + 7]); dg[q] = o; } }
}
__device__ __forceinline__ void ld_col64(gcf W, int N, int k0, int n, float (&v)[64]) {
#pragma unroll
    for (int j = 0; j < 64; ++j) v[j] = (W + (size_t)(k0 + j) * N)[n];
}
__device__ __forceinline__ void use_col_fp8(const float (&v)[64], GAS v4u* dst) {
#pragma unroll
    for (int c = 0; c < 4; ++c) { v4u o; o.x = pk4_fp8(v[16 * c] * 256.f, v[16 * c + 1] * 256.f, v[16 * c + 2] * 256.f, v[16 * c + 3] * 256.f); o.y = pk4_fp8(v[16 * c + 4] * 256.f, v[16 * c + 5] * 256.f, v[16 * c + 6] * 256.f, v[16 * c + 7] * 256.f);
        o.z = pk4_fp8(v[16 * c + 8] * 256.f, v[16 * c + 9] * 256.f, v[16 * c + 10] * 256.f, v[16 * c + 11] * 256.f); o.w = pk4_fp8(v[16 * c + 12] * 256.f, v[16 * c + 13] * 256.f, v[16 * c + 14] * 256.f, v[16 * c + 15] * 256.f); dst[c] = o; }
}
__device__ __forceinline__ void use_col_quant(const float (&v)[64], float mx, GAS v4u* dst, bool copy, GAS v4u* dg) {
    const float inv = mx > 0.f ? 127.f / mx : 0.f;
#pragma unroll
    for (int q = 0; q < 4; ++q) { v4u o; o.x = pk4_i8(v[16 * q] * inv, v[16 * q + 1] * inv, v[16 * q + 2] * inv, v[16 * q + 3] * inv); o.y = pk4_i8(v[16 * q + 4] * inv, v[16 * q + 5] * inv, v[16 * q + 6] * inv, v[16 * q + 7] * inv);
        o.z = pk4_i8(v[16 * q + 8] * inv, v[16 * q + 9] * inv, v[16 * q + 10] * inv, v[16 * q + 11] * inv); o.w = pk4_i8(v[16 * q + 12] * inv, v[16 * q + 13] * inv, v[16 * q + 14] * inv, v[16 * q + 15] * inv); dst[q] = o; }
    if (copy) {
#pragma unroll
        for (int q = 0; q < 8; ++q) { v4u o; o.x = pk2(v[8 * q], v[8 * q + 1]); o.y = pk2(v[8 * q + 2], v[8 * q + 3]); o.z = pk2(v[8 * q + 4], v[8 * q + 5]); o.w = pk2(v[8 * q + 6], v[8 * q + 7]); dg[q] = o; } }
}
__device__ __forceinline__ void transpose_item(gcf W, int K, int N, int Npad, gb WT, int item, int lane, int glu = 0) {
    const int nblk = Npad / 64, kb = item / nblk, nb = item - kb * nblk, k0 = 64 * kb, n = 64 * nb + lane;
    int no = n; if (glu) { const int up = n >= N / 2, c = up ? n - N / 2 : n; no = 256 * (c >> 7) + (c & 127) + (up ? 128 : 0); }
    tr_col_bf16(W, N, k0, n, n < N, (GAS v4u*)(WT + (size_t)no * K + k0));
}
__device__ __forceinline__ void transpose_item8(gcf W, int K, int N, GAS unsigned char* WT, int item, int lane) {
    const int nblk = N / 64, kb = item / nblk, nb = item - kb * nblk, k0 = 64 * kb, n = 64 * nb + lane;
    tr_col_fp8(W, N, k0, n, (GAS v4u*)(WT + (size_t)n * K + k0));
}
__device__ __forceinline__ void cvt_rows(gcf src, gb dst, int cps, size_t dstride, int total, int gt, int GT) {
    for (int e = gt; e < total; e += GT) { const int sb = e / cps, rem = e - sb * cps; float f[8]; ldf8(src + (size_t)e * 8, f); *(GAS v4u*)(dst + (size_t)sb * dstride + (size_t)rem * 8) = pack8(f); }
}

__device__ __forceinline__ int kperm(int d) { return (d & 64) | ((d & 24) << 1) | ((d & 32) >> 2) | (d & 7); }
__device__ __forceinline__ void cvt_rows_k8(gcf src, GAS unsigned char* dst, int cps, size_t dstride, int total, int gt, int GT) {
    typedef unsigned u32x2t __attribute__((ext_vector_type(2)));
    for (int e = gt; e < total; e += GT) { const int sb = e / cps, rem = e - sb * cps; const int row = rem >> 6, c = rem & 63; float f[8]; ldf8(src + (size_t)e * 8, f);
        *(GAS u32x2t*)(dst + (size_t)sb * dstride + ((size_t)(c >> 4) * LSK + row) * 128 + kperm((c & 15) * 8)) = (u32x2t){pk4_fp8(f[0] * 16.f, f[1] * 16.f, f[2] * 16.f, f[3] * 16.f), pk4_fp8(f[4] * 16.f, f[5] * 16.f, f[6] * 16.f, f[7] * 16.f)}; }
}

__device__ __forceinline__ void cvt_rows_v8(gcf src, GAS unsigned char* dst, int cps, size_t dstride, int total, int gt, int GT) {
    typedef unsigned u32x2t __attribute__((ext_vector_type(2)));
    for (int e = gt; e < total; e += GT) { const int sb = e / cps, rem = e - sb * cps; const int row = rem >> 6, c = rem & 63; float f[8]; ldf8(src + (size_t)e * 8, f);
        *(GAS u32x2t*)(dst + (size_t)sb * dstride + ((size_t)(c >> 4) * LSK + row) * 128 + (c & 15) * 8) = (u32x2t){pk4_fp8(f[0] * 16.f, f[1] * 16.f, f[2] * 16.f, f[3] * 16.f), pk4_fp8(f[4] * 16.f, f[5] * 16.f, f[6] * 16.f, f[7] * 16.f)}; }
}

__device__ __forceinline__ void xrows_phase(gcf xp, gcf xs, gb XB, GAS unsigned char* XI, gf SA, gb XS, int gw, int NGW, int lane) {
    for (int row = gw; row < MROWS; row += NGW) {
        gcf xr = row < NPROW ? xp + (size_t)row * DM : xs + (size_t)(row - NPROW) * DM; float v[4][8]; float amax = 0.f;
#pragma unroll
        for (int j = 0; j < 4; ++j) { ldf8(xr + 8 * lane + 512 * j, v[j]);
#pragma unroll
            for (int e = 0; e < 8; ++e) amax = fmaxf(amax, fabsf(v[j][e])); }
#pragma unroll
        for (int o_ = 1; o_ < 64; o_ <<= 1) amax = fmaxf(amax, shfl_f(amax, lane ^ o_));
        const float inv = amax > 0.f ? 127.f / amax : 0.f; typedef unsigned u32x2t __attribute__((ext_vector_type(2)));
        const bool is_s = row >= NPROW; const int t = is_s ? ((row - NPROW) & 63) : (row & 4095), T = is_s ? DSEQ : SEQ;
        const int srow = (is_s ? 4 + ((row - NPROW) >> 6) * 2 : (row >> 12) * 2) + (t - (T - 2));
#pragma unroll
        for (int j = 0; j < 4; ++j) { const v4u pb = pack8(v[j]); *(GAS v4u*)(XB + (size_t)row * DM + 8 * lane + 512 * j) = pb;
            *(GAS u32x2t*)(XI + (size_t)row * DM + 8 * lane + 512 * j) = (u32x2t){pk4_i8(v[j][0] * inv, v[j][1] * inv, v[j][2] * inv, v[j][3] * inv), pk4_i8(v[j][4] * inv, v[j][5] * inv, v[j][6] * inv, v[j][7] * inv)};
            if (t >= T - 2) *(GAS v4u*)(XS + (size_t)srow * DM + 8 * lane + 512 * j) = pb; }
        if (lane == 0) SA[row] = amax * (1.f / 127.f);
    }
}

__device__ __forceinline__ void conv_mix_phase(gcb BCV, gb Z, gcf cw, gcf state, gf out, gcb GS, int gt, int GT) {
    for (int task = gt; task < (MROWS / 16) * 256; task += GT) {
        const int cg = task & 255, seg = task >> 8, row0 = seg * 16, c0 = cg * 8;
        const bool is_s = row0 >= NPROW; const int tl = is_s ? ((row0 - NPROW) & 63) : (row0 & 4095); const int sb = is_s ? ((row0 - NPROW) >> 6) : (row0 >> 12); const int T = is_s ? DSEQ : SEQ;
        float w0[8], w1[8], w2[8]; ldf8(cw + c0, w0); ldf8(cw + DM + c0, w1); ldf8(cw + 2 * DM + c0, w2);
        float um2[8], um1[8];
        if (tl == 0) {
            if (is_s) { ldf8(state + (size_t)(sb * 2 + 0) * DM + c0, um2); ldf8(state + (size_t)(sb * 2 + 1) * DM + c0, um1); }
            else {
#pragma unroll
                for (int e = 0; e < 8; ++e) { um2[e] = 0.f; um1[e] = 0.f; } }
        } else {
            float c8[8], v8[8];
            gcb p2 = BCV + (size_t)(row0 - 2) * NBCV + c0; unpack8(*(const GAS v4u*)(p2 + DM), c8); unpack8(*(const GAS v4u*)(p2 + 2 * DM), v8);
#pragma unroll
            for (int e = 0; e < 8; ++e) um2[e] = c8[e] * v8[e];
            gcb p1 = p2 + NBCV; unpack8(*(const GAS v4u*)(p1 + DM), c8); unpack8(*(const GAS v4u*)(p1 + 2 * DM), v8);
#pragma unroll
            for (int e = 0; e < 8; ++e) um1[e] = c8[e] * v8[e];
        }
#pragma unroll 4
        for (int r = 0; r < 16; ++r) {
            const int row = row0 + r; gcb p = BCV + (size_t)row * NBCV + c0;
            float b8[8], c8[8], v8[8], u[8], z[8];
            unpack8(*(const GAS v4u*)p, b8); unpack8(*(const GAS v4u*)(p + DM), c8); unpack8(*(const GAS v4u*)(p + 2 * DM), v8);
#pragma unroll
            for (int e = 0; e < 8; ++e) { u[e] = c8[e] * v8[e]; z[e] = b8[e] * (w0[e] * um2[e] + w1[e] * um1[e] + w2[e] * u[e]); }
            *(GAS v4u*)(Z + (size_t)row * DM + c0) = pack8(z);
            const int j = tl + r - (T - 2);
            if (j >= 0) { const int srow = (is_s ? 4 + sb * 2 : sb * 2) + j; float ca[8], cb_[8], va[8], vb[8], us[8];
                unpack8(*(const GAS v4u*)(GS + (size_t)srow * 4096 + c0), ca); unpack8(*(const GAS v4u*)(GS + (size_t)(256 + srow) * 4096 + c0), cb_);
                unpack8(*(const GAS v4u*)(GS + (size_t)srow * 4096 + 2048 + c0), va); unpack8(*(const GAS v4u*)(GS + (size_t)(256 + srow) * 4096 + 2048 + c0), vb);
#pragma unroll
                for (int e = 0; e < 8; ++e) us[e] = (ca[e] + cb_[e]) * (va[e] + vb[e]);
                stf8(out + (is_s ? O_CMS : O_CMP) + (size_t)(sb * 2 + j) * DM + c0, us); }
#pragma unroll
            for (int e = 0; e < 8; ++e) { um2[e] = um1[e]; um1[e] = u[e]; }
        }
    }
}
__device__ __forceinline__ void glu_fixup_phase(gcf FIXG, gcf FIXU, gcf HALO, GAS unsigned char* H, gcf cw, gcf cb, gcf state, gf out, gcb GS, int layer, int gt, int GT) {
    constexpr int NCG = DFF / 8;
    for (int task = gt; task < 320 * NCG; task += GT) {
        const int rid = task / NCG, cg = task - rid * NCG, bk = rid >> 1, j = rid & 1, c0 = cg * 8, row = 64 * bk + j;
        const bool is_s = bk >= 128; const int sb = is_s ? bk - 128 : bk >> 6; const bool seq_start = is_s || (bk & 63) == 0, seq_end = is_s || (bk & 63) == 63;
        float w0[8], w1[8], w2[8], bb[8], g0[8], u0[8], h1[8], h0[8];
        ldf8(cw + c0, w0); ldf8(cw + DFF + c0, w1); ldf8(cw + 2 * DFF + c0, w2); ldf8(cb + c0, bb); ldf8(FIXG + (size_t)rid * DFF + c0, g0); ldf8(FIXU + (size_t)rid * DFF + c0, u0);
        if (seq_start) { if (is_s) { ldf8(state + (size_t)(sb * 2 + 0) * DFF + c0, h0); ldf8(state + (size_t)(sb * 2 + 1) * DFF + c0, h1); } else {
#pragma unroll
            for (int e = 0; e < 8; ++e) { h0[e] = 0.f; h1[e] = 0.f; } } }
        else { ldf8(HALO + (size_t)((bk - 1) * 2 + 0) * DFF + c0, h0); ldf8(HALO + (size_t)((bk - 1) * 2 + 1) * DFF + c0, h1); }
        float g1[8], g2[8];
        if (j == 0) {
#pragma unroll
            for (int e = 0; e < 8; ++e) { g1[e] = h1[e]; g2[e] = h0[e]; } }
        else { ldf8(FIXG + (size_t)(bk * 2) * DFF + c0, g1);
#pragma unroll
            for (int e = 0; e < 8; ++e) g2[e] = h1[e]; }
        float h[8];
#pragma unroll
        for (int e = 0; e < 8; ++e) { const float a = w0[e] * g2[e] + w1[e] * g1[e] + w2[e] * g0[e] + bb[e];
            const float sg = __builtin_amdgcn_rcpf(1.f + __builtin_amdgcn_exp2f(-a * 1.4426950408889634f)); h[e] = a * sg * u0[e] * 16.f; }
        { typedef unsigned u32x2t __attribute__((ext_vector_type(2)));
          *(GAS u32x2t*)(H + (size_t)row * DFF + c0) = (u32x2t){pk4_fp8(h[0], h[1], h[2], h[3]), pk4_fp8(h[4], h[5], h[6], h[7])}; }
        if (seq_end) { float s8[8], t8[8]; const int srow = (is_s ? 4 + sb * 2 : sb * 2) + j;
            unpack8(*(const GAS v4u*)(GS + (size_t)srow * DFF + c0), s8); unpack8(*(const GAS v4u*)(GS + (size_t)(256 + srow) * DFF + c0), t8);
#pragma unroll
            for (int e = 0; e < 8; ++e) s8[e] += t8[e];
            stf8(out + (is_s ? O_FCS + (size_t)((layer * 32 + sb) * 2 + j) * DFF : O_FCP + (size_t)((layer * 2 + sb) * 2 + j) * DFF) + c0, s8); }
    }
}
__device__ __forceinline__ void ln_phase(gcb Y, gcf P, gcf g, gcf b, gf XF, gb XB, GAS unsigned char* X8, GAS unsigned char* XI, gf SA, gb XS, int gw, int NGW, int lane) {
    for (int row = gw; row < MROWS; row += NGW) {
        float v[4][8]; float s = 0.f;
#pragma unroll
        for (int j = 0; j < 4; ++j) unpack8(*(const GAS v4u*)(Y + (size_t)row * DM + 8 * lane + 512 * j), v[j]);
        if (row >= NPROW) {
#pragma unroll
            for (int q = 0; q < 3; ++q) { gcf pr = P + ((size_t)q * 2048 + (size_t)(row - NPROW)) * DM + 8 * lane;
#pragma unroll
                for (int j = 0; j < 4; ++j) { float t[8]; ldf8(pr + 512 * j, t);
#pragma unroll
                    for (int e = 0; e < 8; ++e) v[j][e] += t[e]; } }
        }
#pragma unroll
        for (int j = 0; j < 4; ++j)
#pragma unroll
            for (int e = 0; e < 8; ++e) s += v[j][e];
        const float mean = wave_sum(s, lane) * (1.f / DM); float s2 = 0.f;
#pragma unroll
        for (int j = 0; j < 4; ++j)
#pragma unroll
            for (int e = 0; e < 8; ++e) { v[j][e] -= mean; s2 += v[j][e] * v[j][e]; }
        const float rstd = 1.f / sqrtf(wave_sum(s2, lane) * (1.f / DM) + LN_EPS);
        float amax = 0.f;
#pragma unroll
        for (int j = 0; j < 4; ++j) { float g8[8], b8[8], o[8]; ldf8(g + 8 * lane + 512 * j, g8); ldf8(b + 8 * lane + 512 * j, b8);
#pragma unroll
            for (int e = 0; e < 8; ++e) { o[e] = v[j][e] * rstd * g8[e] + b8[e]; v[j][e] = o[e]; amax = fmaxf(amax, fabsf(o[e])); }
            if (XF) stf8(XF + (size_t)row * DM + 8 * lane + 512 * j, o);
            if (XB) *(GAS v4u*)(XB + (size_t)row * DM + 8 * lane + 512 * j) = pack8(o);
            if (X8) { typedef unsigned u32x2t __attribute__((ext_vector_type(2))); *(GAS u32x2t*)(X8 + (size_t)row * DM + 8 * lane + 512 * j) = (u32x2t){pk4_fp8(o[0] * 16.f, o[1] * 16.f, o[2] * 16.f, o[3] * 16.f), pk4_fp8(o[4] * 16.f, o[5] * 16.f, o[6] * 16.f, o[7] * 16.f)}; } }
        if (XI) {
#pragma unroll
            for (int o_ = 1; o_ < 64; o_ <<= 1) amax = fmaxf(amax, shfl_f(amax, lane ^ o_));
            const float inv = amax > 0.f ? 127.f / amax : 0.f; typedef unsigned u32x2t __attribute__((ext_vector_type(2)));
#pragma unroll
            for (int j = 0; j < 4; ++j) *(GAS u32x2t*)(XI + (size_t)row * DM + 8 * lane + 512 * j) = (u32x2t){pk4_i8(v[j][0] * inv, v[j][1] * inv, v[j][2] * inv, v[j][3] * inv), pk4_i8(v[j][4] * inv, v[j][5] * inv, v[j][6] * inv, v[j][7] * inv)};
            if (lane == 0) SA[row] = amax * (1.f / 127.f);
            const bool is_s = row >= NPROW; const int t = is_s ? ((row - NPROW) & 63) : (row & 4095), T = is_s ? DSEQ : SEQ;
            if (t >= T - 2) { const int srow = (is_s ? 4 + ((row - NPROW) >> 6) * 2 : (row >> 12) * 2) + (t - (T - 2));
#pragma unroll
                for (int j = 0; j < 4; ++j) *(GAS v4u*)(XS + (size_t)srow * DM + 8 * lane + 512 * j) = pack8(v[j]); }
        }
    }
}

__device__ __forceinline__ void postproj_phase(gcb PQ, gcb PK, const __attribute__((address_space(4))) float* inv_freq, gcf kng, gcf knb, gf out,
                                               gb QR, gb IQ, gb KP, gb VP, gb IKP, gb KS, gb VS, gb IKS, gf IW, int gw, int NGW, int lane) {
    typedef unsigned u32x2t __attribute__((ext_vector_type(2)));
    const int c = lane & 7, hh = lane >> 3, d0 = 8 * c;
    float invf[8], g1[8], g2[8], bb1[8], bb2[8];
#pragma unroll
    for (int e = 0; e < 8; ++e) { invf[e] = inv_freq[d0 + e]; g1[e] = kng[d0 + e]; g2[e] = kng[64 + d0 + e]; bb1[e] = knb[d0 + e]; bb2[e] = knb[64 + d0 + e]; }
    for (int row = gw; row < MROWS; row += NGW) {
        const bool is_s = row >= NPROW; const int sb = is_s ? ((row - NPROW) >> 6) : (row >> 12); const int t = is_s ? ((row - NPROW) & 63) : (row & 4095);
        const int pos = is_s ? PAST + t : t;
        float cs[8], sn[8];
#pragma unroll
        for (int e = 0; e < 8; ++e) { const float ang = (float)pos * invf[e];
            const double rev = (double)ang * 0.15915494309189535; const float fr = (float)(rev - __builtin_rint(rev));
            cs[e] = __builtin_amdgcn_cosf(fr); sn[e] = __builtin_amdgcn_sinf(fr); }
        gcb Pq = PQ + (size_t)row * 4096; gcb P = PK + (size_t)row * 1280;
        gb qo = QR + (size_t)row * DM; gb iqo = IQ + (size_t)row * DM;
#pragma unroll
        for (int p = 0; p < 2; ++p) { const int h = 8 * p + hh;
            float x1[8], x2[8], y1[8], y2[8], o1[8], o2[8];
            unpack8(*(const GAS v4u*)(Pq + h * 128 + d0), x1); unpack8(*(const GAS v4u*)(Pq + h * 128 + 64 + d0), x2);
            unpack8(*(const GAS v4u*)(Pq + 2048 + h * 128 + d0), y1); unpack8(*(const GAS v4u*)(Pq + 2048 + h * 128 + 64 + d0), y2);
#pragma unroll
            for (int e = 0; e < 8; ++e) { o1[e] = x1[e] * cs[e] - x2[e] * sn[e]; o2[e] = x1[e] * sn[e] + x2[e] * cs[e]; }
            *(GAS v4u*)(qo + h * 128 + d0) = pack8(o1); *(GAS v4u*)(qo + h * 128 + 64 + d0) = pack8(o2);
#pragma unroll
            for (int e = 0; e < 8; ++e) { o1[e] = y1[e] * cs[e] - y2[e] * sn[e]; o2[e] = y1[e] * sn[e] + y2[e] * cs[e]; }
            *(GAS v4u*)(iqo + h * 128 + d0) = pack8(o1); *(GAS v4u*)(iqo + h * 128 + 64 + d0) = pack8(o2);
        }
        gf kof = out + (is_s ? O_KS + (size_t)(row - NPROW) * KVW : O_KP + (size_t)row * KVW);
        gf vof = out + (is_s ? O_VS + (size_t)(row - NPROW) * KVW : O_VP + (size_t)row * KVW);
        GAS unsigned char* kob = is_s ? (GAS unsigned char*)KS + ((size_t)sb * 4 * LSK + PAST + t) * 128 : (GAS unsigned char*)KP + ((size_t)sb * 4 * SEQ + t) * 128;
        GAS unsigned char* vob = is_s ? (GAS unsigned char*)VS + ((size_t)sb * 4 * LSK + PAST + t) * 128 : (GAS unsigned char*)VP + ((size_t)sb * 4 * SEQ + t) * 128;
        const size_t gstr = (size_t)(is_s ? LSK : SEQ) * 128;
        if (hh < 4) { const int g = hh;
            float x1[8], x2[8], o1[8], o2[8];
            unpack8(*(const GAS v4u*)(P + g * 128 + d0), x1); unpack8(*(const GAS v4u*)(P + g * 128 + 64 + d0), x2);
#pragma unroll
            for (int e = 0; e < 8; ++e) { o1[e] = x1[e] * cs[e] - x2[e] * sn[e]; o2[e] = x1[e] * sn[e] + x2[e] * cs[e]; }
            stf8(kof + g * 128 + d0, o1); stf8(kof + g * 128 + 64 + d0, o2);
            *(GAS u32x2t*)(kob + g * gstr + kperm(d0)) = (u32x2t){pk4_fp8(o1[0] * 16.f, o1[1] * 16.f, o1[2] * 16.f, o1[3] * 16.f), pk4_fp8(o1[4] * 16.f, o1[5] * 16.f, o1[6] * 16.f, o1[7] * 16.f)};
            *(GAS u32x2t*)(kob + g * gstr + kperm(64 + d0)) = (u32x2t){pk4_fp8(o2[0] * 16.f, o2[1] * 16.f, o2[2] * 16.f, o2[3] * 16.f), pk4_fp8(o2[4] * 16.f, o2[5] * 16.f, o2[6] * 16.f, o2[7] * 16.f)};
        }
        { float vf[8]; unpack8(*(const GAS v4u*)(P + 512 + 8 * lane), vf); stf8(vof + 8 * lane, vf);
          *(GAS u32x2t*)(vob + (size_t)(lane >> 4) * gstr + ((8 * lane) & 127)) = (u32x2t){pk4_fp8(vf[0] * 16.f, vf[1] * 16.f, vf[2] * 16.f, vf[3] * 16.f), pk4_fp8(vf[4] * 16.f, vf[5] * 16.f, vf[6] * 16.f, vf[7] * 16.f)}; }
        {
            float x1[8], x2[8]; float s = 0.f;
            if (hh == 0) { unpack8(*(const GAS v4u*)(P + 1024 + d0), x1); unpack8(*(const GAS v4u*)(P + 1024 + 64 + d0), x2); }
            else {
#pragma unroll
                for (int e = 0; e < 8; ++e) { x1[e] = 0.f; x2[e] = 0.f; } }
#pragma unroll
            for (int e = 0; e < 8; ++e) s += x1[e] + x2[e];
            const float mean = wave_sum(s, lane) * (1.f / 128.f); float s2 = 0.f;
#pragma unroll
            for (int e = 0; e < 8; ++e) { x1[e] -= mean; x2[e] -= mean; s2 += x1[e] * x1[e] + x2[e] * x2[e]; }
            if (hh != 0) s2 = 0.f;
            const float rstd = 1.f / sqrtf(wave_sum(s2, lane) * (1.f / 128.f) + LN_EPS);
            if (hh == 0) {
                float o1[8], o2[8];
#pragma unroll
                for (int e = 0; e < 8; ++e) { const float n1 = x1[e] * rstd * g1[e] + bb1[e], n2 = x2[e] * rstd * g2[e] + bb2[e]; o1[e] = n1 * cs[e] - n2 * sn[e]; o2[e] = n1 * sn[e] + n2 * cs[e]; }
                gf iof = out + (is_s ? O_IKS + (size_t)(row - NPROW) * IDXD : O_IKP + (size_t)row * IDXD);
                gb iob = is_s ? IKS + ((size_t)sb * LSK + PAST + t) * IDXD : IKP + (size_t)row * IDXD;
                stf8(iof + d0, o1); stf8(iof + 64 + d0, o2); *(GAS v4u*)(iob + d0) = pack8(o1); *(GAS v4u*)(iob + 64 + d0) = pack8(o2);
            }
        }
        if (lane < 16) IW[(size_t)row * 16 + lane] = bf1(P[1152 + lane]) * IDX_W_SCALE;
    }
}

__device__ __forceinline__ void indexer_phase(LAS unsigned char* L, gcb IQ, gcf IW, gcb IKP, gcb IKS, gf SCP, gf SCS,
                                              int vcu, int G, int tid, int lane, int wave) {
    const int r32 = lane & 31, hi = lane >> 5;
    for (int u = vcu; u < 1376; u += G) {
        int qrow0, kt, scld; gcb IKb; gf scb;
        if (u < 1088) { const int b = u / 544; int r = u - b * 544; int gq = 0; while (r >= 4 * (gq + 1)) { r -= 4 * (gq + 1); ++gq; }
            const int c = 4 * gq + r / (gq + 1); kt = r % (gq + 1); qrow0 = b * SEQ + 64 * c; IKb = IKP + (size_t)b * SEQ * IDXD; scb = SCP + (size_t)qrow0 * SEQ; scld = SEQ; }
        else { const int us = u - 1088; const int sb = us / 9; kt = us - sb * 9; qrow0 = NPROW + 64 * sb; IKb = IKS + (size_t)sb * LSK * IDXD; scb = SCS + (size_t)(64 * sb) * SCS_LD; scld = SCS_LD; }
        const int key0 = kt * 256 + 32 * wave;
        pg8::bf16x8 a[8];
#pragma unroll
        for (int ks = 0; ks < 8; ++ks) a[ks] = *(const GAS pg8::bf16x8*)(IKb + (size_t)(key0 + r32) * IDXD + 16 * ks + 8 * hi);
        f32x16 I0, I1;
#pragma unroll
        for (int r = 0; r < 16; ++r) { I0[r] = 0.f; I1[r] = 0.f; }
        const int sq = tid >> 3, sc0 = tid & 7;
        gcb iqsrc = IQ + (size_t)(qrow0 + sq) * DM + sc0 * 8;
        const unsigned wofs0 = (unsigned)(sq * 256 + ((sc0 ^ (sq & 15)) * 16)), wofs1 = (unsigned)(sq * 256 + (((sc0 + 8) ^ (sq & 15)) * 16));
        gcf iw0 = IW + (size_t)(qrow0 + r32) * 16; gcf iw1 = iw0 + 32 * 16;
        v4u se0 = *(const GAS v4u*)iqsrc, se1 = *(const GAS v4u*)(iqsrc + 64), so0 = *(const GAS v4u*)(iqsrc + 128), so1 = *(const GAS v4u*)(iqsrc + 128 + 64);
        float wn0 = iw0[0], wn1 = iw1[0];
        *(LAS v4u*)(L + wofs0) = se0; *(LAS v4u*)(L + wofs1) = se1;
        const unsigned rofs = (unsigned)(r32 * 256), rx = (unsigned)(r32 & 15);
#define IDX_HEAD(h_, LDNEXT, STNEXT) do { __syncthreads(); const float wc0_ = wn0, wc1_ = wn1; LDNEXT; if ((h_) < 15) { wn0 = iw0[(h_) + 1]; wn1 = iw1[(h_) + 1]; } \
            LAS unsigned char* buf_ = L + ((h_) & 1) * 16384; f32x16 S0_, S1_; _Pragma("unroll") for (int r_ = 0; r_ < 16; ++r_) { S0_[r_] = 0.f; S1_[r_] = 0.f; } \
            _Pragma("unroll") for (int ks_ = 0; ks_ < 8; ++ks_) { const unsigned co_ = (((unsigned)(2 * ks_ + hi)) ^ rx) * 16u; \
                const pg8::bf16x8 b0_ = *(const LAS pg8::bf16x8*)(buf_ + rofs + co_), b1_ = *(const LAS pg8::bf16x8*)(buf_ + 8192 + rofs + co_); \
                S0_ = __builtin_amdgcn_mfma_f32_32x32x16_bf16(a[ks_], b0_, S0_, 0, 0, 0); S1_ = __builtin_amdgcn_mfma_f32_32x32x16_bf16(a[ks_], b1_, S1_, 0, 0, 0); } \
            _Pragma("unroll") for (int r_ = 0; r_ < 16; ++r_) { I0[r_] += wc0_ * fmaxf(S0_[r_], 0.f); I1[r_] += wc1_ * fmaxf(S1_[r_], 0.f); } \
            STNEXT; } while (0)
#pragma unroll 1
        for (int h = 0; h < 16; h += 2) {
            IDX_HEAD(h, if (h + 2 < 16) { se0 = *(const GAS v4u*)(iqsrc + (h + 2) * 128); se1 = *(const GAS v4u*)(iqsrc + (h + 2) * 128 + 64); },
                     { LAS unsigned char* nb_ = L + 16384; *(LAS v4u*)(nb_ + wofs0) = so0; *(LAS v4u*)(nb_ + wofs1) = so1; });
            IDX_HEAD(h + 1, if (h + 3 < 16) { so0 = *(const GAS v4u*)(iqsrc + (h + 3) * 128); so1 = *(const GAS v4u*)(iqsrc + (h + 3) * 128 + 64); },
                     if (h + 2 < 16) { *(LAS v4u*)(L + wofs0) = se0; *(LAS v4u*)(L + wofs1) = se1; });
        }
#undef IDX_HEAD
#pragma unroll
        for (int j = 0; j < 4; ++j) {
            *(GAS f32x4*)(scb + (size_t)r32 * scld + key0 + 8 * j + 4 * hi) = (f32x4){I0[4 * j], I0[4 * j + 1], I0[4 * j + 2], I0[4 * j + 3]};
            *(GAS f32x4*)(scb + (size_t)(32 + r32) * scld + key0 + 8 * j + 4 * hi) = (f32x4){I1[4 * j], I1[4 * j + 1], I1[4 * j + 2], I1[4 * j + 3]};
        }
        __syncthreads();
    }
}

__device__ __forceinline__ void topk_phase(LAS unsigned char* L, gcf SCP, gcf SCS, gi SEL, gcf Wf1, gcf SWM1, GAS unsigned char* WI1, gb WG1, gcf Wf2, GAS unsigned char* WT2, int gw, int NGW, int lane, int wave) {
    constexpr int RA_F1 = 32 * 176, RA_F2 = 88 * 32;
#define RA_LOAD(it_, v_) do { const int r_ = (it_); if (r_ < RA_F1) { const int kb_ = r_ / 176, nb_ = r_ - kb_ * 176; ld_col64(Wf1, NGU, 64 * kb_, 64 * nb_ + lane, v_); } \
        else if (r_ < RA_F1 + RA_F2) { const int r2_ = r_ - RA_F1, kb_ = r2_ >> 5, nb_ = r2_ & 31; ld_col64(Wf2, DM, 64 * kb_, 64 * nb_ + lane, v_); } } while (0)
#define RA_USE(it_, v_) do { const int r_ = (it_); if (r_ < RA_F1) { const int kb_ = r_ / 176, nb_ = r_ - kb_ * 176, k0_ = 64 * kb_, n_ = 64 * nb_ + lane; \
            const int up_ = n_ >= NGU / 2, c_ = up_ ? n_ - NGU / 2 : n_, no_ = 256 * (c_ >> 7) + (c_ & 127) + (up_ ? 128 : 0); \
            use_col_quant(v_, SWM1[no_], (GAS v4u*)(WI1 + (size_t)no_ * DM + k0_), !up_, (GAS v4u*)(WG1 + (size_t)c_ * DM + k0_)); } \
        else if (r_ < RA_F1 + RA_F2) { const int r2_ = r_ - RA_F1, kb_ = r2_ >> 5, nb_ = r2_ & 31; use_col_fp8(v_, (GAS v4u*)(WT2 + (size_t)(64 * nb_ + lane) * DFF + 64 * kb_)); } } while (0)
    float wv[64];
    typedef unsigned u32x4t __attribute__((ext_vector_type(4)));
    LAS unsigned* hist = (LAS unsigned*)(L + wave * 17408);
#define TK_ROW(q0_, q_, Lk_, src_) do { q_ = ((q0_) < NPROW && ((q0_) & 2048)) ? (((q0_) & ~4095) | (4095 - ((q0_) & 2047))) : (q0_); \
        if (q_ < NPROW) { const int t_ = q_ & 4095; Lk_ = ((t_ >> 6) + 1) * 64; src_ = SCP + (size_t)q_ * SEQ; } else { Lk_ = LSK; src_ = SCS + (size_t)(q_ - NPROW) * SCS_LD; } } while (0)
#define TK_LOAD(Lk_, src_) do { const int nv_ = (Lk_) >> 6; _Pragma("unroll") for (int gI_ = 0; gI_ < 8; ++gI_) if (nv_ > gI_ * 8) { \
        _Pragma("unroll") for (int i_ = gI_ * 8; i_ < gI_ * 8 + 8; ++i_) raw[i_] = __float_as_uint((src_)[i_ < nv_ ? i_ * 64 + lane : 0]); } } while (0)
    unsigned raw[64];
    if (gw < MROWS) { int q_, Lk_; gcf src_; TK_ROW(gw, q_, Lk_, src_); if (Lk_ > 256) TK_LOAD(Lk_, src_); }
    for (int q0 = gw; q0 < MROWS; q0 += NGW) {
        int q, Lk; gcf src; TK_ROW(q0, q, Lk, src);
        gi selq = SEL + (size_t)q * 256;
        const int nv = Lk >> 6;
        unsigned key[64];
        if (Lk > 256) {
#pragma unroll
            for (int i = 0; i < 64; ++i) { const unsigned ub = raw[i]; key[i] = i < nv ? ((ub & 0x80000000u) ? ~ub : (ub | 0x80000000u)) : 0u; }
        }
        if (q0 + NGW < MROWS) { int qn_, Lkn_; gcf srcn_; TK_ROW(q0 + NGW, qn_, Lkn_, srcn_); if (Lkn_ > 256) TK_LOAD(Lkn_, srcn_); }
        RA_LOAD(q0, wv);
        if (Lk <= 256) { for (int i = lane; i < Lk; i += 64) selq[i] = i; RA_USE(q0, wv); continue; }
        unsigned prefix = 0u; int need = 256;
#pragma unroll 1
        for (int pass = 0; pass < 4; ++pass) {
            const int sh = 24 - 8 * pass; const unsigned himask = pass == 0 ? 0u : (0xffffffffu << (sh + 8));
            *(LAS u32x4t*)(hist + 4 * lane) = (u32x4t){0u, 0u, 0u, 0u};
#pragma unroll
            for (int gI = 0; gI < 8; ++gI) if (nv > gI * 8) {
#pragma unroll
                for (int i = gI * 8; i < gI * 8 + 8; ++i) { const unsigned k = key[i];
                    const bool hit = k != 0u && ((k ^ prefix) & himask) == 0u;
                    if (pass < 2 || __ballot(hit) != 0ull)
                        __hip_atomic_fetch_add(hist + (hit ? ((k >> sh) & 255u) : 256u + (unsigned)lane), 1u, __ATOMIC_RELAXED, __HIP_MEMORY_SCOPE_WORKGROUP); }
            }
            const u32x4t h4 = *(const LAS u32x4t*)(hist + 4 * lane);
            const int s = (int)(h4.x + h4.y + h4.z + h4.w); int S = s;
#pragma unroll
            for (int off = 1; off < 64; off <<= 1) { const int t = __builtin_amdgcn_ds_bpermute(((lane + off) & 63) << 2, S); if (lane + off < 64) S += t; }
            const int above = S - s;
            const bool here = above < need && need <= S;
            int c = above, d = -1, nn = 0;
            { const int hb[4] = {(int)h4.x, (int)h4.y, (int)h4.z, (int)h4.w};
#pragma unroll
              for (int b = 3; b >= 0; --b) { if (d < 0) { if (c + hb[b] >= need) { d = b; nn = need - c; } else c += hb[b]; } } }
            const unsigned long long bal = __ballot(here);
            const int fl = __builtin_amdgcn_readfirstlane(bal ? __ffsll((long long)bal) - 1 : 0);
            const int digit = __builtin_amdgcn_readlane(4 * lane + d, fl);
            need = __builtin_amdgcn_readlane(nn, fl);
            prefix |= ((unsigned)digit & 255u) << sh;
        }
        int cge = 0, ceq = 0;
#pragma unroll
        for (int gI = 0; gI < 8; ++gI) if (nv > gI * 8) {
#pragma unroll
            for (int i = gI * 8; i < gI * 8 + 8; ++i) { cge += key[i] >= prefix ? 1 : 0; ceq += key[i] == prefix ? 1 : 0; }
        }
        const int eq_total = wave_sum_i(ceq, lane);
        if (eq_total == need) {
            int S = cge;
#pragma unroll
            for (int off = 1; off < 64; off <<= 1) { const int t = __builtin_amdgcn_ds_bpermute(((lane - off) & 63) << 2, S); if (lane >= off) S += t; }
            int pos = S - cge;
            LAS int* lst = (LAS int*)(hist + 512);
#pragma unroll
            for (int gI = 0; gI < 8; ++gI) if (nv > gI * 8) {
#pragma unroll
                for (int i = gI * 8; i < gI * 8 + 8; ++i) { const bool take = key[i] >= prefix; lst[take && pos < 256 ? pos : 256 + lane] = i * 64 + lane; pos += take ? 1 : 0; }
            }
#pragma unroll
            for (int i = 0; i < 4; ++i) selq[i * 64 + lane] = lst[i * 64 + lane];
        } else {
            int base = 0, eqtaken = 0;
#pragma unroll
            for (int gI = 0; gI < 8; ++gI) if (nv > gI * 8) {
#pragma unroll
                for (int i = gI * 8; i < gI * 8 + 8; ++i) {
                    const bool gtb = key[i] > prefix, eqb = key[i] == prefix;
                    const unsigned long long be = __ballot(eqb);
                    const int eqrank = eqtaken + (int)__builtin_amdgcn_mbcnt_hi((unsigned)(be >> 32), __builtin_amdgcn_mbcnt_lo((unsigned)be, 0u));
                    const bool take = gtb || (eqb && eqrank < need);
                    const unsigned long long bt = __ballot(take);
                    const int pos = base + (int)__builtin_amdgcn_mbcnt_hi((unsigned)(bt >> 32), __builtin_amdgcn_mbcnt_lo((unsigned)bt, 0u));
                    if (take && pos < 256) selq[pos] = i * 64 + lane;
                    base += __popcll(bt); eqtaken += __popcll(be);
                }
            }
        }
        RA_USE(q0, wv);
    }
}

#undef RA_LOAD
#undef RA_USE
#undef TK_ROW
#undef TK_LOAD
constexpr int ATT_WAVE_LDS = 17408;
__device__ __forceinline__ void attn_phase(LAS unsigned char* L, gcb QR, gb O, gci SEL, gcb KP, gcb VP, gcb KS, gcb VS, int vcu, int G, int lane, int wave) {
    const int kq = lane & 15, lg = lane >> 4;
    LAS unsigned char* Vt = L + wave * ATT_WAVE_LDS;
    LAS int* Sl = (LAS int*)(L + wave * ATT_WAVE_LDS + 16384);
    const int trrow = 8 * lg + (kq >> 1), trx = (trrow >> 1) & 7;
    const unsigned trbase_u = (unsigned)(uintptr_t)(Vt + trrow * 128 + 8 * (kq & 1)) | (unsigned)(trx << 4);
    const int drow = lane >> 3, dslot = lane & 7;
    const int cpx = G >> 3, x = cpx ? vcu / cpx : 8, li = cpx ? (vcu - x * cpx) * NWAVES + wave : 0, nwx = cpx * NWAVES;
    if (x >= 8 || li >= 5120) return;
#define TASK(tl_, q_, g_, nsel_, Kb8_, Vb8_) do { if ((tl_) < 4096) { const int b_ = x >> 2, t_ = (tl_); g_ = x & 3; q_ = b_ * SEQ + t_; const int Lk_ = ((t_ >> 6) + 1) * 64; nsel_ = Lk_ < 256 ? Lk_ : 256; \
            Kb8_ = (const GAS unsigned char*)KP + (size_t)(b_ * 4 + g_) * SEQ * 128; Vb8_ = (const GAS unsigned char*)VP + (size_t)(b_ * 4 + g_) * SEQ * 128; } \
        else { const int s_ = (tl_) - 4096, c_ = x * 16 + (s_ >> 6), sb_ = c_ >> 2; g_ = c_ & 3; q_ = NPROW + sb_ * 64 + (s_ & 63); nsel_ = 256; \
            Kb8_ = (const GAS unsigned char*)KS + (size_t)(sb_ * 4 + g_) * LSK * 128; Vb8_ = (const GAS unsigned char*)VS + (size_t)(sb_ * 4 + g_) * LSK * 128; } } while (0)
#define QCVT(dst_, raw_) do { _Pragma("unroll") for (int ks_ = 0; ks_ < 4; ++ks_) { float f_[8]; unpack8(raw_[ks_], f_); \
            const unsigned lo_ = pk4_fp8(f_[0] * 16.f, f_[1] * 16.f, f_[2] * 16.f, f_[3] * 16.f), hi_ = pk4_fp8(f_[4] * 16.f, f_[5] * 16.f, f_[6] * 16.f, f_[7] * 16.f); \
            dst_[ks_] = kq < 4 ? (long)(((unsigned long long)hi_ << 32) | lo_) : 0l; } } while (0)
    int tl = li, q, g, nsel; const GAS unsigned char* Kb8; const GAS unsigned char* Vb8;
    TASK(tl, q, g, nsel, Kb8, Vb8);
    long qf8[4];
    v4u kb[8][2];
#define KLDX(kg_, Kb8_) do { const GAS unsigned char* kr_ = Kb8_ + ((unsigned)Sl[(kg_) * 16 + kq] * 128u + 16u * (unsigned)lg);         kb[(kg_) & 7][0] = *(const GAS v4u*)kr_; kb[(kg_) & 7][1] = *(const GAS v4u*)(kr_ + 64); } while (0)
    {
        gci selq = SEL + (size_t)q * 256;
#pragma unroll
        for (int i = 0; i < 4; ++i) Sl[i * 64 + lane] = (i * 64 < nsel) ? selq[i * 64 + lane] : 0;
        v4u qraw[4];
#pragma unroll
        for (int ks = 0; ks < 4; ++ks) qraw[ks] = *(const GAS v4u*)(QR + (size_t)q * DM + (4 * g + (kq & 3)) * 128 + 32 * ks + 8 * lg);
        QCVT(qf8, qraw);
#pragma unroll
        for (int kg = 0; kg < 7; ++kg) KLDX(kg, Kb8);
    }
    for (;;) {
        const int tn = tl + nwx; const bool has_next = tn < 5120;
        int qn, gn, nseln; const GAS unsigned char* Kb8n; const GAS unsigned char* Vb8n;
        TASK(has_next ? tn : tl, qn, gn, nseln, Kb8n, Vb8n);
        const int nkg = nsel >> 4, nt = nkg >> 1;
#define VDMA(t_) do { LAS unsigned char* dst_ = Vt + ((t_) & 3) * 4096; \
            _Pragma("unroll") for (int i_ = 0; i_ < 4; ++i_) { const int sx_ = Sl[(2 * (t_) + (drow >> 2)) * 16 + 4 * i_ + (drow & 3)];     \
                const int n_ = dslot ^ ((4 * (i_ & 1) + (drow >> 1)) & 7);                                                         \
                __builtin_amdgcn_global_load_lds((const GAS unsigned*)(Vb8 + ((unsigned)sx_ * 128u + (unsigned)n_ * 16u)), (LAS unsigned*)(dst_ + i_ * 1024), 16, 0, 0); } } while (0)
        VDMA(0); VDMA(1); if (nt > 2) VDMA(2);
        f32x4 sc[16];
#pragma unroll
        for (int kg = 0; kg < 16; ++kg) {
            if (kg < nkg) {
                if (kg + 7 < nkg) { if (kg + 7 < 16) KLDX((kg + 7) & 15, Kb8); }
                f32x4 acc = {0.f, 0.f, 0.f, 0.f};
#pragma unroll
                for (int ks = 0; ks < 4; ++ks) { const v4u w = kb[kg & 7][ks >> 1]; const long a8 = (ks & 1) ? (long)(((unsigned long long)w.w << 32) | w.z) : (long)(((unsigned long long)w.y << 32) | w.x);
                    acc = __builtin_amdgcn_mfma_f32_16x16x32_fp8_fp8(a8, qf8[ks], acc, 0, 0, 0); }
                sc[kg] = acc;
            } else sc[kg] = (f32x4){-INFINITY, -INFINITY, -INFINITY, -INFINITY};
        }
        int selraw[4]; v4u qrawn[4];
        { gci selqn = SEL + (size_t)qn * 256;
#pragma unroll
          for (int i = 0; i < 4; ++i) selraw[i] = (i * 64 < nseln) ? selqn[i * 64 + lane] : 0;
#pragma unroll
          for (int ks = 0; ks < 4; ++ks) qrawn[ks] = *(const GAS v4u*)(QR + (size_t)qn * DM + (4 * gn + (kq & 3)) * 128 + 32 * ks + 8 * lg); }
        float mx = sc[0][0];
#pragma unroll
        for (int kg = 0; kg < 16; ++kg)
#pragma unroll
            for (int r = 0; r < 4; ++r) mx = fmaxf(mx, sc[kg][r]);
        mx = fmaxf(mx, shfl_f(mx, lane ^ 16)); mx = fmaxf(mx, shfl_f(mx, lane ^ 32));
        float sm = 0.f; unsigned pp[16];
        const float e_c = ATTN_SC2 * (1.f / 256.f), e_b = 8.f - mx * e_c;
#pragma unroll
        for (int kg = 0; kg < 16; ++kg) { float p[4];
#pragma unroll
            for (int r = 0; r < 4; ++r) { p[r] = __builtin_amdgcn_exp2f(__builtin_fmaf(sc[kg][r], e_c, e_b)); sm += p[r]; }
            pp[kg] = pk4_fp8_nc(p[0], p[1], p[2], p[3]); }
        sm += shfl_f(sm, lane ^ 16); sm += shfl_f(sm, lane ^ 32);
        f32x4 oacc[8];
#pragma unroll
        for (int n = 0; n < 8; ++n) oacc[n] = (f32x4){0.f, 0.f, 0.f, 0.f};
#define VMM(t_) do { unsigned ta_ = trbase_u + ((t_) & 3) * 4096; asm volatile("" : "+v"(ta_)); long va_[8];     \
            const long pb_ = (long)(((unsigned long long)pp[2 * (t_) + 1] << 32) | (unsigned long long)pp[2 * (t_)]); \
            _Pragma("unroll") for (int n_ = 0; n_ < 8; ++n_) asm volatile("ds_read_b64_tr_b8 %0, %1" : "=&v"(va_[n_]) : "v"(ta_ ^ (unsigned)(n_ << 4)) : "memory"); \
            asm volatile("s_waitcnt lgkmcnt(0)" ::: "memory"); __builtin_amdgcn_sched_barrier(0); \
            _Pragma("unroll") for (int n_ = 0; n_ < 8; ++n_) oacc[n_] = __builtin_amdgcn_mfma_f32_16x16x32_fp8_fp8(va_[n_], pb_, oacc[n_], 0, 0, 0); } while (0)
#define KNEXT do { _Pragma("unroll") for (int i_ = 0; i_ < 4; ++i_) Sl[i_ * 64 + lane] = selraw[i_]; QCVT(qf8, qrawn); \
            _Pragma("unroll") for (int kg_ = 0; kg_ < 7; ++kg_) KLDX(kg_, Kb8n); } while (0)
        if (nt == 2) { asm volatile("s_waitcnt vmcnt(0)" ::: "memory"); KNEXT; }
#pragma unroll
        for (int t = 0; t < 8; ++t) {
            if (t < nt) {
                if (t + 3 < nt) { VDMA(t + 3); if (t >= 3) asm volatile("s_waitcnt vmcnt(12)" ::: "memory"); }
                else if (t >= 3) {
                    if (t + 2 < nt) asm volatile("s_waitcnt vmcnt(22)" ::: "memory");
                    else if (t + 1 < nt) asm volatile("s_waitcnt vmcnt(18)" ::: "memory");
                    else asm volatile("s_waitcnt vmcnt(14)" ::: "memory");
                }
                VMM(t);
                if (t + 4 == nt) KNEXT;
            }
        }
#undef VDMA
#undef VMM
#undef KNEXT
        const float inv = 4.f / sm;
        if (kq < 4) {
#pragma unroll
            for (int n = 0; n < 8; ++n) { const f32x4 v = oacc[n] * inv;
                *(GAS unsigned*)((GAS unsigned char*)O + (size_t)q * DM + (4 * g + kq) * 128 + 16 * n + 4 * lg) = pk4_fp8(v[0], v[1], v[2], v[3]); }
        }
        if (!has_next) break;
        tl = tn; q = qn; g = gn; nsel = nseln; Kb8 = Kb8n; Vb8 = Vb8n;
    }
#undef KLDX
#undef TASK
#undef QCVT
}

constexpr int RING_BYTES = 131072, LDSCTL_OFF = 139264  , MISC_OFF = LDSCTL_OFF + 320, LDS_BYTES = 147456;
struct Args { const float* in[22]; float* out; unsigned char* ws; float inv_freq[64]; };
constexpr int NSTEP = 25;
#ifndef PH_MASK
#define PH_MASK 0x3ff
#endif
#define PHM(k) (((PH_MASK) >> (k)) & 1)
#ifndef REP_MASK
#define REP_MASK 0
#endif

#define PH_ENV \
        int tid; asm volatile("v_mbcnt_lo_u32_b32 %0, -1, 0\n\tv_mbcnt_hi_u32_b32 %0, -1, %0" : "=v"(tid)); tid += wave_s * 64; \
        const __attribute__((address_space(4))) Args* ap = (const __attribute__((address_space(4))) Args*)__builtin_amdgcn_kernarg_segment_ptr(); asm volatile("" : "+s"(ap)); \
        const int lane = tid & 63, wave = wave_s; \
        const int G = gridDim.x, bx = blockIdx.x; const int vcu = (G % 8 == 0) ? (bx % 8) * (G / 8) + bx / 8 : bx; \
        const int gt = vcu * NTHR + tid, GT = G * NTHR, gw = vcu * NWAVES + wave, NGW = G * NWAVES; \
        GAS unsigned char* ws = (GAS unsigned char*)ap->ws; gf out = (gf)ap->out; \
        gcf xp = (gcf)ap->in[0]; gcf xs = (gcf)ap->in[1]; \
        gb WMI = (gb)(ws + WS_WMI); gb WMO = (gb)(ws + WS_WMO); gb WAI = (gb)(ws + WS_WAI); gb WAO = (gb)(ws + WS_WAO); \
        gb WF1 = (gb)(ws + WS_WF1); gb WF2 = (gb)(ws + WS_WF2); \
        gb XB = (gb)(ws + WS_XB); gf XF = (gf)(ws + WS_XF); gb Y = (gb)(ws + WS_Y); gb BIG = (gb)(ws + WS_BIG); gb HB = (gb)(ws + WS_H); \
        gb KP = (gb)(ws + WS_KP); gb VP = (gb)(ws + WS_VP); gb IKP = (gb)(ws + WS_IKP); gf IW = (gf)(ws + WS_IW); gi SEL = (gi)(ws + WS_SEL); \
        gb IKS = (gb)(ws + WS_IKS); gb KS = (gb)(ws + WS_KS); gb VS = (gb)(ws + WS_VS); \
        gf SCP = (gf)(ws + WS_SCP); gf SCS = (gf)(ws + WS_SCS); gb QR = (gb)(ws + WS_QR); gb IQ = (gb)(ws + WS_IQ);
__global__ void __launch_bounds__(NTHR, 2) mega_fwd(Args args) {
    extern __shared__ __attribute__((aligned(16))) unsigned char lds[];
    LAS unsigned char* L = (LAS unsigned char*)lds;
    volatile LAS unsigned* MISC = (volatile LAS unsigned*)(L + MISC_OFF);
    for (int u = threadIdx.x; u < (LDS_BYTES - LDSCTL_OFF) / 4; u += NTHR) ((LAS unsigned*)(L + LDSCTL_OFF))[u] = 0u;
    __syncthreads();
    const int wave_s = __builtin_amdgcn_readfirstlane(threadIdx.x >> 6);
    XcdBarrier bar = xcd_barrier_post((unsigned*)((gu32*)(args.ws + WS_CTL) + CW_BAR), MISC + 8);

#pragma unroll 1
    for (int sidx = 0; sidx < NSTEP * 2; ++sidx) {
        const int pos = sidx >> 1, step = pos == 0 ? 0 : pos == 1 ? 21 : pos == 2 ? 1 : pos == 3 ? 24 : pos <= 7 ? pos - 2 : pos == 8 ? 22 : pos <= 11 ? pos - 3 : pos == 12 ? 20 : pos <= 20 ? pos - 4 : pos == 21 ? 23 : pos - 5;
        if (sidx & 1) { const int kind = (step == 0 || step == 21) ? 0 : (step == 1 || step == 3 || step == 5 || step == 9 || step == 16 || step == 22 || step == 23 || step == 24) ? 1 : (step == 7 || step == 14 || step == 18 || step == 20) ? 2 : step == 2 ? 3 : (step == 6 || step == 17) ? 4
                : (step == 4 || step == 8 || step == 15 || step == 19) ? 5 : step == 10 ? 6 : step == 11 ? 7 : step == 12 ? 8 : 9;
            if (!((REP_MASK >> kind) & 1)) continue;
#ifdef REP_STEP
            if (step != REP_STEP) continue;
#endif
        }
        if (PHM(0) && step == 0) {
            PH_ENV
            constexpr int I_MI = 32 * 96, I_MO = 32 * 32, I_AI = 32 * 84, I_AO = 32 * 32, I_F1 = 32 * 176, I_F2 = 88 * 32;
            constexpr int NITEMS = I_MI + I_MO + I_AI + I_AO + 2 * I_F1 + I_F2;
            for (int it = gw; it < NITEMS; it += NGW) {
                int r = it;
                if (r < I_MI) { absmax_item((gcf)ap->in[7], NBCV, r, lane, (GAS unsigned*)(ws + WS_CTL + 131072) + 2 * NGU, 0); continue; } r -= I_MI;
                if (r < I_MO) { transpose_item((gcf)ap->in[9], DM, DM, DM, WMO, r, lane); continue; } r -= I_MO;
                if (r < I_AI) { const int kb = r / 84, nb = r - kb * 84, k0 = 64 * kb; gcf Wa = (gcf)ap->in[10];
                    if (nb < 64) { const int n_src = (nb < 32 ? 64 * nb : 3072 + 64 * (nb - 32)) + lane; tr_col_fp8(Wa, NATT, k0, n_src, (GAS v4u*)((GAS unsigned char*)WAI + (size_t)(64 * nb + lane) * DM + k0)); }
                    else { const int nbb = nb - 64; const int n_src = (nbb < 16 ? 2048 + 64 * nbb : nbb < 18 ? 5120 + 64 * (nbb - 16) : 5248) + lane; const bool ok = nbb < 18 || (nbb == 18 && lane < 16);
                        tr_col_bf16(Wa, NATT, k0, n_src, ok, (GAS v4u*)((gb)((GAS unsigned char*)WAI + 8 * MiB) + (size_t)(64 * nbb + lane) * DM + k0)); }
                    continue; } r -= I_AI;
                if (r < I_AO) { transpose_item8((gcf)ap->in[13], DM, DM, (GAS unsigned char*)WAO, r, lane); continue; } r -= I_AO;
                if (r < 2 * I_F1) { const int l = r / I_F1; absmax_item((gcf)ap->in[14] + (size_t)l * DM * NGU, NGU, r - l * I_F1, lane, (GAS unsigned*)(ws + WS_CTL + 131072) + l * NGU, 1); continue; } r -= 2 * I_F1;
                { const int l = r / I_F2; transpose_item8((gcf)ap->in[17] + (size_t)l * DFF * DM, DFF, DM, (GAS unsigned char*)WF2 + (size_t)l * DM * DFF, r - l * I_F2, lane); }
            }
            xrows_phase(xp, xs, XB, (GAS unsigned char*)(ws + WS_XF + 20 * MiB), (gf)(ws + WS_XF + 40 * MiB), (gb)(ws + WS_XF + 41 * MiB), gw, NGW, lane);
            for (int e = gt; e < 188 * DM / 8; e += GT) *(GAS v4u*)((gb)(ws + WS_XF + 41 * MiB) + (size_t)68 * DM + (size_t)e * 8) = (v4u){0u, 0u, 0u, 0u};
        } else if (PHM(0) && step == 21) {
            PH_ENV
            constexpr int I_F1 = 32 * 176, I_MI = 32 * 96;
            for (int it = gw; it < I_MI; it += NGW) quant_item((gcf)ap->in[7], DM, NBCV, (GAS unsigned char*)WMI, (gb)(ws + WS_WF2 + 22 * MiB), (gcf)(ws + WS_CTL + 131072) + 2 * NGU, it, lane, 0);
            for (int it = gw; it < I_F1; it += NGW) { const int l = 0;
                quant_item((gcf)ap->in[14] + (size_t)l * DM * NGU, DM, NGU, (GAS unsigned char*)WF1 + (size_t)l * 44 * MiB, (gb)((GAS unsigned char*)WF1 + (size_t)l * 44 * MiB + 22 * MiB), (gcf)(ws + WS_CTL + 131072) + l * NGU, it - l * I_F1, lane, 1); }
        } else if (PHM(1) && step == 1) {
            PH_ENV
            pg8::Gemm g{(gcb)(ws + WS_XF + 20 * MiB), (gcb)WMI, MROWS, NBCV, DM / 2, 127, 127, 1}; pg8::DualOrder S; S.init(MROWS, NBCV, DM / 2, G, bx, 0);
            pg8::EpiBf16P E{BIG, NBCV, 0, (gcf)(ws + WS_XF + 40 * MiB), (gcf)(ws + WS_CTL + 131072) + 2 * NGU};
            pg8::gemm_phase<pg8::EpiBf16P, pg8::DualOrder, true, true, false, true>(L, g, S, E, tid);
        } else if (PHM(1) && (step == 5 || step == 16)) {
            PH_ENV
            const int fl = step == 16 ? 1 : 0;
            pg8::Gemm g{(gcb)(ws + WS_XF + 20 * MiB), (gcb)((const GAS unsigned char*)WF1 + (size_t)fl * 44 * MiB), MROWS, NGU, DM / 2, 127, 127, 1}; pg8::DualOrder S; S.init(MROWS, NGU, DM / 2, G, bx, 0);
#ifdef REP_KFIX
            if (step == REP_STEP && !(sidx & 1)) g.kfix = 1;
#endif

            gf FIX = (gf)((GAS unsigned char*)BIG + 64 * MiB);
            pg8::EpiConvGlu E{(GAS unsigned char*)HB, (gcf)ap->in[15] + (size_t)fl * 3 * DFF, (gcf)ap->in[16] + (size_t)fl * DFF, FIX, FIX + (size_t)320 * DFF, FIX + (size_t)640 * DFF, DFF, (gcf)(ws + WS_XF + 40 * MiB), (gcf)(ws + WS_CTL + 131072) + fl * NGU};
            pg8::gemm_phase<pg8::EpiConvGlu, pg8::DualOrder, true, true, false, true>(L, g, S, E, tid);
        } else if (PHM(1) && (step == 3 || step == 9 || step == 22 || step == 23 || step == 24)) {
            PH_ENV
            gcb A = XB; gcb Bt; int N, M = MROWS, tail = 0, c = bx, mode = 0; gb O = BIG; size_t kslab = 0;
            if (step == 3) { A = HB; Bt = WMO; N = DM; tail = 1; mode = 1; }
            else if (step == 9) { Bt = (gcb)((const GAS unsigned char*)WAI + 8 * MiB); N = 1280; c = G - 1 - bx; O = (gb)((GAS unsigned char*)BIG + 96 * MiB); }
            else if (step == 24) { A = (gcb)(ws + WS_XF + 41 * MiB); Bt = (gcb)(ws + WS_WF2 + 22 * MiB); N = 4096; M = 256; tail = 2; c = G - 1 - bx; O = (gb)(ws + WS_XF + 42 * MiB); kslab = (size_t)256 * 4096; }
            else { const int fl = step == 23 ? 1 : 0;
                A = (gcb)(ws + WS_XF + 41 * MiB); Bt = (gcb)((const GAS unsigned char*)WF1 + (size_t)fl * 44 * MiB + 22 * MiB); N = DFF; M = 256; tail = 2; c = G - 1 - bx; O = (gb)(ws + WS_XF + 42 * MiB); kslab = (size_t)256 * DFF; }
            pg8::Gemm g{A, Bt, M, N, DM, 127, 127, 0}; pg8::DualOrder S; S.init(M, N, DM, G, c, tail);
            pg8::EpiDual E{mode, O, N, Y, XB, NPROW, DM, DN_ALPHA, (gf)BIG, nullptr, nullptr, nullptr, nullptr, nullptr, nullptr, 0, nullptr, nullptr, kslab};
            pg8::gemm_phase<pg8::EpiDual, pg8::DualOrder, true, true, false, false>(L, g, S, E, tid);
            if (step == 9 && (bx < 56 || bx >= 128) && G == 256) {
                const int gt2 = (bx < 56 ? bx : bx - 72) * NTHR + tid, GT2 = 184 * NTHR;
                cvt_rows((gcf)ap->in[5], IKS, PAST * IDXD / 8, (size_t)LSK * IDXD, 32 * PAST * IDXD / 8, gt2, GT2);
                cvt_rows_k8((gcf)ap->in[3], (GAS unsigned char*)KS, PAST * KVW / 8, (size_t)LSK * KVW, 32 * PAST * KVW / 8, gt2, GT2);
                cvt_rows_v8((gcf)ap->in[4], (GAS unsigned char*)VS, PAST * KVW / 8, (size_t)LSK * KVW, 32 * PAST * KVW / 8, gt2, GT2); }
        } else if (PHM(2) && (step == 7 || step == 14 || step == 18 || step == 20)) {
            PH_ENV
            gcb A = HB; gcb Bt; int K8 = DM, sa = 123;
            if (step == 7) { Bt = WF2; K8 = DFF; } else if (step == 14) { A = IQ; Bt = WAO; sa = 121; } else { Bt = (gcb)((const GAS unsigned char*)WF2 + (size_t)DM * DFF); K8 = DFF; }
            int N = DM, mode = 1;
            if (step == 20) { A = (gcb)(ws + WS_XF); Bt = WAI; N = 4096; mode = 0; K8 = DM; sa = 123; }
            pg8::Gemm g{A, Bt, MROWS, N, K8 / 2, 119, sa, 0}; pg8::DualOrder S; S.init(MROWS, N, K8 / 2, G, bx, mode);
#ifdef REP_KFIX
            if (step == REP_STEP && !(sidx & 1)) g.kfix = 1;
#endif

            pg8::EpiDual E{mode, BIG, N, Y, XB, NPROW, DM, DN_ALPHA, (gf)BIG, nullptr, nullptr, nullptr, nullptr, nullptr, nullptr, 0, nullptr, nullptr, 0};
#ifdef REP_PV
            if (step == REP_STEP && !(sidx & 1)) pg8::gemm_phase<pg8::EpiDual, pg8::DualOrder, true, true, true, false, REP_PV>(L, g, S, E, tid); else
#endif
            pg8::gemm_phase<pg8::EpiDual, pg8::DualOrder, true, true, true>(L, g, S, E, tid);
        } else if (PHM(3) && step == 2) {
            PH_ENV
            conv_mix_phase(BIG, HB, (gcf)ap->in[8], (gcf)ap->in[2], out, (gcb)(ws + WS_XF + 42 * MiB), gt, GT);
        } else if (PHM(4) && (step == 6 || step == 17)) {
            PH_ENV
            const int l = step == 6 ? 0 : 1;
            gcf FIX = (gcf)((GAS unsigned char*)BIG + 64 * MiB);
            glu_fixup_phase(FIX, FIX + (size_t)320 * DFF, FIX + (size_t)640 * DFF, (GAS unsigned char*)HB, (gcf)ap->in[15] + (size_t)l * 3 * DFF, (gcf)ap->in[16] + (size_t)l * DFF, (gcf)ap->in[6] + (size_t)l * 32 * 2 * DFF, out, (gcb)(ws + WS_XF + 42 * MiB), l, gt, GT);
        } else if (PHM(5) && (step == 4 || step == 8 || step == 15 || step == 19)) {
            PH_ENV
            gcf g_; gcf b_; gf xo = nullptr; gb xb = XB;
            if (step == 4) { g_ = (gcf)ap->in[18]; b_ = (gcf)ap->in[19]; } else if (step == 8) { g_ = (gcf)ap->in[20]; b_ = (gcf)ap->in[21]; } else if (step == 15) { g_ = (gcf)ap->in[18] + DM; b_ = (gcf)ap->in[19] + DM; }
            else { g_ = (gcf)ap->in[20] + DM; b_ = (gcf)ap->in[21] + DM; xo = out; xb = nullptr; }
            const bool ffn_next = step == 4 || step == 15;
            ln_phase(Y, (gcf)BIG, g_, b_, xo, xb, step == 8 ? (GAS unsigned char*)(ws + WS_XF) : (GAS unsigned char*)nullptr, ffn_next ? (GAS unsigned char*)(ws + WS_XF + 20 * MiB) : (GAS unsigned char*)nullptr, (gf)(ws + WS_XF + 40 * MiB), (gb)(ws + WS_XF + 41 * MiB), gw, NGW, lane);
        } else if (PHM(6) && step == 10) {
            PH_ENV
            postproj_phase(BIG, (gcb)((GAS unsigned char*)BIG + 96 * MiB), ap->inv_freq, (gcf)ap->in[11], (gcf)ap->in[12], out, QR, IQ, KP, VP, IKP, KS, VS, IKS, IW, gw, NGW, lane);
            if (G != 256) {
                cvt_rows((gcf)ap->in[5], IKS, PAST * IDXD / 8, (size_t)LSK * IDXD, 32 * PAST * IDXD / 8, gt, GT);
                cvt_rows_k8((gcf)ap->in[3], (GAS unsigned char*)KS, PAST * KVW / 8, (size_t)LSK * KVW, 32 * PAST * KVW / 8, gt, GT);
                cvt_rows_v8((gcf)ap->in[4], (GAS unsigned char*)VS, PAST * KVW / 8, (size_t)LSK * KVW, 32 * PAST * KVW / 8, gt, GT); }
        } else if (PHM(7) && step == 11) {
            PH_ENV
            indexer_phase(L, IQ, IW, IKP, IKS, SCP, SCS, vcu, G, tid, lane, wave);
        } else if (PHM(8) && step == 12) {
            PH_ENV
            topk_phase(L, SCP, SCS, SEL, (gcf)ap->in[14] + (size_t)DM * NGU, (gcf)(ws + WS_CTL + 131072) + NGU, (GAS unsigned char*)WF1 + (size_t)44 * MiB, (gb)((GAS unsigned char*)WF1 + (size_t)44 * MiB + 22 * MiB),
                       (gcf)ap->in[17] + (size_t)DFF * DM, (GAS unsigned char*)WF2 + (size_t)DM * DFF, gw, NGW, lane, wave);
        } else if (PHM(9) && step == 13) {
            PH_ENV
            attn_phase(L, QR, IQ, SEL, KP, VP, KS, VS, vcu, G, lane, wave);
        }
        if ((sidx + 1 < NSTEP * 2 - 1 || REP_MASK) && step != 20 && step != 1 && step != 5 && step != 16) {   int tb; asm volatile("v_mbcnt_lo_u32_b32 %0, -1, 0\n\tv_mbcnt_hi_u32_b32 %0, -1, %0" : "=v"(tb)); xcd_barrier(bar, tb + wave_s * 64); }
    }
}

extern "C" void kernel_launch(void* const* d_in, const int* in_sizes, int n_in, void* d_out, int out_size, void* d_ws, size_t ws_size, hipStream_t stream) {
    static int grid = 0;
    if (grid == 0) {
        if (n_in != 22 || out_size != (int)O_END || ws_size < WS_END) { fprintf(stderr, "kernel_launch: built for 22 inputs, %zu outputs, >= %zu bytes of workspace; got n_in %d, out %d, ws %zu; nothing launched\n", (size_t)O_END, (size_t)WS_END, n_in, out_size, ws_size); grid = -1; return; }
        int dev = 0, cus = 0;
        if (hipGetDevice(&dev) != hipSuccess || hipDeviceGetAttribute(&cus, hipDeviceAttributeMultiprocessorCount, dev) != hipSuccess) { fprintf(stderr, "kernel_launch: device query failed\n"); grid = -1; return; }
        if (hipFuncSetAttribute((const void*)mega_fwd, hipFuncAttributeMaxDynamicSharedMemorySize, LDS_BYTES) != hipSuccess) { fprintf(stderr, "kernel_launch: hipFuncSetAttribute failed\n"); grid = -1; return; }
        (void)hipGetLastError();
        grid = cus;
    }
    if (grid < 0) return;
    if (hipMemsetAsync((char*)d_ws + WS_CTL, 0, CTL_ZERO_BYTES, stream) != hipSuccess) { fprintf(stderr, "kernel_launch: hipMemsetAsync failed\n"); return; }
    Args a{};
    for (int i = 0; i < 22; ++i) a.in[i] = (const float*)d_in[i];
    a.out = (float*)d_out; a.ws = (unsigned char*)d_ws;
    for (int d = 0; d < 64; ++d) a.inv_freq[d] = (float)pow(10000.0, -(double)d / 64.0);
    hipLaunchKernelGGL(mega_fwd, dim3(grid), dim3(NTHR), LDS_BYTES, stream, a);
    const hipError_t le = hipPeekAtLastError();
    if (le != hipSuccess) fprintf(stderr, "kernel_launch: launch failed: %s\n", hipGetErrorName(le));
}
```

```cpp
#include <hip/hip_runtime.h>
#include <cstdio>
#include <cstdint>
#include <cmath>
namespace pg8 {
#define PG8_LAS __attribute__((address_space(3)))
typedef unsigned short bf16_t;
typedef short bf16x8 __attribute__((ext_vector_type(8)));
typedef float f32x4 __attribute__((ext_vector_type(4)));
typedef unsigned u32x4 __attribute__((ext_vector_type(4)));
constexpr int BM = 256, BK = 64, HALF = 128, HTB = HALF * BK * 2  , STAGE_BYTES = 8 * HTB, NXCD = 8, WGM = 8;

__host__ __device__ __forceinline__ int lds_byte(int r, int c) { const int st = (r >> 4) * 2 + (c >> 5), rr = r & 15, cc = c & 31, ob = rr * 64 + cc * 2; return st * 1024 + (ob ^ (((ob >> 9) & 1) << 5)); }
__host__ __device__ __forceinline__ void stage_rc(int b, int& R, int& C) { const int st = b / 1024, sb = b % 1024, swz = sb ^ (((sb >> 9) & 1) << 5); R = (st >> 1) * 16 + swz / 64; C = (st & 1) * 32 + (swz % 64) / 2; }
__host__ __device__ __forceinline__ int perm32(int rho) { const int n = rho >> 4, i = rho & 15; return 8 * (i >> 2) + 4 * n + (i & 3); }

struct Unit { int pm, pn, k0, ntk, kq; };
struct Gemm { const __attribute__((address_space(1))) bf16_t* A; const __attribute__((address_space(1))) bf16_t* Bt; int M, N, K; int sw, sa; int i8; int kfix; };

struct StaticOrder {
    int nM, nN, nwg, G, c;
    __host__ __device__ void init(int M, int N, int G_, int c_) { nM = M / BM; nN = N / BM; nwg = nM * nN; G = G_; c = c_; }
    __host__ __device__ bool next(int i, Unit& u) const {
        const long L = (long)i * G + c; if (L >= nwg) return false;
        int wgid = (int)L; { const int q = nwg / NXCD, r = nwg % NXCD, xcd = wgid % NXCD, off = wgid / NXCD; wgid = (xcd < r ? xcd * (q + 1) : r * (q + 1) + (xcd - r) * q) + off; }
        const int nig = WGM * nN, gid = wgid / nig, fm = gid * WGM, gsz = (nM - fm) < WGM ? (nM - fm) : WGM;
        u.pm = fm + ((wgid % nig) % gsz); u.pn = (wgid % nig) / gsz; u.k0 = 0; u.ntk = 0; u.kq = 0; return true;
    }
    __device__ __forceinline__ void a_ready(const Unit&) const {}
    __device__ __forceinline__ void done(const Unit&) const {}
};

struct DualOrder {
    int nM, nN, nwg, tail, G, c, qhi, qlo;
    __device__ __forceinline__ void init(int M, int N, int K, int G_, int c_, int tail_) { tail = tail_; G = G_; c = c_; { const int nt = K / BK; qhi = 2 * ((nt + 7) / 8); qlo = (nt - 2 * qhi) / 2; } nM = (tail_ == 1 ? 8192 : M) / BM; nN = N / BM; nwg = tail_ == 2 ? 0 : nM * nN; }
    __device__ __forceinline__ bool next(int i, Unit& u) const {
        long L = (long)i * G + c; int pm = 0, pn = 0, k0 = 0, ntk = 0, kq = 0; bool ok = true;
        if (tail == 1 && (c & 1) && i < 2 && nwg == G) L = (long)(1 - i) * G + c;
        if (L < nwg) {
            int wgid = (int)L; { const int q = nwg / NXCD, r = nwg % NXCD, xcd = wgid % NXCD, off = wgid / NXCD; wgid = (xcd < r ? xcd * (q + 1) : r * (q + 1) + (xcd - r) * q) + off; }
            const int nig = WGM * nN, gid = wgid / nig, fm = gid * WGM, gsz = (nM - fm) < WGM ? (nM - fm) : WGM;
            pm = fm + ((wgid % nig) % gsz); pn = (wgid % nig) / gsz;
        } else if (tail == 2) {
            if (L < 2 * nN) { pn = (int)(L % nN); kq = (int)(L / nN); ntk = 16; k0 = kq * 16; } else ok = false;
        } else if (tail == 1 && L < nwg + 256) {
            const int t = (int)(L - nwg), x = t & 7, j = t >> 3; pm = 32 + (j & 7); pn = x; kq = j >> 3; ntk = kq < 2 ? qhi : qlo; k0 = kq < 2 ? kq * qhi : 2 * qhi + (kq - 2) * qlo;
        } else ok = false;
        u.pm = pm; u.pn = pn; u.k0 = k0; u.ntk = ntk; u.kq = kq; return ok;
    }
    __device__ __forceinline__ void a_ready(const Unit&) const {}
    __device__ __forceinline__ void done(const Unit&) const {}
};
}
namespace pg8 {
#define PG8_GAS __attribute__((address_space(1)))
__device__ __forceinline__ unsigned cvt_pk_bf16(float lo, float hi) { unsigned r; asm volatile("v_cvt_pk_bf16_f32 %0, %1, %2" : "=v"(r) : "v"(lo), "v"(hi)); return r; }
struct EpiBf16P {
    static constexpr bool AFTER_DRAIN = false; __device__ __forceinline__ bool perm() const { return true; }
    PG8_GAS bf16_t* O; int ldc; size_t kslab;
    const PG8_GAS float* SA; const PG8_GAS float* SWM;
    __device__ __forceinline__ void operator()(const f32x4 (&acc)[2][2][4][2], const Unit& u, int wr, int wc, int fr, int fq) const {
        const int row0 = u.pm * BM + wr * 64 + fr, col0 = u.pn * BM + wc * 32 + 8 * fq;
        f32x4 sw[2][2];
#pragma unroll
        for (int bj = 0; bj < 2; ++bj)
#pragma unroll
            for (int n = 0; n < 2; ++n) sw[bj][n] = SA ? *(const PG8_GAS f32x4*)(SWM + col0 + bj * HALF + 4 * n) * (1.f / 127.f) : (f32x4){0.f, 0.f, 0.f, 0.f};
#pragma unroll
        for (int ai = 0; ai < 2; ++ai)
#pragma unroll
            for (int m = 0; m < 4; ++m) { PG8_GAS bf16_t* rowp = O + (size_t)u.kq * kslab + (size_t)(row0 + ai * HALF + m * 16) * ldc + col0;
                const float sar = SA ? SA[row0 + ai * HALF + m * 16] : 0.f;
#pragma unroll
                for (int bj = 0; bj < 2; ++bj) { f32x4 v0 = acc[ai][bj][m][0], v1 = acc[ai][bj][m][1];
                    if (SA) {
#pragma unroll
                        for (int i = 0; i < 4; ++i) { v0[i] = (float)__float_as_int(v0[i]) * (sw[bj][0][i] * sar); v1[i] = (float)__float_as_int(v1[i]) * (sw[bj][1][i] * sar); } }
                    u32x4 w; w.x = cvt_pk_bf16(v0[0], v0[1]); w.y = cvt_pk_bf16(v0[2], v0[3]); w.z = cvt_pk_bf16(v1[0], v1[1]); w.w = cvt_pk_bf16(v1[2], v1[3]);
                    *(PG8_GAS u32x4*)(rowp + bj * HALF) = w; } }
    }
};
struct EpiF32R {
    static constexpr bool AFTER_DRAIN = false; __device__ __forceinline__ bool perm() const { return true; }
    PG8_GAS bf16_t* Y; const PG8_GAS bf16_t* X; int split; int ldc; float alpha; PG8_GAS float* P;
    __device__ __forceinline__ void operator()(const f32x4 (&acc)[2][2][4][2], const Unit& u, int wr, int wc, int fr, int fq) const {
        const int row0 = u.pm * BM + wr * 64 + fr, col0 = u.pn * BM + wc * 32 + 8 * fq;
        if (u.kq > 0) {
#pragma unroll
            for (int ai = 0; ai < 2; ++ai)
#pragma unroll
                for (int m = 0; m < 4; ++m) { PG8_GAS bf16_t* pr = (PG8_GAS bf16_t*)P + ((size_t)(u.kq - 1) * 2048 + (size_t)(row0 + ai * HALF + m * 16 - split)) * ldc + col0;
#pragma unroll
                    for (int bj = 0; bj < 2; ++bj) { const f32x4 a0 = acc[ai][bj][m][0], a1 = acc[ai][bj][m][1];
                        u32x4 o; o.x = cvt_pk_bf16(a0[0], a0[1]); o.y = cvt_pk_bf16(a0[2], a0[3]); o.z = cvt_pk_bf16(a1[0], a1[1]); o.w = cvt_pk_bf16(a1[2], a1[3]);
                        *(PG8_GAS u32x4*)(pr + bj * HALF) = o; } }
            return;
        }
#pragma unroll
        for (int ai = 0; ai < 2; ++ai) {
            u32x4 xv[4][2];
#pragma unroll
            for (int m = 0; m < 4; ++m)
#pragma unroll
                for (int bj = 0; bj < 2; ++bj) xv[m][bj] = *(const PG8_GAS u32x4*)(X + (size_t)(row0 + ai * HALF + m * 16) * ldc + col0 + bj * HALF);
#pragma unroll
            for (int m = 0; m < 4; ++m)
#pragma unroll
                for (int bj = 0; bj < 2; ++bj) { const u32x4 w = xv[m][bj]; const f32x4 a0 = acc[ai][bj][m][0], a1 = acc[ai][bj][m][1];
                    u32x4 o; o.x = cvt_pk_bf16(__uint_as_float(w.x << 16) * alpha + a0[0], __uint_as_float(w.x & 0xffff0000u) * alpha + a0[1]); o.y = cvt_pk_bf16(__uint_as_float(w.y << 16) * alpha + a0[2], __uint_as_float(w.y & 0xffff0000u) * alpha + a0[3]);
                    o.z = cvt_pk_bf16(__uint_as_float(w.z << 16) * alpha + a1[0], __uint_as_float(w.z & 0xffff0000u) * alpha + a1[1]); o.w = cvt_pk_bf16(__uint_as_float(w.w << 16) * alpha + a1[2], __uint_as_float(w.w & 0xffff0000u) * alpha + a1[3]);
                    *(PG8_GAS u32x4*)(Y + (size_t)(row0 + ai * HALF + m * 16) * ldc + col0 + bj * HALF) = o; }
            asm volatile("" ::: "memory");
        }
    }
};

struct EpiConvGlu {
    static constexpr bool AFTER_DRAIN = false; __device__ __forceinline__ bool perm() const { return true; }
    PG8_GAS unsigned char* H; const PG8_GAS float* cw; const PG8_GAS float* cb; PG8_GAS float* FIXG; PG8_GAS float* FIXU; PG8_GAS float* HALO; int ldh;
    const PG8_GAS float* SA; const PG8_GAS float* SWM;
    __device__ __forceinline__ void operator()(const f32x4 (&acc)[2][2][4][2], const Unit& u, int wr, int wc, int fr, int fq) const {
        typedef unsigned u32x2 __attribute__((ext_vector_type(2)));
        const int ch0 = u.pn * 128 + wc * 32 + 8 * fq;
        float w0[8], w1[8], w2[8], bb[8];
#pragma unroll
        for (int h4 = 0; h4 < 2; ++h4) { const f32x4 a = *(const PG8_GAS f32x4*)(cw + ch0 + 4 * h4), b = *(const PG8_GAS f32x4*)(cw + ldh + ch0 + 4 * h4), c = *(const PG8_GAS f32x4*)(cw + 2 * ldh + ch0 + 4 * h4), d = *(const PG8_GAS f32x4*)(cb + ch0 + 4 * h4);
#pragma unroll
            for (int i = 0; i < 4; ++i) { w0[4 * h4 + i] = a[i]; w1[4 * h4 + i] = b[i]; w2[4 * h4 + i] = c[i]; bb[4 * h4 + i] = d[i]; } }
        float sg8[8], su8[8];
#pragma unroll
        for (int h4 = 0; h4 < 2; ++h4) { const f32x4 a = *(const PG8_GAS f32x4*)(SWM + u.pn * BM + wc * 32 + 8 * fq + 4 * h4), b = *(const PG8_GAS f32x4*)(SWM + u.pn * BM + HALF + wc * 32 + 8 * fq + 4 * h4);
#pragma unroll
            for (int i = 0; i < 4; ++i) { sg8[4 * h4 + i] = a[i] * (1.f / 127.f); su8[4 * h4 + i] = b[i] * (1.f / 127.f); } }
        const int src1 = ((fq << 4) | ((fr + 15) & 15)) << 2, src2 = ((fq << 4) | ((fr + 14) & 15)) << 2;
#pragma unroll
        for (int ai = 0; ai < 2; ++ai)
#pragma unroll
            for (int m = 0; m < 4; ++m) {
                const int row = u.pm * BM + ai * HALF + wr * 64 + m * 16 + fr; float hv[8], gvv[8], uvv[8];
                const float sar = SA[row], sam1 = m > 0 ? SA[row - 16] : 0.f;
#pragma unroll
                for (int e8 = 0; e8 < 8; ++e8) { const int n = e8 >> 2, i = e8 & 3;
                    const float gv = (float)__float_as_int(acc[ai][0][m][n][i]) * sar * sg8[e8], gp = m > 0 ? (float)__float_as_int(acc[ai][0][m > 0 ? m - 1 : 0][n][i]) * sam1 * sg8[e8] : 0.f, uv = (float)__float_as_int(acc[ai][1][m][n][i]) * sar * su8[e8];
                    const float g1 = __int_as_float(__builtin_amdgcn_update_dpp(0, __float_as_int(fr == 15 ? gp : gv), 0x121, 0xf, 0xf, false));
                    const float g2 = __int_as_float(__builtin_amdgcn_update_dpp(0, __float_as_int(fr >= 14 ? gp : gv), 0x122, 0xf, 0xf, false));
                    const float a = w0[e8] * g2 + w1[e8] * g1 + w2[e8] * gv + bb[e8];
                    const float sg = __builtin_amdgcn_rcpf(1.f + __builtin_amdgcn_exp2f(-a * 1.4426950408889634f));
                    hv[e8] = fminf(fmaxf(a * sg * uv * 16.f, -448.f), 448.f); gvv[e8] = gv; uvv[e8] = uv; }
                if (m == 0 && fr < 2) { const size_t fo = (size_t)((row >> 6) * 2 + fr) * ldh + ch0;
                    *(PG8_GAS f32x4*)(FIXG + fo) = (f32x4){gvv[0], gvv[1], gvv[2], gvv[3]}; *(PG8_GAS f32x4*)(FIXG + fo + 4) = (f32x4){gvv[4], gvv[5], gvv[6], gvv[7]};
                    *(PG8_GAS f32x4*)(FIXU + fo) = (f32x4){uvv[0], uvv[1], uvv[2], uvv[3]}; *(PG8_GAS f32x4*)(FIXU + fo + 4) = (f32x4){uvv[4], uvv[5], uvv[6], uvv[7]}; }
                else { int p0 = __builtin_amdgcn_cvt_pk_fp8_f32(hv[0], hv[1], 0, false); p0 = __builtin_amdgcn_cvt_pk_fp8_f32(hv[2], hv[3], p0, true);
                    int p1 = __builtin_amdgcn_cvt_pk_fp8_f32(hv[4], hv[5], 0, false); p1 = __builtin_amdgcn_cvt_pk_fp8_f32(hv[6], hv[7], p1, true);
                    *(PG8_GAS u32x2*)(H + (size_t)row * ldh + ch0) = (u32x2){(unsigned)p0, (unsigned)p1}; }
                if (m == 3 && fr >= 14) { const size_t ho = (size_t)((row >> 6) * 2 + fr - 14) * ldh + ch0;
                    *(PG8_GAS f32x4*)(HALO + ho) = (f32x4){gvv[0], gvv[1], gvv[2], gvv[3]}; *(PG8_GAS f32x4*)(HALO + ho + 4) = (f32x4){gvv[4], gvv[5], gvv[6], gvv[7]}; }
            }
    }
};

struct EpiDual {
    static constexpr bool AFTER_DRAIN = false;
    int mode; PG8_GAS bf16_t* O; int ldo; PG8_GAS bf16_t* Y; const PG8_GAS bf16_t* X; int split; int ldc; float alpha; PG8_GAS float* P;
    PG8_GAS unsigned char* H; const PG8_GAS float* cw; const PG8_GAS float* cb; PG8_GAS float* FIXG; PG8_GAS float* FIXU; PG8_GAS float* HALO; int ldh; const PG8_GAS float* SA; const PG8_GAS float* SWM;
    size_t kslab;
    __device__ __forceinline__ bool perm() const { return true; }
    __device__ __forceinline__ void operator()(const f32x4 (&acc)[2][2][4][2], const Unit& u, int wr, int wc, int fr, int fq) const {
        if (mode == 0) { EpiBf16P e{O, ldo, kslab, SA, SWM}; e(acc, u, wr, wc, fr, fq); } else if (mode == 1) { EpiF32R e{Y, X, split, ldc, alpha, P}; e(acc, u, wr, wc, fr, fq); }
        else { EpiConvGlu e{H, cw, cb, FIXG, FIXU, HALO, ldh, SA, SWM}; e(acc, u, wr, wc, fr, fq); }
    }
};
}
namespace pg8 {
template <class Epi, class Sched, bool ALIGN_EPI = false, bool SP2 = false, bool FP8 = false, bool I8 = false, int PV = 0>
__device__ __forceinline__ void gemm_phase(PG8_LAS unsigned char* lds, const Gemm g, const Sched& S, const Epi& E, const int tid) {
    const int wid = __builtin_amdgcn_readfirstlane(tid >> 6), lane = tid & 63, wr = wid >> 2, wc = wid & 3, fr = lane & 15, fq = lane >> 4;
    const int K = g.K, nt = K / BK;
    unsigned voffA[2], voffB[2];
#pragma unroll
    for (int i = 0; i < 2; ++i) { int R, C; stage_rc(tid * 16 + i * 8192, R, C); const int Rb = E.perm() ? ((R & ~31) + perm32(R & 31)) : R;
        voffA[i] = (unsigned)(R * K + C) * 2u; voffB[i] = (unsigned)(Rb * K + C) * 2u; }

#ifdef REP_KFIX
    const size_t kstep = g.kfix ? (size_t)0 : (size_t)(BK * 2);
#else
    const size_t kstep = (size_t)(BK * 2);
#endif
    const size_t hstep = (size_t)HALF * K * 2;
    const size_t tstep = 2 * hstep;
    const unsigned ldsw = (unsigned)wid * 1024u;
    const int aoff = lds_byte(wr * 64 + fr, fq * 8), boff = lds_byte(wc * 32 + fr, fq * 8);
#define PG8_SA(b, h) (((b) * 2 + (h)) * HTB)
#define PG8_SB(b, h) ((4 + (b) * 2 + (h)) * HTB)
#define PG8_STAGE(bufoff, gbase, voff) do { if constexpr (PV != 2) _Pragma("unroll") for (int _i = 0; _i < 2; ++_i) \
        __builtin_amdgcn_global_load_lds((const unsigned*)((const char*)(gbase) + (voff)[_i]), (PG8_LAS unsigned*)(lds + (bufoff) + ldsw + _i * 8192), 16, 0, 0); } while (0)
#define PG8_LDA(dst, b, h) do { _Pragma("unroll") for (int m = 0; m < 4; ++m) { if constexpr (FP8) { const bf16x8 lo_ = *(const PG8_LAS bf16x8*)(lds + PG8_SA(b, h) + aoff + m * 2048), hi_ = *(const PG8_LAS bf16x8*)(lds + PG8_SA(b, h) + aoff + m * 2048 + 1024); \
        dst##8[m] = __builtin_shufflevector(lo_, hi_, 0, 1, 2, 3, 4, 5, 6, 7, 8, 9, 10, 11, 12, 13, 14, 15); } else { _Pragma("unroll") for (int k = 0; k < 2; ++k) dst[m][k] = *(const PG8_LAS bf16x8*)(lds + PG8_SA(b, h) + aoff + m * 2048 + k * 1024); } } } while (0)
#define PG8_LDB(dst, b, h) do { _Pragma("unroll") for (int n = 0; n < 2; ++n) { if constexpr (FP8) { const bf16x8 lo_ = *(const PG8_LAS bf16x8*)(lds + PG8_SB(b, h) + boff + n * 2048), hi_ = *(const PG8_LAS bf16x8*)(lds + PG8_SB(b, h) + boff + n * 2048 + 1024); \
        dst##8[n] = __builtin_shufflevector(lo_, hi_, 0, 1, 2, 3, 4, 5, 6, 7, 8, 9, 10, 11, 12, 13, 14, 15); } else { _Pragma("unroll") for (int k = 0; k < 2; ++k) dst[n][k] = *(const PG8_LAS bf16x8*)(lds + PG8_SB(b, h) + boff + n * 2048 + k * 1024); } } } while (0)
#define PG8_MMA(ai, bj, At, Bt) do { __builtin_amdgcn_s_setprio(1); _Pragma("unroll") for (int m = 0; m < 4; ++m) _Pragma("unroll") for (int n = 0; n < 2; ++n) { \
        if constexpr (PV == 1) { if constexpr (FP8) asm volatile("" :: "v"(Bt##8[n]), "v"(At##8[m])); else asm volatile("" :: "v"(Bt[n][0]), "v"(At[m][0]), "v"(Bt[n][1]), "v"(At[m][1])); } else \
        if constexpr (FP8) asm volatile("v_mfma_scale_f32_16x16x128_f8f6f4 %0, %1, %2, %0, %3, %4 op_sel_hi:[0,0,0]" : "+v"(acc[ai][bj][m][n]) : "v"(__builtin_bit_cast(pg8_i32x8, Bt##8[n])), "v"(__builtin_bit_cast(pg8_i32x8, At##8[m])), "v"(swv), "v"(sav)); \
        else if constexpr (I8) { _Pragma("unroll") for (int k = 0; k < 2; ++k) asm volatile("v_mfma_i32_16x16x64_i8 %0, %1, %2, %0" : "+v"(acc[ai][bj][m][n]) : "v"(Bt[n][k]), "v"(At[m][k])); }     \
        else { _Pragma("unroll") for (int k = 0; k < 2; ++k) acc[ai][bj][m][n] = __builtin_amdgcn_mfma_f32_16x16x32_bf16(Bt[n][k], At[m][k], acc[ai][bj][m][n], 0, 0, 0); } } \
        __builtin_amdgcn_s_setprio(0); } while (0)
#define PG8_WAIT_V(n) asm volatile("s_waitcnt vmcnt(" #n ")" ::: "memory")
#define PG8_WAIT_L(n) asm volatile("s_waitcnt lgkmcnt(" #n ")" ::: "memory")
#define PG8_BAR __builtin_amdgcn_s_barrier()
#define PG8_SCHED __builtin_amdgcn_sched_barrier(0)
    Unit cur, nxt; int ui = 0;
    if (!S.next(0, cur)) return;
    int swv = g.sw, sav = g.sa; asm volatile("" : "+v"(swv), "+v"(sav));
    f32x4 acc[2][2][4][2];
#pragma unroll
    for (int a = 0; a < 2; ++a)
#pragma unroll
        for (int b = 0; b < 2; ++b)
#pragma unroll
            for (int m = 0; m < 4; ++m)
#pragma unroll
                for (int n = 0; n < 2; ++n) acc[a][b][m][n] = (f32x4){0.f, 0.f, 0.f, 0.f};
    typedef short pg8_s16x16 __attribute__((ext_vector_type(16))); typedef int pg8_i32x8 __attribute__((ext_vector_type(8)));
    bf16x8 At[4][2], B0[2][2], B1[2][2];
    pg8_s16x16 At8[4], B08[2], B18[2];
    const char* cA = (const char*)g.A + (size_t)cur.pm * tstep + (size_t)cur.k0 * kstep; const char* cB = (const char*)g.Bt + (size_t)cur.pn * tstep + (size_t)cur.k0 * kstep;
    int cnt = cur.ntk ? cur.ntk : nt;
    S.a_ready(cur);
    if constexpr (SP2) {
        PG8_STAGE(PG8_SB(0, 0), cB, voffB); PG8_STAGE(PG8_SB(0, 1), cB + hstep, voffB); PG8_STAGE(PG8_SA(0, 0), cA, voffA); PG8_STAGE(PG8_SA(0, 1), cA + hstep, voffA);
        if (wr == 1) PG8_BAR;
        PG8_WAIT_V(2); PG8_BAR;
        PG8_STAGE(PG8_SB(1, 0), cB + kstep, voffB); PG8_STAGE(PG8_SA(1, 0), cA + kstep, voffA); PG8_STAGE(PG8_SB(1, 1), cB + hstep + kstep, voffB);
        PG8_WAIT_V(6); PG8_BAR;
    } else {
        PG8_STAGE(PG8_SB(0, 0), cB, voffB); PG8_STAGE(PG8_SA(0, 0), cA, voffA); PG8_STAGE(PG8_SB(0, 1), cB + hstep, voffB); PG8_STAGE(PG8_SA(0, 1), cA + hstep, voffA);
        if (wr == 1) PG8_BAR;
        PG8_WAIT_V(4); PG8_BAR;
        PG8_STAGE(PG8_SB(1, 0), cB + kstep, voffB); PG8_STAGE(PG8_SA(1, 0), cA + kstep, voffA); PG8_STAGE(PG8_SB(1, 1), cB + hstep + kstep, voffB);
        PG8_WAIT_V(6); PG8_BAR;
    }
    for (;;) {
        const bool has_next = S.next(ui + 1, nxt);
        const char* nA = has_next ? (const char*)g.A + (size_t)nxt.pm * tstep + (size_t)nxt.k0 * kstep : cA; const char* nB = has_next ? (const char*)g.Bt + (size_t)nxt.pn * tstep + (size_t)nxt.k0 * kstep : cB;
        for (int t = 0; t < cnt; t += 2) {
            const bool last = (t == cnt - 2);
            const char* a1 = cA + (size_t)(t + 1) * kstep;
            const char* a2 = last ? nA : cA + (size_t)(t + 2) * kstep; const char* b2 = last ? nB : cB + (size_t)(t + 2) * kstep;
            const char* a3 = a2 + kstep; const char* b3 = b2 + kstep;
            if (last && has_next) S.a_ready(nxt);
            if constexpr (SP2) {
            PG8_LDB(B0, 0, 0); PG8_LDB(B1, 0, 1); PG8_SCHED; PG8_LDA(At, 0, 0); PG8_STAGE(PG8_SA(1, 1), a1 + hstep, voffA);
            PG8_WAIT_V(8); PG8_WAIT_L(0); PG8_BAR; PG8_MMA(0, 0, At, B0); PG8_MMA(0, 1, At, B1); PG8_BAR; PG8_SCHED;
            PG8_LDA(At, 0, 1); PG8_STAGE(PG8_SB(0, 0), b2, voffB); PG8_STAGE(PG8_SB(0, 1), b2 + hstep, voffB); PG8_STAGE(PG8_SA(0, 0), a2, voffA);
            PG8_WAIT_V(8); PG8_WAIT_L(0); PG8_BAR; PG8_MMA(1, 0, At, B0); PG8_MMA(1, 1, At, B1); PG8_BAR; PG8_SCHED;
            PG8_LDB(B0, 1, 0); PG8_LDB(B1, 1, 1); PG8_SCHED; PG8_LDA(At, 1, 0); PG8_STAGE(PG8_SA(0, 1), a2 + hstep, voffA);
            PG8_WAIT_V(8); PG8_WAIT_L(0); PG8_BAR; PG8_MMA(0, 0, At, B0); PG8_MMA(0, 1, At, B1); PG8_BAR; PG8_SCHED;
            PG8_LDA(At, 1, 1); PG8_STAGE(PG8_SB(1, 0), b3, voffB); PG8_STAGE(PG8_SB(1, 1), b3 + hstep, voffB); PG8_STAGE(PG8_SA(1, 0), a3, voffA);
            PG8_WAIT_V(8); PG8_WAIT_L(0); PG8_BAR; PG8_MMA(1, 0, At, B0); PG8_MMA(1, 1, At, B1); PG8_BAR; PG8_SCHED;
            } else {
            PG8_LDB(B0, 0, 0); PG8_SCHED; PG8_LDA(At, 0, 0); PG8_STAGE(PG8_SA(1, 1), a1 + hstep, voffA);
            PG8_WAIT_L(8); PG8_BAR; PG8_WAIT_L(0); PG8_MMA(0, 0, At, B0); PG8_BAR; PG8_SCHED;
            PG8_LDB(B1, 0, 1); PG8_STAGE(PG8_SB(0, 0), b2, voffB);
            PG8_BAR; PG8_WAIT_L(0); PG8_MMA(0, 1, At, B1); PG8_BAR;
            PG8_LDA(At, 0, 1); PG8_STAGE(PG8_SA(0, 0), a2, voffA);
            PG8_BAR; PG8_WAIT_L(0); PG8_MMA(1, 0, At, B0); PG8_BAR; PG8_SCHED;
            PG8_STAGE(PG8_SB(0, 1), b2 + hstep, voffB);
            PG8_WAIT_V(6); PG8_BAR; PG8_MMA(1, 1, At, B1); PG8_BAR;
            PG8_LDB(B0, 1, 0); PG8_SCHED; PG8_LDA(At, 1, 0); PG8_STAGE(PG8_SA(0, 1), a2 + hstep, voffA);
            PG8_WAIT_L(8); PG8_BAR; PG8_WAIT_L(0); PG8_MMA(0, 0, At, B0); PG8_BAR; PG8_SCHED;
            PG8_LDB(B1, 1, 1); PG8_STAGE(PG8_SB(1, 0), b3, voffB);
            PG8_BAR; PG8_WAIT_L(0); PG8_MMA(0, 1, At, B1); PG8_BAR;
            PG8_LDA(At, 1, 1); PG8_STAGE(PG8_SA(1, 0), a3, voffA);
            PG8_BAR; PG8_WAIT_L(0); PG8_MMA(1, 0, At, B0); PG8_BAR; PG8_SCHED;
            PG8_STAGE(PG8_SB(1, 1), b3 + hstep, voffB);
            PG8_WAIT_V(6); PG8_BAR; PG8_MMA(1, 1, At, B1); PG8_BAR;
            }
        }
        if constexpr (ALIGN_EPI) { if (wr == 0) PG8_BAR; }
        if constexpr (FP8 || I8) asm volatile("s_nop 15\n\ts_nop 15" ::: "memory");
        if constexpr (!Epi::AFTER_DRAIN) { int l2_; asm volatile("v_mbcnt_lo_u32_b32 %0, -1, 0\n\tv_mbcnt_hi_u32_b32 %0, -1, %0" : "=v"(l2_));
            E(acc, cur, wr, wc, l2_ & 15, l2_ >> 4); S.done(cur); }
        if (!has_next) break;
#pragma unroll
        for (int a = 0; a < 2; ++a)
#pragma unroll
            for (int b = 0; b < 2; ++b)
#pragma unroll
                for (int m = 0; m < 4; ++m)
#pragma unroll
                    for (int n = 0; n < 2; ++n) acc[a][b][m][n] = (f32x4){0.f, 0.f, 0.f, 0.f};
        cur = nxt; cA = nA; cB = nB; ++ui; cnt = cur.ntk ? cur.ntk : nt;
        if constexpr (ALIGN_EPI) { if (wr == 1) PG8_BAR; }
    }
    PG8_WAIT_V(0);
    if constexpr (!ALIGN_EPI) { if (wr == 0) PG8_BAR; }
    PG8_BAR;
    if constexpr (Epi::AFTER_DRAIN) { E.fused(acc, cur, wr, wc, fr, fq, lds, wid, lane); S.done(cur); }
#undef PG8_SA
#undef PG8_SB
#undef PG8_STAGE
#undef PG8_LDA
#undef PG8_LDB
#undef PG8_MMA
#undef PG8_WAIT_V
#undef PG8_WAIT_L
#undef PG8_BAR
#undef PG8_SCHED
}
}
#define GAS __attribute__((address_space(1)))
#define LAS __attribute__((address_space(3)))
typedef unsigned short bf16;
typedef unsigned v4u __attribute__((ext_vector_type(4)));
typedef float f32x4 __attribute__((ext_vector_type(4)));
typedef short bf16x8 __attribute__((ext_vector_type(8)));
typedef GAS unsigned gu32;
typedef GAS unsigned long long gu64;
#define RLX_AGENT __ATOMIC_RELAXED, __HIP_MEMORY_SCOPE_AGENT
#define LDS_WAIT() asm volatile("s_waitcnt lgkmcnt(0)" ::: "memory")
#define VM_WAIT() asm volatile("s_waitcnt vmcnt(0)" ::: "memory")
__device__ __forceinline__ unsigned long long rt() { return __builtin_amdgcn_s_memrealtime(); }
__device__ __forceinline__ unsigned f2bf(float f) { unsigned u = __builtin_bit_cast(unsigned, f); return (u + 0x7fffu + ((u >> 16) & 1u)) >> 16; }
__device__ __forceinline__ unsigned pk2(float lo, float hi) { return f2bf(lo) | (f2bf(hi) << 16); }
#define XB_TMO      128
#define XB_XCNT(j)  (256  + 64 * (j))
#define XB_XSUB(j)  (1280 + 64 * (j))
#define XB_XGEN(j)  (2304 + 64 * (j))
#define XB_TOP      3328
#define XB_TOPGEN   3392
#define XCD_BAR_WORDS 3456
#define XB_SPIN_CAP (1u << 18)

__device__ __forceinline__ unsigned xb_ld(unsigned* p)              { return __hip_atomic_load(p, __ATOMIC_RELAXED, __HIP_MEMORY_SCOPE_AGENT); }
__device__ __forceinline__ unsigned xb_add(unsigned* p, unsigned v) { return __hip_atomic_fetch_add(p, v, __ATOMIC_RELAXED, __HIP_MEMORY_SCOPE_AGENT); }
__device__ __forceinline__ unsigned xb_xcc_id() { return (unsigned)__builtin_amdgcn_s_getreg((3 << 11) | 20) & 0xFu; }
#define XB_SPIN(cond, bar) do { unsigned _sp = 0; while (cond) { __builtin_amdgcn_s_sleep(1); \
    if ((++_sp & 255u) == 0u) { if (xb_ld(&(bar)[XB_TMO])) break; if (_sp > XB_SPIN_CAP) { atomicAdd(&(bar)[XB_TMO], 1u); break; } } } } while (0)

struct XcdBarrier {
    unsigned* bar; unsigned x;
    volatile LAS unsigned* st;
};

__device__ __forceinline__ XcdBarrier xcd_barrier_post(unsigned* bar, volatile LAS unsigned* st) {
    XcdBarrier b; b.bar = bar; b.x = xb_xcc_id(); b.st = st;
    if (threadIdx.x == 0) (void)xb_add(&bar[XB_XCNT(b.x)], 1u);
    return b;
}
__device__ __forceinline__ void xcd_barrier_complete(unsigned* bar, unsigned x, unsigned& nloc, unsigned& nx) {
    const unsigned G = gridDim.x * gridDim.y * gridDim.z;
    unsigned sum, cnt, mine, sp = 0u;
    for (;;) {
        sum = 0u; cnt = 0u; mine = 0u;
#pragma unroll
        for (unsigned j = 0; j < 16; ++j) { const unsigned c = xb_ld(&bar[XB_XCNT(j)]); sum += c; cnt += (c > 0u) ? 1u : 0u; mine = (j == x) ? c : mine; }
        if (sum == G) break;
        __builtin_amdgcn_s_sleep(1);
        if ((++sp & 255u) == 0u) { if (xb_ld(&bar[XB_TMO])) break; if (sp > XB_SPIN_CAP) { atomicAdd(&bar[XB_TMO], 1u); break; } }
    }
    nloc = mine > 0u ? mine : 1u; nx = cnt > 0u ? cnt : 1u;
}

__device__ __forceinline__ void xcd_barrier(const XcdBarrier& b, const int tid_) {
    asm volatile("s_waitcnt vmcnt(0)" ::: "memory");
    __syncthreads();
    if (tid_ == 0) {
        unsigned* bar = b.bar;
        __builtin_amdgcn_s_waitcnt(0);
        unsigned nloc = b.st[0], nx = b.st[1];
        if (nloc == 0u) { xcd_barrier_complete(bar, b.x, nloc, nx); b.st[0] = nloc; b.st[1] = nx; }
        const unsigned old = xb_add(&bar[XB_XSUB(b.x)], 1u);
        const unsigned gen = old / nloc;
        if (old + 1u == (gen + 1u) * nloc) {
            __builtin_amdgcn_fence(__ATOMIC_RELEASE, "agent");
            asm volatile("s_waitcnt vmcnt(0)" ::: "memory");
            const unsigned og = xb_add(&bar[XB_TOP], 1u);
            const unsigned tg = og / nx;
            if (og + 1u == (tg + 1u) * nx) xb_add(&bar[XB_TOPGEN], 1u);
            else XB_SPIN(xb_ld(&bar[XB_TOPGEN]) == tg, bar);
            __builtin_amdgcn_fence(__ATOMIC_ACQUIRE, "agent");
            xb_add(&bar[XB_XGEN(b.x)], 1u);
            asm volatile("s_waitcnt vmcnt(0)" ::: "memory");
        } else {
            XB_SPIN(xb_ld(&bar[XB_XGEN(b.x)]) == gen, bar);
            __builtin_amdgcn_fence(__ATOMIC_ACQUIRE, "agent");
            asm volatile("s_waitcnt vmcnt(0)" ::: "memory");
        }
    }
    __syncthreads();
}

constexpr int NWAVES = 8, NTHR = 512;
constexpr int DM = 2048, NPROW = 8192, MROWS = 10240, SEQ = 4096, DSEQ = 64, PAST = 2048, LSK = 2112, DFF = 5632;
constexpr int NBCV = 6144, NGU = 11264, NPROJ = 5376, NATT = 5264, KVW = 512, IDXD = 128;
constexpr int SCS_LD = 2304;
constexpr float LN_EPS = 1e-5f, DN_ALPHA = 1.4142135623730951f, ATTN_SC2 = 0.08838834764831845f * 1.4426950408889634f, IDX_W_SCALE = 0.022097086912079608f;
constexpr size_t O_YP = 0, O_YS = 16777216, O_CMP = 20971520, O_KP = 20979712, O_VP = 25174016, O_IKP = 29368320, O_FCP = 30416896,
                 O_CMS = 30461952, O_KS = 30593024, O_VS = 31641600, O_IKS = 32690176, O_FCS = 32952320, O_END = 33673216;
constexpr size_t MiB = 1u << 20;
constexpr size_t WS_CTL = 0, CTL_ZERO_BYTES = 1 * MiB;
constexpr size_t WS_WMI = 1 * MiB, WS_WMO = 25 * MiB, WS_WAI = 33 * MiB, WS_WAO = 54 * MiB, WS_WF1 = 62 * MiB, WS_WF2 = 150 * MiB;
constexpr size_t WF1_STRIDE = 44 * MiB, WF2_STRIDE = 22 * MiB;
constexpr size_t WS_XB = 194 * MiB, WS_XF = 234 * MiB  , WS_Y = 314 * MiB, WS_BIG = 394 * MiB, WS_H = 614 * MiB, WS_END = 724 * MiB;
constexpr size_t WS_KP = 1 * MiB, WS_VP = 9 * MiB, WS_IKP = 17 * MiB, WS_IW = 19 * MiB, WS_SEL = 20 * MiB;
constexpr size_t WS_IKS = 62 * MiB;
constexpr size_t WS_KS = 314 * MiB;
constexpr size_t WS_PROJ = 394 * MiB, WS_SCP = 394 * MiB, WS_SCS = 522 * MiB, WS_VS = 548 * MiB;
constexpr size_t WS_QR = 614 * MiB, WS_IQ = 654 * MiB;
constexpr int CW_BAR = 4096;

typedef const GAS float* gcf; typedef GAS float* gf; typedef const GAS bf16* gcb; typedef GAS bf16* gb; typedef const GAS int* gci; typedef GAS int* gi;
typedef float f32x16 __attribute__((ext_vector_type(16)));
typedef float f32x2 __attribute__((ext_vector_type(2)));
__device__ __forceinline__ float bflo(unsigned w) { return __uint_as_float(w << 16); }
__device__ __forceinline__ float bfhi(unsigned w) { return __uint_as_float(w & 0xffff0000u); }
__device__ __forceinline__ float bf1(bf16 h) { return __uint_as_float((unsigned)h << 16); }
__device__ __forceinline__ void unpack8(const v4u w, float (&f)[8]) { f[0] = bflo(w.x); f[1] = bfhi(w.x); f[2] = bflo(w.y); f[3] = bfhi(w.y); f[4] = bflo(w.z); f[5] = bfhi(w.z); f[6] = bflo(w.w); f[7] = bfhi(w.w); }
__device__ __forceinline__ v4u pack8(const float (&f)[8]) { v4u o; o.x = pk2(f[0], f[1]); o.y = pk2(f[2], f[3]); o.z = pk2(f[4], f[5]); o.w = pk2(f[6], f[7]); return o; }
__device__ __forceinline__ void ldf8(gcf p, float (&f)[8]) { const f32x4 a = *(const GAS f32x4*)p, b = *(const GAS f32x4*)(p + 4); f[0] = a.x; f[1] = a.y; f[2] = a.z; f[3] = a.w; f[4] = b.x; f[5] = b.y; f[6] = b.z; f[7] = b.w; }
__device__ __forceinline__ void ldf8_nt(gcf p, float (&f)[8]) { const f32x4 a = __builtin_nontemporal_load((const GAS f32x4*)p), b = __builtin_nontemporal_load((const GAS f32x4*)(p + 4)); f[0] = a.x; f[1] = a.y; f[2] = a.z; f[3] = a.w; f[4] = b.x; f[5] = b.y; f[6] = b.z; f[7] = b.w; }
__device__ __forceinline__ void stf8_nt(gf p, const float (&f)[8]) { __builtin_nontemporal_store((f32x4){f[0], f[1], f[2], f[3]}, (GAS f32x4*)p); __builtin_nontemporal_store((f32x4){f[4], f[5], f[6], f[7]}, (GAS f32x4*)(p + 4)); }
__device__ __forceinline__ void stf8(gf p, const float (&f)[8]) { *(GAS f32x4*)p = (f32x4){f[0], f[1], f[2], f[3]}; *(GAS f32x4*)(p + 4) = (f32x4){f[4], f[5], f[6], f[7]}; }
__device__ __forceinline__ unsigned pk4_fp8(float a, float b, float c, float d) {
    a = fminf(fmaxf(a, -448.f), 448.f); b = fminf(fmaxf(b, -448.f), 448.f); c = fminf(fmaxf(c, -448.f), 448.f); d = fminf(fmaxf(d, -448.f), 448.f);
    int w = __builtin_amdgcn_cvt_pk_fp8_f32(a, b, 0, false); w = __builtin_amdgcn_cvt_pk_fp8_f32(c, d, w, true); return (unsigned)w; }
__device__ __forceinline__ unsigned pk4_fp8_nc(float a, float b, float c, float d) {
    int w = __builtin_amdgcn_cvt_pk_fp8_f32(a, b, 0, false); w = __builtin_amdgcn_cvt_pk_fp8_f32(c, d, w, true); return (unsigned)w; }
__device__ __forceinline__ unsigned pk4_i8(float a, float b, float c, float d) {
    const int ia = (int)__builtin_rintf(a), ib = (int)__builtin_rintf(b), ic = (int)__builtin_rintf(c), id = (int)__builtin_rintf(d);
    return (unsigned)(ia & 0xff) | ((unsigned)(ib & 0xff) << 8) | ((unsigned)(ic & 0xff) << 16) | ((unsigned)id << 24); }
__device__ __forceinline__ float shfl_f(float v, int src) { return __int_as_float(__builtin_amdgcn_ds_bpermute(src << 2, __float_as_int(v))); }
__device__ __forceinline__ float wave_sum(float v, int lane) {
#pragma unroll
    for (int o = 1; o < 64; o <<= 1) v += shfl_f(v, lane ^ o);
    return v;
}
__device__ __forceinline__ int wave_sum_i(int v, int lane) {
#pragma unroll
    for (int o = 1; o < 64; o <<= 1) v += __builtin_amdgcn_ds_bpermute((lane ^ o) << 2, v);
    return v;
}

__device__ __forceinline__ void tr_col_bf16(gcf W, int N, int k0, int n_src, bool ok, GAS v4u* dst) {
    float v[64]; const int nc = ok ? n_src : 0;
#pragma unroll
    for (int j = 0; j < 64; ++j) v[j] = __builtin_nontemporal_load(W + (size_t)(k0 + j) * N + nc);
#pragma unroll
    for (int c = 0; c < 8; ++c) { v4u o; o.x = pk2(v[8 * c], v[8 * c + 1]); o.y = pk2(v[8 * c + 2], v[8 * c + 3]); o.z = pk2(v[8 * c + 4], v[8 * c + 5]); o.w = pk2(v[8 * c + 6], v[8 * c + 7]);
        if (!ok) o = (v4u){0u, 0u, 0u, 0u}; dst[c] = o; }
}
__device__ __forceinline__ void tr_col_fp8(gcf W, int N, int k0, int n_src, GAS v4u* dst) {
    float v[64];
#pragma unroll
    for (int j = 0; j < 64; ++j) v[j] = __builtin_nontemporal_load(W + (size_t)(k0 + j) * N + n_src) * 256.f;
#pragma unroll
    for (int c = 0; c < 4; ++c) { v4u o; o.x = pk4_fp8(v[16 * c], v[16 * c + 1], v[16 * c + 2], v[16 * c + 3]); o.y = pk4_fp8(v[16 * c + 4], v[16 * c + 5], v[16 * c + 6], v[16 * c + 7]);
        o.z = pk4_fp8(v[16 * c + 8], v[16 * c + 9], v[16 * c + 10], v[16 * c + 11]); o.w = pk4_fp8(v[16 * c + 12], v[16 * c + 13], v[16 * c + 14], v[16 * c + 15]); dst[c] = o; }
}
__device__ __forceinline__ void absmax_item(gcf W, int N, int item, int lane, GAS unsigned* SWMbits, int glu) {
    const int nblk = N / 64, kb = item / nblk, nb = item - kb * nblk, k0 = 64 * kb, n = 64 * nb + lane;
    float v[64]; float mx = 0.f;
#pragma unroll
    for (int j = 0; j < 64; ++j) v[j] = __builtin_nontemporal_load(W + (size_t)(k0 + j) * N + n);
#pragma unroll
    for (int j = 0; j < 64; ++j) mx = fmaxf(mx, fabsf(v[j]));
    int no = n; if (glu) { const int up = n >= N / 2, c = up ? n - N / 2 : n; no = 256 * (c >> 7) + (c & 127) + (up ? 128 : 0); }
    __hip_atomic_fetch_max(SWMbits + no, __float_as_uint(mx), __ATOMIC_RELAXED, __HIP_MEMORY_SCOPE_AGENT);
}
__device__ __forceinline__ void absmax_tr_item(gcf W, int N, int item, int lane, GAS unsigned* SWMbits, int glu, gb Tlo, gb Thi, int nsplit, int K) {
    const int nblk = N / 64, kb = item / nblk, nb = item - kb * nblk, k0 = 64 * kb, n = 64 * nb + lane;
    float v[64]; float mx = 0.f;
#pragma unroll
    for (int j = 0; j < 64; ++j) v[j] = __builtin_nontemporal_load(W + (size_t)(k0 + j) * N + n);
#pragma unroll
    for (int j = 0; j < 64; ++j) mx = fmaxf(mx, fabsf(v[j]));
    int no = n; if (glu) { const int up = n >= N / 2, c = up ? n - N / 2 : n; no = 256 * (c >> 7) + (c & 127) + (up ? 128 : 0); }
    __hip_atomic_fetch_max(SWMbits + no, __float_as_uint(mx), __ATOMIC_RELAXED, __HIP_MEMORY_SCOPE_AGENT);
    GAS v4u* dst = (GAS v4u*)((n < nsplit ? Tlo + (size_t)n * K : Thi + (size_t)(n - nsplit) * K) + k0);
#pragma unroll
    for (int c = 0; c < 8; ++c) { v4u o; o.x = pk2(v[8 * c], v[8 * c + 1]); o.y = pk2(v[8 * c + 2], v[8 * c + 3]); o.z = pk2(v[8 * c + 4], v[8 * c + 5]); o.w = pk2(v[8 * c + 6], v[8 * c + 7]); dst[c] = o; }
}
__device__ __forceinline__ void quant_row_ld(gcb src, int lane, v4u (&w)[4]) {
#pragma unroll
    for (int j = 0; j < 4; ++j) w[j] = *(const GAS v4u*)(src + 8 * lane + 512 * j);
}
__device__ __forceinline__ void quant_row_st(const v4u (&w)[4], float mx, GAS unsigned char* dst, int lane) {
    typedef unsigned u32x2t __attribute__((ext_vector_type(2)));
    const float inv = mx > 0.f ? 127.f / mx : 0.f;
#pragma unroll
    for (int j = 0; j < 4; ++j) { float f[8]; unpack8(w[j], f);
        *(GAS u32x2t*)(dst + 8 * lane + 512 * j) = (u32x2t){pk4_i8(f[0] * inv, f[1] * inv, f[2] * inv, f[3] * inv), pk4_i8(f[4] * inv, f[5] * inv, f[6] * inv, f[7] * inv)}; }
}
__device__ __forceinline__ void quant_item(gcf W, int K, int N, GAS unsigned char* WI, gb WG, gcf SWM, int item, int lane, int glu) {
    const int nblk = N / 64, kb = item / nblk, nb = item - kb * nblk, k0 = 64 * kb, n = 64 * nb + lane;
    int up, c, no; if (glu) { up = n >= N / 2; c = up ? n - N / 2 : n; no = 256 * (c >> 7) + (c & 127) + (up ? 128 : 0); } else { up = n < 2048; c = n - 2048; no = n; }
    float v[64];
#pragma unroll
    for (int j = 0; j < 64; ++j) v[j] = __builtin_nontemporal_load(W + (size_t)(k0 + j) * N + n);
    const float mx = SWM[no], inv = mx > 0.f ? 127.f / mx : 0.f;
    GAS v4u* dst = (GAS v4u*)(WI + (size_t)no * K + k0);
#pragma unroll
    for (int q = 0; q < 4; ++q) { v4u o; o.x = pk4_i8(v[16 * q] * inv, v[16 * q + 1] * inv, v[16 * q + 2] * inv, v[16 * q + 3] * inv); o.y = pk4_i8(v[16 * q + 4] * inv, v[16 * q + 5] * inv, v[16 * q + 6] * inv, v[16 * q + 7] * inv);
        o.z = pk4_i8(v[16 * q + 8] * inv, v[16 * q + 9] * inv, v[16 * q + 10] * inv, v[16 * q + 11] * inv); o.w = pk4_i8(v[16 * q + 12] * inv, v[16 * q + 13] * inv, v[16 * q + 14] * inv, v[16 * q + 15] * inv); dst[q] = o; }
    if (!up) { GAS v4u* dg = (GAS v4u*)(WG + (size_t)c * K + k0);
#pragma unroll
        for (int q = 0; q < 8; ++q) { v4u o; o.x = pk2(v[8 * q], v[8 * q + 1]); o.y = pk2(v[8 * q + 2], v[8 * q + 3]); o.z = pk2(v[8 * q + 4], v[8 * q + 5]); o.w = pk2(v[8 * q + 6], v[8 * q + 7]); dg[q] = o; } }
}
__device__ __forceinline__ void transpose_item(gcf W, int K, int N, int Npad, gb WT, int item, int lane, int glu = 0) {
    const int nblk = Npad / 64, kb = item / nblk, nb = item - kb * nblk, k0 = 64 * kb, n = 64 * nb + lane;
    int no = n; if (glu) { const int up = n >= N / 2, c = up ? n - N / 2 : n; no = 256 * (c >> 7) + (c & 127) + (up ? 128 : 0); }
    tr_col_bf16(W, N, k0, n, n < N, (GAS v4u*)(WT + (size_t)no * K + k0));
}
__device__ __forceinline__ void transpose_item8(gcf W, int K, int N, GAS unsigned char* WT, int item, int lane) {
    const int nblk = N / 64, kb = item / nblk, nb = item - kb * nblk, k0 = 64 * kb, n = 64 * nb + lane;
    tr_col_fp8(W, N, k0, n, (GAS v4u*)(WT + (size_t)n * K + k0));
}
__device__ __forceinline__ void cvt_rows(gcf src, gb dst, int cps, size_t dstride, int total, int gt, int GT) {
    for (int e = gt; e < total; e += GT) { const int sb = e / cps, rem = e - sb * cps; float f[8]; ldf8_nt(src + (size_t)e * 8, f); *(GAS v4u*)(dst + (size_t)sb * dstride + (size_t)rem * 8) = pack8(f); }
}

__device__ __forceinline__ int kperm(int d) { return (d & 64) | ((d & 24) << 1) | ((d & 32) >> 2) | (d & 7); }
__device__ __forceinline__ void cvt_rows_k8(gcf src, GAS unsigned char* dst, int cps, size_t dstride, int total, int gt, int GT) {
    typedef unsigned u32x2t __attribute__((ext_vector_type(2)));
    for (int e = gt; e < total; e += GT) { const int sb = e / cps, rem = e - sb * cps; const int row = rem >> 6, c = rem & 63; float f[8]; ldf8_nt(src + (size_t)e * 8, f);
        *(GAS u32x2t*)(dst + (size_t)sb * dstride + ((size_t)(c >> 4) * LSK + row) * 128 + kperm((c & 15) * 8)) = (u32x2t){pk4_fp8(f[0] * 16.f, f[1] * 16.f, f[2] * 16.f, f[3] * 16.f), pk4_fp8(f[4] * 16.f, f[5] * 16.f, f[6] * 16.f, f[7] * 16.f)}; }
}

__device__ __forceinline__ void cvt_rows_v8(gcf src, GAS unsigned char* dst, int cps, size_t dstride, int total, int gt, int GT) {
    typedef unsigned u32x2t __attribute__((ext_vector_type(2)));
    for (int e = gt; e < total; e += GT) { const int sb = e / cps, rem = e - sb * cps; const int row = rem >> 6, c = rem & 63; float f[8]; ldf8_nt(src + (size_t)e * 8, f);
        *(GAS u32x2t*)(dst + (size_t)sb * dstride + ((size_t)(c >> 4) * LSK + row) * 128 + (c & 15) * 8) = (u32x2t){pk4_fp8(f[0] * 16.f, f[1] * 16.f, f[2] * 16.f, f[3] * 16.f), pk4_fp8(f[4] * 16.f, f[5] * 16.f, f[6] * 16.f, f[7] * 16.f)}; }
}

__device__ __forceinline__ void xrows_phase(gcf xp, gcf xs, gb XB, GAS unsigned char* XI, gf SA, gb XS, int gw, int NGW, int lane) {
    for (int row = gw; row < MROWS; row += NGW) {
        gcf xr = row < NPROW ? xp + (size_t)row * DM : xs + (size_t)(row - NPROW) * DM; float v[4][8]; float amax = 0.f;
#pragma unroll
        for (int j = 0; j < 4; ++j) { ldf8_nt(xr + 8 * lane + 512 * j, v[j]);
#pragma unroll
            for (int e = 0; e < 8; ++e) amax = fmaxf(amax, fabsf(v[j][e])); }
#pragma unroll
        for (int o_ = 1; o_ < 64; o_ <<= 1) amax = fmaxf(amax, shfl_f(amax, lane ^ o_));
        const float inv = amax > 0.f ? 127.f / amax : 0.f; typedef unsigned u32x2t __attribute__((ext_vector_type(2)));
        const bool is_s = row >= NPROW; const int t = is_s ? ((row - NPROW) & 63) : (row & 4095), T = is_s ? DSEQ : SEQ;
        const int srow = (is_s ? 4 + ((row - NPROW) >> 6) * 2 : (row >> 12) * 2) + (t - (T - 2));
#pragma unroll
        for (int j = 0; j < 4; ++j) { const v4u pb = pack8(v[j]); *(GAS v4u*)(XB + (size_t)row * DM + 8 * lane + 512 * j) = pb;
            *(GAS u32x2t*)(XI + (size_t)row * DM + 8 * lane + 512 * j) = (u32x2t){pk4_i8(v[j][0] * inv, v[j][1] * inv, v[j][2] * inv, v[j][3] * inv), pk4_i8(v[j][4] * inv, v[j][5] * inv, v[j][6] * inv, v[j][7] * inv)};
            if (t >= T - 2) *(GAS v4u*)(XS + (size_t)srow * DM + 8 * lane + 512 * j) = pb; }
        if (lane == 0) SA[row] = amax * (1.f / 127.f);
    }
}

__device__ __forceinline__ void conv_mix_phase(gcb BCV, gb Z, gcf cw, gcf state, gf out, gcb GS, int gt, int GT) {
    for (int task = gt; task < (MROWS / 16) * 256; task += GT) {
        const int cg = task & 255, seg = task >> 8, row0 = seg * 16, c0 = cg * 8;
        const bool is_s = row0 >= NPROW; const int tl = is_s ? ((row0 - NPROW) & 63) : (row0 & 4095); const int sb = is_s ? ((row0 - NPROW) >> 6) : (row0 >> 12); const int T = is_s ? DSEQ : SEQ;
        float w0[8], w1[8], w2[8]; ldf8(cw + c0, w0); ldf8(cw + DM + c0, w1); ldf8(cw + 2 * DM + c0, w2);
        float um2[8], um1[8];
        if (tl == 0) {
            if (is_s) { ldf8(state + (size_t)(sb * 2 + 0) * DM + c0, um2); ldf8(state + (size_t)(sb * 2 + 1) * DM + c0, um1); }
            else {
#pragma unroll
                for (int e = 0; e < 8; ++e) { um2[e] = 0.f; um1[e] = 0.f; } }
        } else {
            float c8[8], v8[8];
            gcb p2 = BCV + (size_t)(row0 - 2) * NBCV + c0; unpack8(*(const GAS v4u*)(p2 + DM), c8); unpack8(*(const GAS v4u*)(p2 + 2 * DM), v8);
#pragma unroll
            for (int e = 0; e < 8; ++e) um2[e] = c8[e] * v8[e];
            gcb p1 = p2 + NBCV; unpack8(*(const GAS v4u*)(p1 + DM), c8); unpack8(*(const GAS v4u*)(p1 + 2 * DM), v8);
#pragma unroll
            for (int e = 0; e < 8; ++e) um1[e] = c8[e] * v8[e];
        }
#pragma unroll 4
        for (int r = 0; r < 16; ++r) {
            const int row = row0 + r; gcb p = BCV + (size_t)row * NBCV + c0;
            float b8[8], c8[8], v8[8], u[8], z[8];
            unpack8(__builtin_nontemporal_load((const GAS v4u*)p), b8); unpack8(__builtin_nontemporal_load((const GAS v4u*)(p + DM)), c8); unpack8(__builtin_nontemporal_load((const GAS v4u*)(p + 2 * DM)), v8);
#pragma unroll
            for (int e = 0; e < 8; ++e) { u[e] = c8[e] * v8[e]; z[e] = b8[e] * (w0[e] * um2[e] + w1[e] * um1[e] + w2[e] * u[e]); }
            *(GAS v4u*)(Z + (size_t)row * DM + c0) = pack8(z);
            const int j = tl + r - (T - 2);
            if (j >= 0) { const int srow = (is_s ? 4 + sb * 2 : sb * 2) + j; float ca[8], cb_[8], va[8], vb[8], us[8];
                unpack8(*(const GAS v4u*)(GS + (size_t)srow * 4096 + c0), ca); unpack8(*(const GAS v4u*)(GS + (size_t)(256 + srow) * 4096 + c0), cb_);
                unpack8(*(const GAS v4u*)(GS + (size_t)srow * 4096 + 2048 + c0), va); unpack8(*(const GAS v4u*)(GS + (size_t)(256 + srow) * 4096 + 2048 + c0), vb);
#pragma unroll
                for (int e = 0; e < 8; ++e) us[e] = (ca[e] + cb_[e]) * (va[e] + vb[e]);
                stf8(out + (is_s ? O_CMS : O_CMP) + (size_t)(sb * 2 + j) * DM + c0, us); }
#pragma unroll
            for (int e = 0; e < 8; ++e) { um2[e] = um1[e]; um1[e] = u[e]; }
        }
    }
}
__device__ __forceinline__ void glu_fixup_phase(gcf FIXG, gcf FIXU, gcf HALO, GAS unsigned char* H, gcf cw, gcf cb, gcf state, gf out, gcb GS, int layer, int gt, int GT) {
    constexpr int NCG = DFF / 8;
    for (int task = gt; task < 320 * NCG; task += GT) {
        const int rid = task / NCG, cg = task - rid * NCG, bk = rid >> 1, j = rid & 1, c0 = cg * 8, row = 64 * bk + j;
        const bool is_s = bk >= 128; const int sb = is_s ? bk - 128 : bk >> 6; const bool seq_start = is_s || (bk & 63) == 0, seq_end = is_s || (bk & 63) == 63;
        float w0[8], w1[8], w2[8], bb[8], g0[8], u0[8], h1[8], h0[8];
        ldf8(cw + c0, w0); ldf8(cw + DFF + c0, w1); ldf8(cw + 2 * DFF + c0, w2); ldf8(cb + c0, bb); ldf8(FIXG + (size_t)rid * DFF + c0, g0); ldf8(FIXU + (size_t)rid * DFF + c0, u0);
        if (seq_start) { if (is_s) { ldf8(state + (size_t)(sb * 2 + 0) * DFF + c0, h0); ldf8(state + (size_t)(sb * 2 + 1) * DFF + c0, h1); } else {
#pragma unroll
            for (int e = 0; e < 8; ++e) { h0[e] = 0.f; h1[e] = 0.f; } } }
        else { ldf8(HALO + (size_t)((bk - 1) * 2 + 0) * DFF + c0, h0); ldf8(HALO + (size_t)((bk - 1) * 2 + 1) * DFF + c0, h1); }
        float g1[8], g2[8];
        if (j == 0) {
#pragma unroll
            for (int e = 0; e < 8; ++e) { g1[e] = h1[e]; g2[e] = h0[e]; } }
        else { ldf8(FIXG + (size_t)(bk * 2) * DFF + c0, g1);
#pragma unroll
            for (int e = 0; e < 8; ++e) g2[e] = h1[e]; }
        float h[8];
#pragma unroll
        for (int e = 0; e < 8; ++e) { const float a = w0[e] * g2[e] + w1[e] * g1[e] + w2[e] * g0[e] + bb[e];
            const float sg = __builtin_amdgcn_rcpf(1.f + __builtin_amdgcn_exp2f(-a * 1.4426950408889634f)); h[e] = a * sg * u0[e] * 16.f; }
        { typedef unsigned u32x2t __attribute__((ext_vector_type(2)));
          *(GAS u32x2t*)(H + (size_t)row * DFF + c0) = (u32x2t){pk4_fp8(h[0], h[1], h[2], h[3]), pk4_fp8(h[4], h[5], h[6], h[7])}; }
        if (seq_end) { float s8[8], t8[8]; const int srow = (is_s ? 4 + sb * 2 : sb * 2) + j;
            unpack8(*(const GAS v4u*)(GS + (size_t)srow * DFF + c0), s8); unpack8(*(const GAS v4u*)(GS + (size_t)(256 + srow) * DFF + c0), t8);
#pragma unroll
            for (int e = 0; e < 8; ++e) s8[e] += t8[e];
            stf8(out + (is_s ? O_FCS + (size_t)((layer * 32 + sb) * 2 + j) * DFF : O_FCP + (size_t)((layer * 2 + sb) * 2 + j) * DFF) + c0, s8); }
    }
}
__device__ __forceinline__ void ln_phase(gcb Y, gcf P, gcf g, gcf b, gf XF, gb XB, GAS unsigned char* X8, GAS unsigned char* XI, gf SA, gb XS, int gw, int NGW, int lane) {
    for (int row = gw; row < MROWS; row += NGW) {
        float v[4][8]; float s = 0.f;
#pragma unroll
        for (int j = 0; j < 4; ++j) unpack8(__builtin_nontemporal_load((const GAS v4u*)(Y + (size_t)row * DM + 8 * lane + 512 * j)), v[j]);
        if (row >= NPROW) {
#pragma unroll
            for (int q = 0; q < 3; ++q) { gcb pr = (gcb)P + ((size_t)q * 2048 + (size_t)(row - NPROW)) * DM + 8 * lane;
#pragma unroll
                for (int j = 0; j < 4; ++j) { float t[8]; unpack8(*(const GAS v4u*)(pr + 512 * j), t);
#pragma unroll
                    for (int e = 0; e < 8; ++e) v[j][e] += t[e]; } }
        }
#pragma unroll
        for (int j = 0; j < 4; ++j)
#pragma unroll
            for (int e = 0; e < 8; ++e) s += v[j][e];
        const float mean = wave_sum(s, lane) * (1.f / DM); float s2 = 0.f;
#pragma unroll
        for (int j = 0; j < 4; ++j)
#pragma unroll
            for (int e = 0; e < 8; ++e) { v[j][e] -= mean; s2 += v[j][e] * v[j][e]; }
        const float rstd = 1.f / sqrtf(wave_sum(s2, lane) * (1.f / DM) + LN_EPS);
        float amax = 0.f;
#pragma unroll
        for (int j = 0; j < 4; ++j) { float g8[8], b8[8], o[8]; ldf8(g + 8 * lane + 512 * j, g8); ldf8(b + 8 * lane + 512 * j, b8);
#pragma unroll
            for (int e = 0; e < 8; ++e) { o[e] = v[j][e] * rstd * g8[e] + b8[e]; v[j][e] = o[e]; amax = fmaxf(amax, fabsf(o[e])); }
            if (XF) stf8_nt(XF + (size_t)row * DM + 8 * lane + 512 * j, o);
            if (XB) *(GAS v4u*)(XB + (size_t)row * DM + 8 * lane + 512 * j) = pack8(o);
            if (X8) { typedef unsigned u32x2t __attribute__((ext_vector_type(2))); *(GAS u32x2t*)(X8 + (size_t)row * DM + 8 * lane + 512 * j) = (u32x2t){pk4_fp8(o[0] * 16.f, o[1] * 16.f, o[2] * 16.f, o[3] * 16.f), pk4_fp8(o[4] * 16.f, o[5] * 16.f, o[6] * 16.f, o[7] * 16.f)}; } }
        if (XI) {
#pragma unroll
            for (int o_ = 1; o_ < 64; o_ <<= 1) amax = fmaxf(amax, shfl_f(amax, lane ^ o_));
            const float inv = amax > 0.f ? 127.f / amax : 0.f; typedef unsigned u32x2t __attribute__((ext_vector_type(2)));
#pragma unroll
            for (int j = 0; j < 4; ++j) *(GAS u32x2t*)(XI + (size_t)row * DM + 8 * lane + 512 * j) = (u32x2t){pk4_i8(v[j][0] * inv, v[j][1] * inv, v[j][2] * inv, v[j][3] * inv), pk4_i8(v[j][4] * inv, v[j][5] * inv, v[j][6] * inv, v[j][7] * inv)};
            if (lane == 0) SA[row] = amax * (1.f / 127.f);
            const bool is_s = row >= NPROW; const int t = is_s ? ((row - NPROW) & 63) : (row & 4095), T = is_s ? DSEQ : SEQ;
            if (t >= T - 2) { const int srow = (is_s ? 4 + ((row - NPROW) >> 6) * 2 : (row >> 12) * 2) + (t - (T - 2));
#pragma unroll
                for (int j = 0; j < 4; ++j) *(GAS v4u*)(XS + (size_t)srow * DM + 8 * lane + 512 * j) = pack8(v[j]); }
        }
    }
}

__device__ __forceinline__ void postproj_phase(gcb PQ, gcb PK, const __attribute__((address_space(4))) float* inv_freq, gcf kng, gcf knb, gf out,
                                               gb QR, gb IQ, gb KP, gb VP, gb IKP, gb KS, gb VS, gb IKS, gf IW, int gw, int NGW, int lane) {
    typedef unsigned u32x2t __attribute__((ext_vector_type(2)));
    const int c = lane & 7, hh = lane >> 3, d0 = 8 * c;
    float invf[8], g1[8], g2[8], bb1[8], bb2[8];
#pragma unroll
    for (int e = 0; e < 8; ++e) { invf[e] = inv_freq[d0 + e]; g1[e] = kng[d0 + e]; g2[e] = kng[64 + d0 + e]; bb1[e] = knb[d0 + e]; bb2[e] = knb[64 + d0 + e]; }
    for (int row = gw; row < MROWS; row += NGW) {
        const bool is_s = row >= NPROW; const int sb = is_s ? ((row - NPROW) >> 6) : (row >> 12); const int t = is_s ? ((row - NPROW) & 63) : (row & 4095);
        const int pos = is_s ? PAST + t : t;
        float cs[8], sn[8];
#pragma unroll
        for (int e = 0; e < 8; ++e) { const float ang = (float)pos * invf[e];
            const double rev = (double)ang * 0.15915494309189535; const float fr = (float)(rev - __builtin_rint(rev));
            cs[e] = __builtin_amdgcn_cosf(fr); sn[e] = __builtin_amdgcn_sinf(fr); }
        gcb Pq = PQ + (size_t)row * 4096; gcb P = PK + (size_t)row * 1280;
        gb qo = QR + (size_t)row * DM; gb iqo = IQ + (size_t)row * DM;
#pragma unroll
        for (int p = 0; p < 2; ++p) { const int h = 8 * p + hh;
            float x1[8], x2[8], y1[8], y2[8], o1[8], o2[8];
            unpack8(__builtin_nontemporal_load((const GAS v4u*)(Pq + h * 128 + d0)), x1); unpack8(__builtin_nontemporal_load((const GAS v4u*)(Pq + h * 128 + 64 + d0)), x2);
            unpack8(__builtin_nontemporal_load((const GAS v4u*)(Pq + 2048 + h * 128 + d0)), y1); unpack8(__builtin_nontemporal_load((const GAS v4u*)(Pq + 2048 + h * 128 + 64 + d0)), y2);
#pragma unroll
            for (int e = 0; e < 8; ++e) { o1[e] = x1[e] * cs[e] - x2[e] * sn[e]; o2[e] = x1[e] * sn[e] + x2[e] * cs[e]; }
            { typedef unsigned u32x2q __attribute__((ext_vector_type(2))); GAS unsigned char* q8 = (GAS unsigned char*)QR + (size_t)row * DM + h * 128;
              *(GAS u32x2q*)(q8 + kperm(d0)) = (u32x2q){pk4_fp8(o1[0] * 16.f, o1[1] * 16.f, o1[2] * 16.f, o1[3] * 16.f), pk4_fp8(o1[4] * 16.f, o1[5] * 16.f, o1[6] * 16.f, o1[7] * 16.f)};
              *(GAS u32x2q*)(q8 + kperm(64 + d0)) = (u32x2q){pk4_fp8(o2[0] * 16.f, o2[1] * 16.f, o2[2] * 16.f, o2[3] * 16.f), pk4_fp8(o2[4] * 16.f, o2[5] * 16.f, o2[6] * 16.f, o2[7] * 16.f)}; }
#pragma unroll
            for (int e = 0; e < 8; ++e) { o1[e] = y1[e] * cs[e] - y2[e] * sn[e]; o2[e] = y1[e] * sn[e] + y2[e] * cs[e]; }
            *(GAS v4u*)(iqo + h * 128 + d0) = pack8(o1); *(GAS v4u*)(iqo + h * 128 + 64 + d0) = pack8(o2);
        }
        gf kof = out + (is_s ? O_KS + (size_t)(row - NPROW) * KVW : O_KP + (size_t)row * KVW);
        gf vof = out + (is_s ? O_VS + (size_t)(row - NPROW) * KVW : O_VP + (size_t)row * KVW);
        GAS unsigned char* kob = is_s ? (GAS unsigned char*)KS + ((size_t)sb * 4 * LSK + PAST + t) * 128 : (GAS unsigned char*)KP + ((size_t)sb * 4 * SEQ + t) * 128;
        GAS unsigned char* vob = is_s ? (GAS unsigned char*)VS + ((size_t)sb * 4 * LSK + PAST + t) * 128 : (GAS unsigned char*)VP + ((size_t)sb * 4 * SEQ + t) * 128;
        const size_t gstr = (size_t)(is_s ? LSK : SEQ) * 128;
        if (hh < 4) { const int g = hh;
            float x1[8], x2[8], o1[8], o2[8];
            unpack8(*(const GAS v4u*)(P + g * 128 + d0), x1); unpack8(*(const GAS v4u*)(P + g * 128 + 64 + d0), x2);
#pragma unroll
            for (int e = 0; e < 8; ++e) { o1[e] = x1[e] * cs[e] - x2[e] * sn[e]; o2[e] = x1[e] * sn[e] + x2[e] * cs[e]; }
            stf8_nt(kof + g * 128 + d0, o1); stf8_nt(kof + g * 128 + 64 + d0, o2);
            *(GAS u32x2t*)(kob + g * gstr + kperm(d0)) = (u32x2t){pk4_fp8(o1[0] * 16.f, o1[1] * 16.f, o1[2] * 16.f, o1[3] * 16.f), pk4_fp8(o1[4] * 16.f, o1[5] * 16.f, o1[6] * 16.f, o1[7] * 16.f)};
            *(GAS u32x2t*)(kob + g * gstr + kperm(64 + d0)) = (u32x2t){pk4_fp8(o2[0] * 16.f, o2[1] * 16.f, o2[2] * 16.f, o2[3] * 16.f), pk4_fp8(o2[4] * 16.f, o2[5] * 16.f, o2[6] * 16.f, o2[7] * 16.f)};
        }
        { float vf[8]; unpack8(*(const GAS v4u*)(P + 512 + 8 * lane), vf); stf8_nt(vof + 8 * lane, vf);
          *(GAS u32x2t*)(vob + (size_t)(lane >> 4) * gstr + ((8 * lane) & 127)) = (u32x2t){pk4_fp8(vf[0] * 16.f, vf[1] * 16.f, vf[2] * 16.f, vf[3] * 16.f), pk4_fp8(vf[4] * 16.f, vf[5] * 16.f, vf[6] * 16.f, vf[7] * 16.f)}; }
        {
            float x1[8], x2[8]; float s = 0.f;
            if (hh == 0) { unpack8(*(const GAS v4u*)(P + 1024 + d0), x1); unpack8(*(const GAS v4u*)(P + 1024 + 64 + d0), x2); }
            else {
#pragma unroll
                for (int e = 0; e < 8; ++e) { x1[e] = 0.f; x2[e] = 0.f; } }
#pragma unroll
            for (int e = 0; e < 8; ++e) s += x1[e] + x2[e];
            const float mean = wave_sum(s, lane) * (1.f / 128.f); float s2 = 0.f;
#pragma unroll
            for (int e = 0; e < 8; ++e) { x1[e] -= mean; x2[e] -= mean; s2 += x1[e] * x1[e] + x2[e] * x2[e]; }
            if (hh != 0) s2 = 0.f;
            const float rstd = 1.f / sqrtf(wave_sum(s2, lane) * (1.f / 128.f) + LN_EPS);
            if (hh == 0) {
                float o1[8], o2[8];
#pragma unroll
                for (int e = 0; e < 8; ++e) { const float n1 = x1[e] * rstd * g1[e] + bb1[e], n2 = x2[e] * rstd * g2[e] + bb2[e]; o1[e] = n1 * cs[e] - n2 * sn[e]; o2[e] = n1 * sn[e] + n2 * cs[e]; }
                gf iof = out + (is_s ? O_IKS + (size_t)(row - NPROW) * IDXD : O_IKP + (size_t)row * IDXD);
                gb iob = is_s ? IKS + ((size_t)sb * LSK + PAST + t) * IDXD : IKP + (size_t)row * IDXD;
                stf8_nt(iof + d0, o1); stf8_nt(iof + 64 + d0, o2); *(GAS v4u*)(iob + d0) = pack8(o1); *(GAS v4u*)(iob + 64 + d0) = pack8(o2);
            }
        }
        if (lane < 16) IW[(size_t)lane * MROWS + row] = bf1(P[1152 + lane]) * IDX_W_SCALE;
    }
}

__device__ __forceinline__ void indexer_phase(LAS unsigned char* L, gcb IQ, gcf IW, gcb IKP, gcb IKS, gf SCP, gf SCS,
                                              int vcu, int G, int tid, int lane, int wave) {
    const int r32 = lane & 31, hi = lane >> 5;
    for (int u = vcu; u < 1376; u += G) {
        int qrow0, kt, scld; gcb IKb; gf scb;
        if (u < 1088) { const int b = u / 544; int r = u - b * 544; int gq = 0; while (r >= 4 * (gq + 1)) { r -= 4 * (gq + 1); ++gq; }
            const int c = 4 * gq + r / (gq + 1); kt = r % (gq + 1); qrow0 = b * SEQ + 64 * c; IKb = IKP + (size_t)b * SEQ * IDXD; scb = SCP + (size_t)qrow0 * SEQ; scld = SEQ; }
        else { const int us = u - 1088; const int sb = us / 9; kt = us - sb * 9; qrow0 = NPROW + 64 * sb; IKb = IKS + (size_t)sb * LSK * IDXD; scb = SCS + (size_t)(64 * sb) * SCS_LD; scld = SCS_LD; }
        const int key0 = kt * 256 + 32 * wave;
        pg8::bf16x8 a[8];
#pragma unroll
        for (int ks = 0; ks < 8; ++ks) a[ks] = *(const GAS pg8::bf16x8*)(IKb + (size_t)(key0 + r32) * IDXD + 16 * ks + 8 * hi);
        f32x16 I0, I1;
#pragma unroll
        for (int r = 0; r < 16; ++r) { I0[r] = 0.f; I1[r] = 0.f; }
        const int sq = tid >> 3, sc0 = tid & 7;
        gcb iqsrc = IQ + (size_t)(qrow0 + sq) * DM + sc0 * 8;
        const unsigned wofs0 = (unsigned)(sq * 256 + ((sc0 ^ (sq & 15)) * 16)), wofs1 = (unsigned)(sq * 256 + (((sc0 + 8) ^ (sq & 15)) * 16));
        gcf iw0 = IW + (size_t)(qrow0 + r32); gcf iw1 = iw0 + 32;
        v4u se0 = *(const GAS v4u*)iqsrc, se1 = *(const GAS v4u*)(iqsrc + 64), so0 = *(const GAS v4u*)(iqsrc + 128), so1 = *(const GAS v4u*)(iqsrc + 128 + 64);
        float wn0 = iw0[0], wn1 = iw1[0];
        *(LAS v4u*)(L + wofs0) = se0; *(LAS v4u*)(L + wofs1) = se1;
        const unsigned rofs = (unsigned)(r32 * 256), rx = (unsigned)(r32 & 15);
#define IDX_HEAD(h_, LDNEXT, STNEXT) do { __syncthreads(); const float wc0_ = wn0, wc1_ = wn1; LDNEXT; if ((h_) < 15) { wn0 = iw0[(size_t)((h_) + 1) * MROWS]; wn1 = iw1[(size_t)((h_) + 1) * MROWS]; } \
            LAS unsigned char* buf_ = L + ((h_) & 1) * 16384; f32x16 S0_, S1_; _Pragma("unroll") for (int r_ = 0; r_ < 16; ++r_) { S0_[r_] = 0.f; S1_[r_] = 0.f; } \
            _Pragma("unroll") for (int ks_ = 0; ks_ < 8; ++ks_) { const unsigned co_ = (((unsigned)(2 * ks_ + hi)) ^ rx) * 16u; \
                const pg8::bf16x8 b0_ = *(const LAS pg8::bf16x8*)(buf_ + rofs + co_), b1_ = *(const LAS pg8::bf16x8*)(buf_ + 8192 + rofs + co_); \
                S0_ = __builtin_amdgcn_mfma_f32_32x32x16_bf16(a[ks_], b0_, S0_, 0, 0, 0); S1_ = __builtin_amdgcn_mfma_f32_32x32x16_bf16(a[ks_], b1_, S1_, 0, 0, 0); } \
            _Pragma("unroll") for (int r_ = 0; r_ < 16; ++r_) { I0[r_] += wc0_ * fmaxf(S0_[r_], 0.f); I1[r_] += wc1_ * fmaxf(S1_[r_], 0.f); } \
            STNEXT; } while (0)
#pragma unroll 1
        for (int h = 0; h < 16; h += 2) {
            IDX_HEAD(h, if (h + 2 < 16) { se0 = *(const GAS v4u*)(iqsrc + (h + 2) * 128); se1 = *(const GAS v4u*)(iqsrc + (h + 2) * 128 + 64); },
                     { LAS unsigned char* nb_ = L + 16384; *(LAS v4u*)(nb_ + wofs0) = so0; *(LAS v4u*)(nb_ + wofs1) = so1; });
            IDX_HEAD(h + 1, if (h + 3 < 16) { so0 = *(const GAS v4u*)(iqsrc + (h + 3) * 128); so1 = *(const GAS v4u*)(iqsrc + (h + 3) * 128 + 64); },
                     if (h + 2 < 16) { *(LAS v4u*)(L + wofs0) = se0; *(LAS v4u*)(L + wofs1) = se1; });
        }
#undef IDX_HEAD
        { LAS unsigned char* T = L + 32768 + wave * 8192;
#pragma unroll
          for (int j = 0; j < 4; ++j) { const int ch = 2 * j + hi;
              *(LAS f32x4*)(T + r32 * 128 + ((ch ^ ((r32 >> 1) & 7)) * 16)) = (f32x4){I0[4 * j], I0[4 * j + 1], I0[4 * j + 2], I0[4 * j + 3]};
              *(LAS f32x4*)(T + (32 + r32) * 128 + ((ch ^ (((32 + r32) >> 1) & 7)) * 16)) = (f32x4){I1[4 * j], I1[4 * j + 1], I1[4 * j + 2], I1[4 * j + 3]}; }
#pragma unroll
          for (int i = 0; i < 8; ++i) { const int row = 8 * i + (lane >> 3), ch = lane & 7;
              const f32x4 v = *(const LAS f32x4*)(T + row * 128 + ((ch ^ ((row >> 1) & 7)) * 16));
              *(GAS f32x4*)(scb + (size_t)row * scld + key0 + 4 * ch) = v; } }
        __syncthreads();
    }
}

__device__ __forceinline__ void topk_phase(LAS unsigned char* L, gcf SCP, gcf SCS, gi SEL, int gw, int NGW, int lane, int wave) {
    typedef unsigned u32x4t __attribute__((ext_vector_type(4)));
    LAS unsigned* hist = (LAS unsigned*)(L + wave * 17408);
#define TK_ROW(q0_, q_, Lk_, src_) do { q_ = ((q0_) < NPROW && ((q0_) & 2048)) ? (((q0_) & ~4095) | (4095 - ((q0_) & 2047))) : (q0_); \
        if (q_ < NPROW) { const int t_ = q_ & 4095; Lk_ = ((t_ >> 6) + 1) * 64; src_ = SCP + (size_t)q_ * SEQ; } else { Lk_ = LSK; src_ = SCS + (size_t)(q_ - NPROW) * SCS_LD; } } while (0)
#define TK_LOAD(Lk_, src_) do { const int nv_ = (Lk_) >> 6; _Pragma("unroll") for (int gI_ = 0; gI_ < 8; ++gI_) if (nv_ > gI_ * 8) { \
        _Pragma("unroll") for (int i_ = gI_ * 8; i_ < gI_ * 8 + 8; ++i_) raw[i_] = __float_as_uint(__builtin_nontemporal_load((src_) + (i_ < nv_ ? i_ * 64 + lane : 0))); } } while (0)
    unsigned raw[64];
    if (gw < MROWS) { int q_, Lk_; gcf src_; TK_ROW(gw, q_, Lk_, src_); if (Lk_ > 256) TK_LOAD(Lk_, src_); }
    for (int q0 = gw; q0 < MROWS; q0 += NGW) {
        int q, Lk; gcf src; TK_ROW(q0, q, Lk, src);
        gi selq = SEL + (size_t)q * 256;
        const int nv = Lk >> 6;
        unsigned key[64];
        if (Lk > 256) {
#pragma unroll
            for (int i = 0; i < 64; ++i) { const unsigned ub = raw[i]; key[i] = i < nv ? ((ub & 0x80000000u) ? ~ub : (ub | 0x80000000u)) : 0u; }
        }
        if (q0 + NGW < MROWS) { int qn_, Lkn_; gcf srcn_; TK_ROW(q0 + NGW, qn_, Lkn_, srcn_); if (Lkn_ > 256) TK_LOAD(Lkn_, srcn_); }
        if (Lk <= 256) { for (int i = lane; i < Lk; i += 64) selq[i] = i; continue; }
        unsigned prefix = 0u; int need = 256;
#pragma unroll 1
        for (int pass = 0; pass < 4; ++pass) {
            const int sh = 24 - 8 * pass; const unsigned himask = pass == 0 ? 0u : (0xffffffffu << (sh + 8));
            *(LAS u32x4t*)(hist + 4 * lane) = (u32x4t){0u, 0u, 0u, 0u};
#pragma unroll
            for (int gI = 0; gI < 8; ++gI) if (nv > gI * 8) {
#pragma unroll
                for (int i = gI * 8; i < gI * 8 + 8; ++i) { const unsigned k = key[i];
                    const bool hit = k != 0u && ((k ^ prefix) & himask) == 0u;
                    if (pass < 2 || __ballot(hit) != 0ull)
                        __hip_atomic_fetch_add(hist + (hit ? ((k >> sh) & 255u) : 256u + (unsigned)lane), 1u, __ATOMIC_RELAXED, __HIP_MEMORY_SCOPE_WORKGROUP); }
            }
            const u32x4t h4 = *(const LAS u32x4t*)(hist + 4 * lane);
            const int s = (int)(h4.x + h4.y + h4.z + h4.w); int S = s;
#pragma unroll
            for (int off = 1; off < 64; off <<= 1) { const int t = __builtin_amdgcn_ds_bpermute(((lane + off) & 63) << 2, S); if (lane + off < 64) S += t; }
            const int above = S - s;
            const bool here = above < need && need <= S;
            int c = above, d = -1, nn = 0;
            { const int hb[4] = {(int)h4.x, (int)h4.y, (int)h4.z, (int)h4.w};
#pragma unroll
              for (int b = 3; b >= 0; --b) { if (d < 0) { if (c + hb[b] >= need) { d = b; nn = need - c; } else c += hb[b]; } } }
            const unsigned long long bal = __ballot(here);
            const int fl = __builtin_amdgcn_readfirstlane(bal ? __ffsll((long long)bal) - 1 : 0);
            const int digit = __builtin_amdgcn_readlane(4 * lane + d, fl);
            need = __builtin_amdgcn_readlane(nn, fl);
            prefix |= ((unsigned)digit & 255u) << sh;
        }
        int cge = 0, ceq = 0;
#pragma unroll
        for (int gI = 0; gI < 8; ++gI) if (nv > gI * 8) {
#pragma unroll
            for (int i = gI * 8; i < gI * 8 + 8; ++i) { cge += key[i] >= prefix ? 1 : 0; ceq += key[i] == prefix ? 1 : 0; }
        }
        const int eq_total = wave_sum_i(ceq, lane);
        if (eq_total == need) {
            int S = cge;
#pragma unroll
            for (int off = 1; off < 64; off <<= 1) { const int t = __builtin_amdgcn_ds_bpermute(((lane - off) & 63) << 2, S); if (lane >= off) S += t; }
            int pos = S - cge;
            LAS int* lst = (LAS int*)(hist + 512);
#pragma unroll
            for (int gI = 0; gI < 8; ++gI) if (nv > gI * 8) {
#pragma unroll
                for (int i = gI * 8; i < gI * 8 + 8; ++i) { const bool take = key[i] >= prefix; lst[take && pos < 256 ? pos : 256 + lane] = i * 64 + lane; pos += take ? 1 : 0; }
            }
#pragma unroll
            for (int i = 0; i < 4; ++i) selq[i * 64 + lane] = lst[i * 64 + lane];
        } else {
            int base = 0, eqtaken = 0;
#pragma unroll
            for (int gI = 0; gI < 8; ++gI) if (nv > gI * 8) {
#pragma unroll
                for (int i = gI * 8; i < gI * 8 + 8; ++i) {
                    const bool gtb = key[i] > prefix, eqb = key[i] == prefix;
                    const unsigned long long be = __ballot(eqb);
                    const int eqrank = eqtaken + (int)__builtin_amdgcn_mbcnt_hi((unsigned)(be >> 32), __builtin_amdgcn_mbcnt_lo((unsigned)be, 0u));
                    const bool take = gtb || (eqb && eqrank < need);
                    const unsigned long long bt = __ballot(take);
                    const int pos = base + (int)__builtin_amdgcn_mbcnt_hi((unsigned)(bt >> 32), __builtin_amdgcn_mbcnt_lo((unsigned)bt, 0u));
                    if (take && pos < 256) selq[pos] = i * 64 + lane;
                    base += __popcll(bt); eqtaken += __popcll(be);
                }
            }
        }
    }
}

#undef TK_ROW
#undef TK_LOAD
constexpr int ATT_WAVE_LDS = 17408;
__device__ __forceinline__ void attn_phase(LAS unsigned char* L, gcb QR, gb O, gci SEL, gcb KP, gcb VP, gcb KS, gcb VS, int vcu, int G, int lane, int wave) {
    const int kq = lane & 15, lg = lane >> 4;
    LAS unsigned char* Vt = L + wave * ATT_WAVE_LDS;
    LAS int* Sl = (LAS int*)(L + wave * ATT_WAVE_LDS + 16384);
    const int trrow = 8 * lg + (kq >> 1), trx = (trrow >> 1) & 7;
    const unsigned trbase_u = (unsigned)(uintptr_t)(Vt + trrow * 128 + 8 * (kq & 1)) | (unsigned)(trx << 4);
    const int drow = lane >> 3, dslot = lane & 7;
    const int cpx = G >> 3, x = cpx ? vcu / cpx : 8, li = cpx ? (vcu - x * cpx) * NWAVES + wave : 0, nwx = cpx * NWAVES;
    if (x >= 8 || li >= 5120) return;
#define TASK(tl_, q_, g_, nsel_, Kb8_, Vb8_) do { if ((tl_) < 4096) { const int b_ = x >> 2, t_ = (tl_); g_ = x & 3; q_ = b_ * SEQ + t_; const int Lk_ = ((t_ >> 6) + 1) * 64; nsel_ = Lk_ < 256 ? Lk_ : 256; \
            Kb8_ = (const GAS unsigned char*)KP + (size_t)(b_ * 4 + g_) * SEQ * 128; Vb8_ = (const GAS unsigned char*)VP + (size_t)(b_ * 4 + g_) * SEQ * 128; } \
        else { const int s_ = (tl_) - 4096, c_ = x * 16 + (s_ >> 6), sb_ = c_ >> 2; g_ = c_ & 3; q_ = NPROW + sb_ * 64 + (s_ & 63); nsel_ = 256; \
            Kb8_ = (const GAS unsigned char*)KS + (size_t)(sb_ * 4 + g_) * LSK * 128; Vb8_ = (const GAS unsigned char*)VS + (size_t)(sb_ * 4 + g_) * LSK * 128; } } while (0)
#define QCVT(dst_, raw_) do { dst_[0] = kq < 4 ? (long)(((unsigned long long)raw_[0].y << 32) | raw_[0].x) : 0l; dst_[1] = kq < 4 ? (long)(((unsigned long long)raw_[0].w << 32) | raw_[0].z) : 0l; \
            dst_[2] = kq < 4 ? (long)(((unsigned long long)raw_[1].y << 32) | raw_[1].x) : 0l; dst_[3] = kq < 4 ? (long)(((unsigned long long)raw_[1].w << 32) | raw_[1].z) : 0l; } while (0)
    int tl = li, q, g, nsel; const GAS unsigned char* Kb8; const GAS unsigned char* Vb8;
    TASK(tl, q, g, nsel, Kb8, Vb8);
    long qf8[4];
    v4u kb[8][2];
#define KLDX(kg_, Kb8_) do { const GAS unsigned char* kr_ = Kb8_ + ((unsigned)Sl[(kg_) * 16 + kq] * 128u + 16u * (unsigned)lg);         kb[(kg_) & 7][0] = *(const GAS v4u*)kr_; kb[(kg_) & 7][1] = *(const GAS v4u*)(kr_ + 64); } while (0)
    {
        gci selq = SEL + (size_t)q * 256;
#pragma unroll
        for (int i = 0; i < 4; ++i) Sl[i * 64 + lane] = (i * 64 < nsel) ? selq[i * 64 + lane] : 0;
        v4u qraw[2];
#pragma unroll
        for (int j = 0; j < 2; ++j) qraw[j] = *(const GAS v4u*)((const GAS unsigned char*)QR + (size_t)q * DM + (4 * g + (kq & 3)) * 128 + 64 * j + 16 * lg);
        QCVT(qf8, qraw);
#pragma unroll
        for (int kg = 0; kg < 7; ++kg) KLDX(kg, Kb8);
    }
    for (;;) {
        const int tn = tl + nwx; const bool has_next = tn < 5120;
        int qn, gn, nseln; const GAS unsigned char* Kb8n; const GAS unsigned char* Vb8n;
        TASK(has_next ? tn : tl, qn, gn, nseln, Kb8n, Vb8n);
        const int nkg = nsel >> 4, nt = nkg >> 1;
#define VDMA(t_) do { LAS unsigned char* dst_ = Vt + ((t_) & 3) * 4096; \
            _Pragma("unroll") for (int i_ = 0; i_ < 4; ++i_) { const int sx_ = Sl[(2 * (t_) + (drow >> 2)) * 16 + 4 * i_ + (drow & 3)];     \
                const int n_ = dslot ^ ((4 * (i_ & 1) + (drow >> 1)) & 7);                                                         \
                __builtin_amdgcn_global_load_lds((const GAS unsigned*)(Vb8 + ((unsigned)sx_ * 128u + (unsigned)n_ * 16u)), (LAS unsigned*)(dst_ + i_ * 1024), 16, 0, 0); } } while (0)
        VDMA(0); VDMA(1); if (nt > 2) VDMA(2);
        f32x4 sc[16];
#pragma unroll
        for (int kg = 0; kg < 16; ++kg) {
            if (kg < nkg) {
                if (kg + 7 < nkg) { if (kg + 7 < 16) KLDX((kg + 7) & 15, Kb8); }
                f32x4 acc = {0.f, 0.f, 0.f, 0.f};
#pragma unroll
                for (int ks = 0; ks < 4; ++ks) { const v4u w = kb[kg & 7][ks >> 1]; const long a8 = (ks & 1) ? (long)(((unsigned long long)w.w << 32) | w.z) : (long)(((unsigned long long)w.y << 32) | w.x);
                    acc = __builtin_amdgcn_mfma_f32_16x16x32_fp8_fp8(a8, qf8[ks], acc, 0, 0, 0); }
                sc[kg] = acc;
            } else sc[kg] = (f32x4){-INFINITY, -INFINITY, -INFINITY, -INFINITY};
        }
        int selraw[4]; v4u qrawn[2];
        { gci selqn = SEL + (size_t)qn * 256;
#pragma unroll
          for (int i = 0; i < 4; ++i) selraw[i] = (i * 64 < nseln) ? selqn[i * 64 + lane] : 0;
#pragma unroll
          for (int j = 0; j < 2; ++j) qrawn[j] = *(const GAS v4u*)((const GAS unsigned char*)QR + (size_t)qn * DM + (4 * gn + (kq & 3)) * 128 + 64 * j + 16 * lg); }
        float mx = sc[0][0];
#pragma unroll
        for (int kg = 0; kg < 16; ++kg)
#pragma unroll
            for (int r = 0; r < 4; ++r) mx = fmaxf(mx, sc[kg][r]);
        mx = fmaxf(mx, shfl_f(mx, lane ^ 16)); mx = fmaxf(mx, shfl_f(mx, lane ^ 32));
        float sm = 0.f; unsigned pp[16];
        const float e_c = ATTN_SC2 * (1.f / 256.f), e_b = 8.f - mx * e_c;
#pragma unroll
        for (int kg = 0; kg < 16; ++kg) { float p[4];
#pragma unroll
            for (int r = 0; r < 4; ++r) { p[r] = __builtin_amdgcn_exp2f(__builtin_fmaf(sc[kg][r], e_c, e_b)); sm += p[r]; }
            pp[kg] = pk4_fp8_nc(p[0], p[1], p[2], p[3]); }
        sm += shfl_f(sm, lane ^ 16); sm += shfl_f(sm, lane ^ 32);
        f32x4 oacc[8];
#pragma unroll
        for (int n = 0; n < 8; ++n) oacc[n] = (f32x4){0.f, 0.f, 0.f, 0.f};
#define VMM(t_) do { unsigned ta_ = trbase_u + ((t_) & 3) * 4096; asm volatile("" : "+v"(ta_)); long va_[8];     \
            const long pb_ = (long)(((unsigned long long)pp[2 * (t_) + 1] << 32) | (unsigned long long)pp[2 * (t_)]); \
            _Pragma("unroll") for (int n_ = 0; n_ < 8; ++n_) asm volatile("ds_read_b64_tr_b8 %0, %1" : "=&v"(va_[n_]) : "v"(ta_ ^ (unsigned)(n_ << 4)) : "memory"); \
            asm volatile("s_waitcnt lgkmcnt(0)" ::: "memory"); __builtin_amdgcn_sched_barrier(0); \
            _Pragma("unroll") for (int n_ = 0; n_ < 8; ++n_) oacc[n_] = __builtin_amdgcn_mfma_f32_16x16x32_fp8_fp8(va_[n_], pb_, oacc[n_], 0, 0, 0); } while (0)
#define KNEXT do { _Pragma("unroll") for (int i_ = 0; i_ < 4; ++i_) Sl[i_ * 64 + lane] = selraw[i_]; QCVT(qf8, qrawn); \
            _Pragma("unroll") for (int kg_ = 0; kg_ < 7; ++kg_) KLDX(kg_, Kb8n); } while (0)
        if (nt == 2) { asm volatile("s_waitcnt vmcnt(0)" ::: "memory"); KNEXT; }
#pragma unroll
        for (int t = 0; t < 8; ++t) {
            if (t < nt) {
                if (t + 3 < nt) { VDMA(t + 3); if (t >= 3) asm volatile("s_waitcnt vmcnt(12)" ::: "memory"); }
                else if (t >= 3) {
                    if (t + 2 < nt) asm volatile("s_waitcnt vmcnt(22)" ::: "memory");
                    else if (t + 1 < nt) asm volatile("s_waitcnt vmcnt(18)" ::: "memory");
                    else asm volatile("s_waitcnt vmcnt(14)" ::: "memory");
                }
                VMM(t);
                if (t + 4 == nt) KNEXT;
            }
        }
#undef VDMA
#undef VMM
#undef KNEXT
        const float inv = 4.f / sm;
        { LAS unsigned char* ost = Vt + 3 * 4096; const unsigned oa = (unsigned)(uintptr_t)(ost + kq * 128 + 4 * lg);
          if (kq < 4) {
#pragma unroll
              for (int n = 0; n < 8; ++n) { const f32x4 v = oacc[n] * inv; const unsigned w = pk4_fp8(v[0], v[1], v[2], v[3]); asm volatile("ds_write_b32 %0, %1" :: "v"(oa + 16u * n), "v"(w) : "memory"); }
          }
          asm volatile("s_waitcnt lgkmcnt(0)" ::: "memory");
          if (lane < 32) { v4u ov; asm volatile("ds_read_b128 %0, %1\n\ts_waitcnt lgkmcnt(0)" : "=v"(ov) : "v"((unsigned)(uintptr_t)(ost + 16 * lane)) : "memory");
              *(GAS v4u*)((GAS unsigned char*)O + (size_t)q * DM + (4 * g) * 128 + 16 * lane) = ov; } }
        if (!has_next) break;
        tl = tn; q = qn; g = gn; nsel = nseln; Kb8 = Kb8n; Vb8 = Vb8n;
    }
#undef KLDX
#undef TASK
#undef QCVT
}

constexpr int RING_BYTES = 131072, LDSCTL_OFF = 139264  , MISC_OFF = LDSCTL_OFF + 320, LDS_BYTES = 147456;
struct Args { const float* in[22]; float* out; unsigned char* ws; float inv_freq[64]; };
constexpr int NSTEP = 25;
#ifndef PH_MASK
#define PH_MASK 0x3ff
#endif
#define PHM(k) (((PH_MASK) >> (k)) & 1)
#ifndef REP_MASK
#define REP_MASK 0
#endif

#define PH_ENV \
        int tid; asm volatile("v_mbcnt_lo_u32_b32 %0, -1, 0\n\tv_mbcnt_hi_u32_b32 %0, -1, %0" : "=v"(tid)); tid += wave_s * 64; \
        const __attribute__((address_space(4))) Args* ap = (const __attribute__((address_space(4))) Args*)__builtin_amdgcn_kernarg_segment_ptr(); asm volatile("" : "+s"(ap)); \
        const int lane = tid & 63, wave = wave_s; \
        const int G = gridDim.x, bx = blockIdx.x; const int vcu = (G % 8 == 0) ? (bx % 8) * (G / 8) + bx / 8 : bx; \
        const int gt = vcu * NTHR + tid, GT = G * NTHR, gw = vcu * NWAVES + wave, NGW = G * NWAVES; \
        GAS unsigned char* ws = (GAS unsigned char*)ap->ws; gf out = (gf)ap->out; \
        gcf xp = (gcf)ap->in[0]; gcf xs = (gcf)ap->in[1]; \
        gb WMI = (gb)(ws + WS_WMI); gb WMO = (gb)(ws + WS_WMO); gb WAI = (gb)(ws + WS_WAI); gb WAO = (gb)(ws + WS_WAO); \
        gb WF1 = (gb)(ws + WS_WF1); gb WF2 = (gb)(ws + WS_WF2); \
        gb XB = (gb)(ws + WS_XB); gf XF = (gf)(ws + WS_XF); gb Y = (gb)(ws + WS_Y); gb BIG = (gb)(ws + WS_BIG); gb HB = (gb)(ws + WS_H); \
        gb KP = (gb)(ws + WS_KP); gb VP = (gb)(ws + WS_VP); gb IKP = (gb)(ws + WS_IKP); gf IW = (gf)(ws + WS_IW); gi SEL = (gi)(ws + WS_SEL); \
        gb IKS = (gb)(ws + WS_IKS); gb KS = (gb)(ws + WS_KS); gb VS = (gb)(ws + WS_VS); \
        gf SCP = (gf)(ws + WS_SCP); gf SCS = (gf)(ws + WS_SCS); gb QR = (gb)(ws + WS_QR); gb IQ = (gb)(ws + WS_IQ);
__global__ void __launch_bounds__(NTHR, 2) mega_fwd(Args args) {
    extern __shared__ __attribute__((aligned(16))) unsigned char lds[];
    LAS unsigned char* L = (LAS unsigned char*)lds;
    volatile LAS unsigned* MISC = (volatile LAS unsigned*)(L + MISC_OFF);
    for (int u = threadIdx.x; u < (LDS_BYTES - LDSCTL_OFF) / 4; u += NTHR) ((LAS unsigned*)(L + LDSCTL_OFF))[u] = 0u;
    __syncthreads();
    const int wave_s = __builtin_amdgcn_readfirstlane(threadIdx.x >> 6);
    XcdBarrier bar = xcd_barrier_post((unsigned*)((gu32*)(args.ws + WS_CTL) + CW_BAR), MISC + 8);

#pragma unroll 1
    for (int sidx = 0; sidx < NSTEP * 2; ++sidx) {
        const int pos = sidx >> 1, step = pos == 0 ? 0 : pos == 1 ? 21 : pos == 2 ? 1 : pos == 3 ? 24 : pos <= 7 ? pos - 2 : pos == 8 ? 22 : pos <= 11 ? pos - 3 : pos == 12 ? 20 : pos <= 20 ? pos - 4 : pos == 21 ? 23 : pos - 5;
        if (sidx & 1) { const int kind = (step == 0 || step == 21) ? 0 : (step == 1 || step == 3 || step == 5 || step == 9 || step == 16 || step == 22 || step == 23 || step == 24) ? 1 : (step == 7 || step == 14 || step == 18 || step == 20) ? 2 : step == 2 ? 3 : (step == 6 || step == 17) ? 4
                : (step == 4 || step == 8 || step == 15 || step == 19) ? 5 : step == 10 ? 6 : step == 11 ? 7 : step == 12 ? 8 : 9;
            if (!((REP_MASK >> kind) & 1)) continue;
#ifdef REP_STEP
            if (step != REP_STEP) continue;
#endif
        }
        if (PHM(0) && step == 0) {
            PH_ENV
            constexpr int I_MI = 32 * 96, I_MO = 32 * 32, I_AI = 32 * 84, I_AO = 32 * 32, I_F1 = 32 * 176, I_F2 = 88 * 32;
            constexpr int NITEMS = I_MI + I_MO + I_AI + I_AO + 2 * I_F1 + 2 * I_F2;
            for (int it = gw; it < NITEMS; it += NGW) {
                int r = it;
                if (r < I_MI) { absmax_tr_item((gcf)ap->in[7], NBCV, r, lane, (GAS unsigned*)(ws + WS_CTL + 131072) + 2 * NGU, 0, BIG, (gb)(ws + WS_WF2 + 22 * MiB), 2048, DM); continue; } r -= I_MI;
                if (r < I_MO) { transpose_item((gcf)ap->in[9], DM, DM, DM, WMO, r, lane); continue; } r -= I_MO;
                if (r < I_AI) { const int kb = r / 84, nb = r - kb * 84, k0 = 64 * kb; gcf Wa = (gcf)ap->in[10];
                    if (nb < 64) { const int n_src = (nb < 32 ? 64 * nb : 3072 + 64 * (nb - 32)) + lane; tr_col_fp8(Wa, NATT, k0, n_src, (GAS v4u*)((GAS unsigned char*)WAI + (size_t)(64 * nb + lane) * DM + k0)); }
                    else { const int nbb = nb - 64; const int n_src = (nbb < 16 ? 2048 + 64 * nbb : nbb < 18 ? 5120 + 64 * (nbb - 16) : 5248) + lane; const bool ok = nbb < 18 || (nbb == 18 && lane < 16);
                        tr_col_bf16(Wa, NATT, k0, n_src, ok, (GAS v4u*)((gb)((GAS unsigned char*)WAI + 8 * MiB) + (size_t)(64 * nbb + lane) * DM + k0)); }
                    continue; } r -= I_AI;
                if (r < I_AO) { transpose_item8((gcf)ap->in[13], DM, DM, (GAS unsigned char*)WAO, r, lane); continue; } r -= I_AO;
                if (r < 2 * I_F1) { const int l = r / I_F1; absmax_tr_item((gcf)ap->in[14] + (size_t)l * DM * NGU, NGU, r - l * I_F1, lane, (GAS unsigned*)(ws + WS_CTL + 131072) + l * NGU, 1,
                        (gb)((GAS unsigned char*)WF1 + (size_t)l * 44 * MiB + 22 * MiB), (gb)((GAS unsigned char*)BIG + (size_t)(16 + 24 * l) * MiB), DFF, DM); continue; } r -= 2 * I_F1;
                { const int l = r / I_F2; transpose_item8((gcf)ap->in[17] + (size_t)l * DFF * DM, DFF, DM, (GAS unsigned char*)WF2 + (size_t)l * DM * DFF, r - l * I_F2, lane); }
            }
            xrows_phase(xp, xs, XB, (GAS unsigned char*)(ws + WS_XF + 20 * MiB), (gf)(ws + WS_XF + 40 * MiB), (gb)(ws + WS_XF + 41 * MiB), gw, NGW, lane);
            for (int e = gt; e < 188 * DM / 8; e += GT) *(GAS v4u*)((gb)(ws + WS_XF + 41 * MiB) + (size_t)68 * DM + (size_t)e * 8) = (v4u){0u, 0u, 0u, 0u};
        } else if (PHM(0) && step == 21) {
            PH_ENV
            gcf SWMf = (gcf)(ws + WS_CTL + 131072);
#define Q_ROW(row_, src_, mx_, dst_) do { if ((row_) < NBCV) { const int n_ = (row_); src_ = n_ < 2048 ? (gcb)BIG + (size_t)n_ * DM : (gcb)(ws + WS_WF2 + 22 * MiB) + (size_t)(n_ - 2048) * DM; \
                    mx_ = SWMf[2 * NGU + n_]; dst_ = (GAS unsigned char*)WMI + (size_t)n_ * DM; } \
                else { const int r2_ = (row_) - NBCV, l_ = r2_ / NGU, no_ = r2_ - l_ * NGU, c_ = 128 * (no_ >> 8) + (no_ & 127), up_ = (no_ >> 7) & 1; \
                    src_ = up_ ? (gcb)((GAS unsigned char*)BIG + (size_t)(16 + 24 * l_) * MiB) + (size_t)c_ * DM : (gcb)((GAS unsigned char*)WF1 + (size_t)l_ * 44 * MiB + 22 * MiB) + (size_t)c_ * DM; \
                    mx_ = SWMf[l_ * NGU + no_]; dst_ = (GAS unsigned char*)WF1 + (size_t)l_ * 44 * MiB + (size_t)no_ * DM; } } while (0)
            constexpr int NQR = NBCV + 2 * NGU;
            if (gw < NQR) {
                gcb src; float mx; GAS unsigned char* dst; v4u wc[4];
                Q_ROW(gw, src, mx, dst); quant_row_ld(src, lane, wc);
                for (int row = gw; row < NQR; row += NGW) {
                    gcb srcn = src; float mxn = mx; GAS unsigned char* dstn = dst; v4u wn[4];
                    const int rn = row + NGW < NQR ? row + NGW : row;
                    Q_ROW(rn, srcn, mxn, dstn); quant_row_ld(srcn, lane, wn);
                    quant_row_st(wc, mx, dst, lane);
#pragma unroll
                    for (int j = 0; j < 4; ++j) wc[j] = wn[j];
                    src = srcn; mx = mxn; dst = dstn;
                }
            }
#undef Q_ROW
        } else if (PHM(1) && step == 1) {
            PH_ENV
            pg8::Gemm g{(gcb)(ws + WS_XF + 20 * MiB), (gcb)WMI, MROWS, NBCV, DM / 2, 127, 127, 1}; pg8::DualOrder S; S.init(MROWS, NBCV, DM / 2, G, bx, 0);
            pg8::EpiBf16P E{BIG, NBCV, 0, (gcf)(ws + WS_XF + 40 * MiB), (gcf)(ws + WS_CTL + 131072) + 2 * NGU};
            pg8::gemm_phase<pg8::EpiBf16P, pg8::DualOrder, true, true, false, true>(L, g, S, E, tid);
        } else if (PHM(1) && (step == 5 || step == 16)) {
            PH_ENV
            const int fl = step == 16 ? 1 : 0;
            pg8::Gemm g{(gcb)(ws + WS_XF + 20 * MiB), (gcb)((const GAS unsigned char*)WF1 + (size_t)fl * 44 * MiB), MROWS, NGU, DM / 2, 127, 127, 1}; pg8::DualOrder S; S.init(MROWS, NGU, DM / 2, G, bx, 0);
#ifdef REP_KFIX
            if (step == REP_STEP && !(sidx & 1)) g.kfix = 1;
#endif

            gf FIX = (gf)((GAS unsigned char*)BIG + 64 * MiB);
            pg8::EpiConvGlu E{(GAS unsigned char*)HB, (gcf)ap->in[15] + (size_t)fl * 3 * DFF, (gcf)ap->in[16] + (size_t)fl * DFF, FIX, FIX + (size_t)320 * DFF, FIX + (size_t)640 * DFF, DFF, (gcf)(ws + WS_XF + 40 * MiB), (gcf)(ws + WS_CTL + 131072) + fl * NGU};
            pg8::gemm_phase<pg8::EpiConvGlu, pg8::DualOrder, true, true, false, true>(L, g, S, E, tid);
        } else if (PHM(1) && (step == 3 || step == 9 || step == 22 || step == 23 || step == 24)) {
            PH_ENV
            gcb A = XB; gcb Bt; int N, M = MROWS, tail = 0, c = bx, mode = 0; gb O = BIG; size_t kslab = 0;
            if (step == 3) { A = HB; Bt = WMO; N = DM; tail = 1; mode = 1; }
            else if (step == 9) { Bt = (gcb)((const GAS unsigned char*)WAI + 8 * MiB); N = 1280; c = G - 1 - bx; O = (gb)((GAS unsigned char*)BIG + 96 * MiB); }
            else if (step == 24) { A = (gcb)(ws + WS_XF + 41 * MiB); Bt = (gcb)(ws + WS_WF2 + 22 * MiB); N = 4096; M = 256; tail = 2; c = G - 1 - bx; O = (gb)(ws + WS_XF + 42 * MiB); kslab = (size_t)256 * 4096; }
            else { const int fl = step == 23 ? 1 : 0;
                A = (gcb)(ws + WS_XF + 41 * MiB); Bt = (gcb)((const GAS unsigned char*)WF1 + (size_t)fl * 44 * MiB + 22 * MiB); N = DFF; M = 256; tail = 2; c = G - 1 - bx; O = (gb)(ws + WS_XF + 42 * MiB); kslab = (size_t)256 * DFF; }
            pg8::Gemm g{A, Bt, M, N, DM, 127, 127, 0}; pg8::DualOrder S; S.init(M, N, DM, G, c, tail);
            pg8::EpiDual E{mode, O, N, Y, XB, NPROW, DM, DN_ALPHA, (gf)BIG, nullptr, nullptr, nullptr, nullptr, nullptr, nullptr, 0, nullptr, nullptr, kslab};
            pg8::gemm_phase<pg8::EpiDual, pg8::DualOrder, true, true, false, false>(L, g, S, E, tid);
            if (step == 9 && (bx < 56 || bx >= 128) && G == 256) {
                const int gt2 = (bx < 56 ? bx : bx - 72) * NTHR + tid, GT2 = 184 * NTHR;
                cvt_rows((gcf)ap->in[5], IKS, PAST * IDXD / 8, (size_t)LSK * IDXD, 32 * PAST * IDXD / 8, gt2, GT2);
                cvt_rows_k8((gcf)ap->in[3], (GAS unsigned char*)KS, PAST * KVW / 8, (size_t)LSK * KVW, 32 * PAST * KVW / 8, gt2, GT2);
                cvt_rows_v8((gcf)ap->in[4], (GAS unsigned char*)VS, PAST * KVW / 8, (size_t)LSK * KVW, 32 * PAST * KVW / 8, gt2, GT2); }
        } else if (PHM(2) && (step == 7 || step == 14 || step == 18 || step == 20)) {
            PH_ENV
            gcb A = HB; gcb Bt; int K8 = DM, sa = 123;
            if (step == 7) { Bt = WF2; K8 = DFF; } else if (step == 14) { A = IQ; Bt = WAO; sa = 121; } else { Bt = (gcb)((const GAS unsigned char*)WF2 + (size_t)DM * DFF); K8 = DFF; }
            int N = DM, mode = 1;
            if (step == 20) { A = (gcb)(ws + WS_XF); Bt = WAI; N = 4096; mode = 0; K8 = DM; sa = 123; }
            pg8::Gemm g{A, Bt, MROWS, N, K8 / 2, 119, sa, 0}; pg8::DualOrder S; S.init(MROWS, N, K8 / 2, G, bx, mode);
#ifdef REP_KFIX
            if (step == REP_STEP && !(sidx & 1)) g.kfix = 1;
#endif

            pg8::EpiDual E{mode, BIG, N, Y, XB, NPROW, DM, DN_ALPHA, (gf)BIG, nullptr, nullptr, nullptr, nullptr, nullptr, nullptr, 0, nullptr, nullptr, 0};
#ifdef REP_PV
            if (step == REP_STEP && !(sidx & 1)) pg8::gemm_phase<pg8::EpiDual, pg8::DualOrder, true, true, true, false, REP_PV>(L, g, S, E, tid); else
#endif
            pg8::gemm_phase<pg8::EpiDual, pg8::DualOrder, true, true, true>(L, g, S, E, tid);
        } else if (PHM(3) && step == 2) {
            PH_ENV
            conv_mix_phase(BIG, HB, (gcf)ap->in[8], (gcf)ap->in[2], out, (gcb)(ws + WS_XF + 42 * MiB), gt, GT);
        } else if (PHM(4) && (step == 6 || step == 17)) {
            PH_ENV
            const int l = step == 6 ? 0 : 1;
            gcf FIX = (gcf)((GAS unsigned char*)BIG + 64 * MiB);
            glu_fixup_phase(FIX, FIX + (size_t)320 * DFF, FIX + (size_t)640 * DFF, (GAS unsigned char*)HB, (gcf)ap->in[15] + (size_t)l * 3 * DFF, (gcf)ap->in[16] + (size_t)l * DFF, (gcf)ap->in[6] + (size_t)l * 32 * 2 * DFF, out, (gcb)(ws + WS_XF + 42 * MiB), l, gt, GT);
        } else if (PHM(5) && (step == 4 || step == 8 || step == 15 || step == 19)) {
            PH_ENV
            gcf g_; gcf b_; gf xo = nullptr; gb xb = XB;
            if (step == 4) { g_ = (gcf)ap->in[18]; b_ = (gcf)ap->in[19]; } else if (step == 8) { g_ = (gcf)ap->in[20]; b_ = (gcf)ap->in[21]; } else if (step == 15) { g_ = (gcf)ap->in[18] + DM; b_ = (gcf)ap->in[19] + DM; }
            else { g_ = (gcf)ap->in[20] + DM; b_ = (gcf)ap->in[21] + DM; xo = out; xb = nullptr; }
            const bool ffn_next = step == 4 || step == 15;
            ln_phase(Y, (gcf)BIG, g_, b_, xo, xb, step == 8 ? (GAS unsigned char*)(ws + WS_XF) : (GAS unsigned char*)nullptr, ffn_next ? (GAS unsigned char*)(ws + WS_XF + 20 * MiB) : (GAS unsigned char*)nullptr, (gf)(ws + WS_XF + 40 * MiB), (gb)(ws + WS_XF + 41 * MiB), gw, NGW, lane);
        } else if (PHM(6) && step == 10) {
            PH_ENV
            postproj_phase(BIG, (gcb)((GAS unsigned char*)BIG + 96 * MiB), ap->inv_freq, (gcf)ap->in[11], (gcf)ap->in[12], out, QR, IQ, KP, VP, IKP, KS, VS, IKS, IW, gw, NGW, lane);
            if (G != 256) {
                cvt_rows((gcf)ap->in[5], IKS, PAST * IDXD / 8, (size_t)LSK * IDXD, 32 * PAST * IDXD / 8, gt, GT);
                cvt_rows_k8((gcf)ap->in[3], (GAS unsigned char*)KS, PAST * KVW / 8, (size_t)LSK * KVW, 32 * PAST * KVW / 8, gt, GT);
                cvt_rows_v8((gcf)ap->in[4], (GAS unsigned char*)VS, PAST * KVW / 8, (size_t)LSK * KVW, 32 * PAST * KVW / 8, gt, GT); }
        } else if (PHM(7) && step == 11) {
            PH_ENV
            indexer_phase(L, IQ, IW, IKP, IKS, SCP, SCS, vcu, G, tid, lane, wave);
        } else if (PHM(8) && step == 12) {
            PH_ENV
            topk_phase(L, SCP, SCS, SEL, gw, NGW, lane, wave);
        } else if (PHM(9) && step == 13) {
            PH_ENV
            attn_phase(L, QR, IQ, SEL, KP, VP, KS, VS, vcu, G, lane, wave);
        }
        if ((sidx + 1 < NSTEP * 2 - 1 || REP_MASK) && step != 20 && step != 1 && step != 5 && step != 16) {   int tb; asm volatile("v_mbcnt_lo_u32_b32 %0, -1, 0\n\tv_mbcnt_hi_u32_b32 %0, -1, %0" : "=v"(tb)); xcd_barrier(bar, tb + wave_s * 64); }
    }
}

extern "C" void kernel_launch(void* const* d_in, const int* in_sizes, int n_in, void* d_out, int out_size, void* d_ws, size_t ws_size, hipStream_t stream) {
    static int grid = 0;
    if (grid == 0) {
        if (n_in != 22 || out_size != (int)O_END || ws_size < WS_END) { fprintf(stderr, "kernel_launch: built for 22 inputs, %zu outputs, >= %zu bytes of workspace; got n_in %d, out %d, ws %zu; nothing launched\n", (size_t)O_END, (size_t)WS_END, n_in, out_size, ws_size); grid = -1; return; }
        int dev = 0, cus = 0;
        if (hipGetDevice(&dev) != hipSuccess || hipDeviceGetAttribute(&cus, hipDeviceAttributeMultiprocessorCount, dev) != hipSuccess) { fprintf(stderr, "kernel_launch: device query failed\n"); grid = -1; return; }
        if (hipFuncSetAttribute((const void*)mega_fwd, hipFuncAttributeMaxDynamicSharedMemorySize, LDS_BYTES) != hipSuccess) { fprintf(stderr, "kernel_launch: hipFuncSetAttribute failed\n"); grid = -1; return; }
        (void)hipGetLastError();
        grid = cus;
    }
    if (grid < 0) return;
    if (hipMemsetAsync((char*)d_ws + WS_CTL, 0, CTL_ZERO_BYTES, stream) != hipSuccess) { fprintf(stderr, "kernel_launch: hipMemsetAsync failed\n"); return; }
    Args a{};
    for (int i = 0; i < 22; ++i) a.in[i] = (const float*)d_in[i];
    a.out = (float*)d_out; a.ws = (unsigned char*)d_ws;
    for (int d = 0; d < 64; ++d) a.inv_freq[d] = (float)pow(10000.0, -(double)d / 64.0);
    hipLaunchKernelGGL(mega_fwd, dim3(grid), dim3(NTHR), LDS_BYTES, stream, a);
    const hipError_t le = hipPeekAtLastError();
    if (le != hipSuccess) fprintf(stderr, "kernel_launch: launch failed: %s\n", hipGetErrorName(le));
}
```
